# Optimizing an MI355X kernel written in HIP

```python
import jax, jax.numpy as jnp
from jax import lax
import numpy as np

D_MODEL = 1024
BATCH = 32
SEQ = 2048
DEPTH = 4

N_A_LAYERS = DEPTH // 2
N_B_LAYERS = DEPTH - N_A_LAYERS
RMS_EPS = 1e-6
RET_HEADS = D_MODEL // 256
RET_QK_DIM = D_MODEL // RET_HEADS
RET_V_DIM = 2 * D_MODEL // RET_HEADS
RET_IN_WIDTH = 6 * D_MODEL
RET_CHUNK = 128
RET_ROT_BASE = 10000.0
GN_EPS = 1e-6
ATT_HEADS = 16
ATT_HEAD_DIM = D_MODEL // ATT_HEADS
DIL_GROUPS = ((128, 1), (512, 4), (2048, 16))
N_GROUPS = 3
ATT_BLOCK = 128
ROPE_THETA = 500000.0
ROPE_DIMS = ATT_HEAD_DIM // 4
Q_WIDTH = N_GROUPS * ATT_HEADS * ATT_HEAD_DIM
D_FF = 2816
CONV_WIDTH = 3

kernel_name = "yoco_retention_dilated_attn_convffn"


def rmsnorm(x, g):
    xf = x.astype(jnp.float32)
    y = xf * lax.rsqrt(jnp.mean(xf * xf, axis=-1, keepdims=True) + RMS_EPS)
    return (y * g).astype(x.dtype)


def apply_rotary(t, pos, inv_freq):
    n = 2 * inv_freq.shape[0]
    S = t.shape[1]
    ang = pos.astype(jnp.float32)[:, None] * inv_freq[None, :]
    bshape = (1, S) + (1,) * (t.ndim - 3) + (n // 2,)
    cos = jnp.cos(ang).reshape(bshape)
    sin = jnp.sin(ang).reshape(bshape)
    t1, t2, rest = t[..., : n // 2], t[..., n // 2: n], t[..., n:]
    rot = jnp.concatenate([t1 * cos - t2 * sin, t2 * cos + t1 * sin], axis=-1).astype(t.dtype)
    return jnp.concatenate([rot, rest], axis=-1)


def retention_chunkwise(q, k, v, log_gamma):
    B, S, H, dk = q.shape
    dv = v.shape[-1]
    C = RET_CHUNK
    nc = S // C
    qc = q.reshape(B, nc, C, H, dk)
    kc = k.reshape(B, nc, C, H, dk)
    vc = v.reshape(B, nc, C, H, dv)
    n = jnp.arange(C, dtype=jnp.float32)
    diff = n[:, None] - n[None, :]
    decay_mask = jnp.where(diff[None] >= 0,
                           jnp.exp(jnp.maximum(diff, 0.0)[None] * log_gamma[:, None, None]), 0.0)
    scores = jnp.einsum('bnqhd,bnkhd->bnhqk', qc, kc) * decay_mask
    intra = jnp.einsum('bnhqk,bnkhe->bnqhe', scores, vc)
    xi = jnp.exp((n + 1.0)[None, :] * log_gamma[:, None]).T[None, :, :, None]
    zeta = jnp.exp((C - 1.0 - n)[None, :] * log_gamma[:, None]).T[None, :, :, None]
    chunk_decay = jnp.exp(C * log_gamma)[None, :, None, None]

    def step(state, inp):
        qi, ki, vi = inp
        cross = jnp.einsum('bchd,bhde->bche', qi, state) * xi
        state = state * chunk_decay + jnp.einsum('bchd,bche->bhde', ki * zeta, vi)
        return state, cross

    state0 = jnp.zeros((B, H, dk, dv), jnp.float32)
    _, cross = lax.scan(step, state0, (jnp.moveaxis(qc, 1, 0), jnp.moveaxis(kc, 1, 0), jnp.moveaxis(vc, 1, 0)))
    out = intra + jnp.moveaxis(cross, 0, 1)
    return out.reshape(B, S, H, dv).astype(v.dtype)


def retention_mixer(h, w_in, w_out, gn_gain, pos):
    B, S, _ = h.shape
    dqk = RET_HEADS * RET_QK_DIM
    dv = RET_HEADS * RET_V_DIM
    proj = h @ w_in
    q = proj[..., :dqk].reshape(B, S, RET_HEADS, RET_QK_DIM)
    k = proj[..., dqk:2 * dqk].reshape(B, S, RET_HEADS, RET_QK_DIM) * (RET_QK_DIM ** -0.5)
    v = proj[..., 2 * dqk:2 * dqk + dv].reshape(B, S, RET_HEADS, RET_V_DIM)
    g = proj[..., 2 * dqk + dv:]
    inv_freq = 1.0 / (RET_ROT_BASE ** jnp.linspace(0.0, 1.0, RET_QK_DIM // 2, dtype=jnp.float32))
    q = apply_rotary(q, pos, inv_freq)
    k = apply_rotary(k, pos, inv_freq)
    log_gamma = jnp.log(1.0 - 2.0 ** (-5.0 - jnp.arange(RET_HEADS, dtype=jnp.float32)))
    y = retention_chunkwise(q, k, v, log_gamma).astype(jnp.float32)
    mu = jnp.mean(y, axis=-1, keepdims=True)
    var = jnp.mean(jnp.square(y - mu), axis=-1, keepdims=True)
    yn = ((y - mu) * lax.rsqrt(var + GN_EPS)).reshape(B, S, dv) * gn_gain
    return (jax.nn.silu(g) * yn.astype(g.dtype)) @ w_out


def shared_kv(x, kv_norm, w_kv, pos):
    B, S, _ = x.shape
    kv = (rmsnorm(x, kv_norm) @ w_kv).reshape(B, S, 2, N_GROUPS, ATT_HEADS, ATT_HEAD_DIM)
    inv_freq = ROPE_THETA ** (-jnp.arange(0, ROPE_DIMS, 2, dtype=jnp.float32) / ROPE_DIMS)
    k = apply_rotary(kv[:, :, 0], pos, inv_freq)
    v = kv[:, :, 1]
    return k, v


def dilated_group_attention(q, k, v, window, dilation):
    B, S, H, hd = q.shape
    blk = ATT_BLOCK
    steps = window // dilation
    span = dilation * blk
    s_pad = -(-S // span) * span
    L = s_pad // dilation
    nblk = L // blk

    def to_sub(t):
        t = jnp.pad(t, ((0, 0), (0, s_pad - S), (0, 0), (0, 0)))
        return t.reshape(B, L, dilation, H, hd).transpose(0, 2, 1, 3, 4)

    qs = to_sub(q)
    ks = jnp.pad(to_sub(k), ((0, 0), (0, 0), (blk, 0), (0, 0), (0, 0)))
    vs = jnp.pad(to_sub(v), ((0, 0), (0, 0), (blk, 0), (0, 0), (0, 0)))
    kj = jnp.arange(2 * blk)[None, :]
    dist = (jnp.arange(blk)[:, None] + blk) - kj
    band = (dist >= 0) & (dist <= steps)
    scale = hd ** -0.5

    def one_block(idx):
        r = idx // nblk
        b = idx % nblk
        qb = lax.dynamic_slice(qs, (0, r, b * blk, 0, 0), (B, 1, blk, H, hd))[:, 0]
        kb = lax.dynamic_slice(ks, (0, r, b * blk, 0, 0), (B, 1, 2 * blk, H, hd))[:, 0]
        vb = lax.dynamic_slice(vs, (0, r, b * blk, 0, 0), (B, 1, 2 * blk, H, hd))[:, 0]
        s = jnp.einsum('bqhd,bkhd->bhqk', qb, kb).astype(jnp.float32) * scale
        valid = band & (b * blk + kj - blk >= 0)
        s = jnp.where(valid, s, -jnp.inf)
        m = jnp.max(s, axis=-1, keepdims=True)
        p = jnp.exp(s - m)
        den = jnp.sum(p, axis=-1)
        o = jnp.einsum('bhqk,bkhd->bqhd', p, vb) / den.transpose(0, 2, 1)[..., None]
        lse = (m[..., 0] + jnp.log(den)).transpose(0, 2, 1)
        return o.astype(q.dtype), lse

    o, lse = lax.map(one_block, jnp.arange(dilation * nblk))
    o = o.reshape(dilation, nblk, B, blk, H, hd).transpose(2, 1, 3, 0, 4, 5).reshape(B, s_pad, H, hd)[:, :S]
    lse = lse.reshape(dilation, nblk, B, blk, H).transpose(2, 1, 3, 0, 4).reshape(B, s_pad, H)[:, :S]
    return o, lse


def dilated_mixer(h, w_q, w_o, k_sh, v_sh, pos):
    B, S, _ = h.shape
    q = (h @ w_q).reshape(B, S, N_GROUPS, ATT_HEADS, ATT_HEAD_DIM)
    inv_freq = ROPE_THETA ** (-jnp.arange(0, ROPE_DIMS, 2, dtype=jnp.float32) / ROPE_DIMS)
    q = apply_rotary(q, pos, inv_freq)
    outs, lses = [], []
    for gi, (window, dilation) in enumerate(DIL_GROUPS):
        o, l = dilated_group_attention(q[:, :, gi], k_sh[:, :, gi], v_sh[:, :, gi], window, dilation)
        outs.append(o)
        lses.append(l)
    alpha = jax.nn.softmax(jnp.stack(lses, axis=0), axis=0)
    o = jnp.einsum('gbsh,gbshd->bshd', alpha, jnp.stack(outs, axis=0).astype(jnp.float32))
    return o.astype(h.dtype).reshape(B, S, ATT_HEADS * ATT_HEAD_DIM) @ w_o


def conv_ffn(h, w_up, conv_w, conv_b, w_down):
    S = h.shape[1]
    u = h @ w_up
    gate, val = u[..., :D_FF], u[..., D_FF:]
    gp = jnp.pad(gate, ((0, 0), (CONV_WIDTH - 1, 0), (0, 0)))
    conv = conv_b
    for i in range(CONV_WIDTH):
        conv = conv + conv_w[i] * gp[:, i:i + S]
    return (jax.nn.gelu(conv, approximate=True) * val) @ w_down


def setup_inputs(seed: int = 0) -> dict:
    key = jax.random.key(seed)
    ks = jax.random.split(key, 17)
    f32 = jnp.float32

    def nrm(k, shape, fan_in):
        return jax.random.normal(k, shape, f32) * (fan_in ** -0.5)

    def gain(k, shape):
        return 1.0 + 0.02 * jax.random.normal(k, shape, f32)

    return {
        "x": jax.random.normal(ks[0], (BATCH, SEQ, D_MODEL), f32),
        "ret_w_in": nrm(ks[1], (N_A_LAYERS, D_MODEL, RET_IN_WIDTH), D_MODEL),
        "ret_w_out": nrm(ks[2], (N_A_LAYERS, RET_HEADS * RET_V_DIM, D_MODEL), RET_HEADS * RET_V_DIM),
        "ret_gn_gain": gain(ks[3], (N_A_LAYERS, RET_HEADS * RET_V_DIM)),
        "kv_norm": gain(ks[4], (D_MODEL,)),
        "att_w_kv": nrm(ks[5], (D_MODEL, 2 * Q_WIDTH), D_MODEL),
        "att_w_q": nrm(ks[6], (N_B_LAYERS, D_MODEL, Q_WIDTH), D_MODEL),
        "att_w_o": nrm(ks[7], (N_B_LAYERS, ATT_HEADS * ATT_HEAD_DIM, D_MODEL), ATT_HEADS * ATT_HEAD_DIM),
        "norm_mix_pre": gain(ks[8], (DEPTH, D_MODEL)),
        "norm_mix_post": gain(ks[9], (DEPTH, D_MODEL)),
        "norm_ffn_pre": gain(ks[10], (DEPTH, D_MODEL)),
        "norm_ffn_post": gain(ks[11], (DEPTH, D_MODEL)),
        "ffn_w_up": nrm(ks[12], (DEPTH, D_MODEL, 2 * D_FF), D_MODEL),
        "ffn_conv_w": nrm(ks[13], (DEPTH, CONV_WIDTH, D_FF), CONV_WIDTH),
        "ffn_conv_b": 0.02 * jax.random.normal(ks[14], (DEPTH, D_FF), f32),
        "ffn_w_down": nrm(ks[15], (DEPTH, D_FF, D_MODEL), D_FF),
    }


def reference(x, ret_w_in, ret_w_out, ret_gn_gain, kv_norm, att_w_kv, att_w_q, att_w_o,
              norm_mix_pre, norm_mix_post, norm_ffn_pre, norm_ffn_post,
              ffn_w_up, ffn_conv_w, ffn_conv_b, ffn_w_down):
    pos = jnp.arange(x.shape[1], dtype=jnp.int32)
    k_sh, v_sh = None, None
    for layer in range(DEPTH):
        h = rmsnorm(x, norm_mix_pre[layer])
        if layer < N_A_LAYERS:
            m = retention_mixer(h, ret_w_in[layer], ret_w_out[layer], ret_gn_gain[layer], pos)
        else:
            bi = layer - N_A_LAYERS
            m = dilated_mixer(h, att_w_q[bi], att_w_o[bi], k_sh, v_sh, pos)
        x = x + rmsnorm(m, norm_mix_post[layer])
        f = conv_ffn(rmsnorm(x, norm_ffn_pre[layer]), ffn_w_up[layer], ffn_conv_w[layer],
                     ffn_conv_b[layer], ffn_w_down[layer])
        x = x + rmsnorm(f, norm_ffn_post[layer])
        if layer == N_A_LAYERS - 1:
            k_sh, v_sh = shared_kv(x, kv_norm, att_w_kv, pos)
    return x
```

```cpp
#include <hip/hip_runtime.h>
#include <cstdio>
#include <cstdint>
namespace pg8 {
#define PG8_LAS __attribute__((address_space(3)))
typedef unsigned short bf16_t;
typedef short bf16x8 __attribute__((ext_vector_type(8)));
typedef float f32x4 __attribute__((ext_vector_type(4)));
typedef unsigned u32x4 __attribute__((ext_vector_type(4)));
constexpr int BM = 256, BK = 64, HALF = 128, HTB = HALF * BK * 2  , STAGE_BYTES = 8 * HTB, NXCD = 8, WGM = 8;

__host__ __device__ __forceinline__ int lds_byte(int r, int c) { const int st = (r >> 4) * 2 + (c >> 5), rr = r & 15, cc = c & 31, ob = rr * 64 + cc * 2; return st * 1024 + (ob ^ (((ob >> 9) & 1) << 5)); }
__host__ __device__ __forceinline__ void stage_rc(int b, int& R, int& C) { const int st = b / 1024, sb = b % 1024, swz = sb ^ (((sb >> 9) & 1) << 5); R = (st >> 1) * 16 + swz / 64; C = (st & 1) * 32 + (swz % 64) / 2; }
__host__ __device__ __forceinline__ int perm32(int rho) { const int n = rho >> 4, i = rho & 15; return 8 * (i >> 2) + 4 * n + (i & 3); }

struct Unit { int pm, pn; };
struct Gemm { const bf16_t* A; const bf16_t* Bt; int M, N, K; };

struct StaticOrder {
    int nM, nN, nwg, G, c;
    __host__ __device__ void init(int M, int N, int G_, int c_) { nM = M / BM; nN = N / BM; nwg = nM * nN; G = G_; c = c_; }
    __host__ __device__ bool next(int i, Unit& u) const {
        const long L = (long)i * G + c; if (L >= nwg) return false;
        int wgid = (int)L; { const int q = nwg / NXCD, r = nwg % NXCD, xcd = wgid % NXCD, off = wgid / NXCD; wgid = (xcd < r ? xcd * (q + 1) : r * (q + 1) + (xcd - r) * q) + off; }
        const int nig = WGM * nN, gid = wgid / nig, fm = gid * WGM, gsz = (nM - fm) < WGM ? (nM - fm) : WGM;
        u.pm = fm + ((wgid % nig) % gsz); u.pn = (wgid % nig) / gsz; return true;
    }
    __device__ __forceinline__ void a_ready(const Unit&) const {}
    __device__ __forceinline__ void done(const Unit&) const {}
};
__device__ __forceinline__ unsigned cvt_pk_bf16(float lo, float hi) { unsigned r; asm volatile("v_cvt_pk_bf16_f32 %0, %1, %2" : "=v"(r) : "v"(lo), "v"(hi)); return r; }
template <class Epi, class Sched, bool ALIGN_EPI = false, bool SP2 = false>
__device__ __forceinline__ void gemm_phase(PG8_LAS unsigned char* lds, const Gemm g, const Sched& S, const Epi& E) {
    const int tid = threadIdx.x, wid = __builtin_amdgcn_readfirstlane(tid >> 6), lane = tid & 63, wr = wid >> 2, wc = wid & 3, fr = lane & 15, fq = lane >> 4;
    const int K = g.K, nt = K / BK;
    unsigned voffA[2], voffB[2];
#pragma unroll
    for (int i = 0; i < 2; ++i) { int R, C; stage_rc(tid * 16 + i * 8192, R, C); const int Rb = Epi::PERM ? ((R & ~31) + perm32(R & 31)) : R;
        voffA[i] = (unsigned)(R * K + C) * 2u; voffB[i] = (unsigned)(Rb * K + C) * 2u; }
    const size_t kstep = (size_t)(BK * 2);
    const size_t hstep = (size_t)HALF * K * 2;
    const size_t tstep = 2 * hstep;
    const unsigned ldsw = (unsigned)wid * 1024u;
    const int aoff = lds_byte(wr * 64 + fr, fq * 8), boff = lds_byte(wc * 32 + fr, fq * 8);
#define PG8_SA(b, h) (((b) * 2 + (h)) * HTB)
#define PG8_SB(b, h) ((4 + (b) * 2 + (h)) * HTB)
#define PG8_STAGE(bufoff, gbase, voff) do { _Pragma("unroll") for (int _i = 0; _i < 2; ++_i) \
        __builtin_amdgcn_global_load_lds((const unsigned*)((const char*)(gbase) + (voff)[_i]), (PG8_LAS unsigned*)(lds + (bufoff) + ldsw + _i * 8192), 16, 0, 0); } while (0)
#define PG8_LDA(dst, b, h) do { _Pragma("unroll") for (int m = 0; m < 4; ++m) _Pragma("unroll") for (int k = 0; k < 2; ++k) dst[m][k] = *(const PG8_LAS bf16x8*)(lds + PG8_SA(b, h) + aoff + m * 2048 + k * 1024); } while (0)
#define PG8_LDB(dst, b, h) do { _Pragma("unroll") for (int n = 0; n < 2; ++n) _Pragma("unroll") for (int k = 0; k < 2; ++k) dst[n][k] = *(const PG8_LAS bf16x8*)(lds + PG8_SB(b, h) + boff + n * 2048 + k * 1024); } while (0)
#define PG8_MMA(ai, bj, At, Bt) do { __builtin_amdgcn_s_setprio(1); _Pragma("unroll") for (int m = 0; m < 4; ++m) _Pragma("unroll") for (int n = 0; n < 2; ++n) _Pragma("unroll") for (int k = 0; k < 2; ++k) \
        acc[ai][bj][m][n] = __builtin_amdgcn_mfma_f32_16x16x32_bf16(Bt[n][k], At[m][k], acc[ai][bj][m][n], 0, 0, 0); __builtin_amdgcn_s_setprio(0); } while (0)
#define PG8_WAIT_V(n) asm volatile("s_waitcnt vmcnt(" #n ")" ::: "memory")
#define PG8_WAIT_L(n) asm volatile("s_waitcnt lgkmcnt(" #n ")" ::: "memory")
#define PG8_BAR __builtin_amdgcn_s_barrier()
#define PG8_SCHED __builtin_amdgcn_sched_barrier(0)
    Unit cur, nxt; int ui = 0;
    if (!S.next(0, cur)) return;
    f32x4 acc[2][2][4][2];
#pragma unroll
    for (int a = 0; a < 2; ++a)
#pragma unroll
        for (int b = 0; b < 2; ++b)
#pragma unroll
            for (int m = 0; m < 4; ++m)
#pragma unroll
                for (int n = 0; n < 2; ++n) acc[a][b][m][n] = (f32x4){0.f, 0.f, 0.f, 0.f};
    bf16x8 At[4][2], B0[2][2], B1[2][2];
    const char* cA = (const char*)g.A + (size_t)cur.pm * tstep; const char* cB = (const char*)g.Bt + (size_t)cur.pn * tstep;
    S.a_ready(cur);
    if constexpr (SP2) {
        PG8_STAGE(PG8_SB(0, 0), cB, voffB); PG8_STAGE(PG8_SB(0, 1), cB + hstep, voffB); PG8_STAGE(PG8_SA(0, 0), cA, voffA); PG8_STAGE(PG8_SA(0, 1), cA + hstep, voffA);
        if (wr == 1) PG8_BAR;
        PG8_WAIT_V(2); PG8_BAR;
        PG8_STAGE(PG8_SB(1, 0), cB + kstep, voffB); PG8_STAGE(PG8_SA(1, 0), cA + kstep, voffA); PG8_STAGE(PG8_SB(1, 1), cB + hstep + kstep, voffB);
        PG8_WAIT_V(6); PG8_BAR;
    } else {
        PG8_STAGE(PG8_SB(0, 0), cB, voffB); PG8_STAGE(PG8_SA(0, 0), cA, voffA); PG8_STAGE(PG8_SB(0, 1), cB + hstep, voffB); PG8_STAGE(PG8_SA(0, 1), cA + hstep, voffA);
        if (wr == 1) PG8_BAR;
        PG8_WAIT_V(4); PG8_BAR;
        PG8_STAGE(PG8_SB(1, 0), cB + kstep, voffB); PG8_STAGE(PG8_SA(1, 0), cA + kstep, voffA); PG8_STAGE(PG8_SB(1, 1), cB + hstep + kstep, voffB);
        PG8_WAIT_V(6); PG8_BAR;
    }
    for (;;) {
        const bool has_next = S.next(ui + 1, nxt);
        const char* nA = has_next ? (const char*)g.A + (size_t)nxt.pm * tstep : cA; const char* nB = has_next ? (const char*)g.Bt + (size_t)nxt.pn * tstep : cB;
        for (int t = 0; t < nt; t += 2) {
            const bool last = (t == nt - 2);
            const char* a1 = cA + (size_t)(t + 1) * kstep;
            const char* a2 = last ? nA : cA + (size_t)(t + 2) * kstep; const char* b2 = last ? nB : cB + (size_t)(t + 2) * kstep;
            const char* a3 = a2 + kstep; const char* b3 = b2 + kstep;
            if (last && has_next) S.a_ready(nxt);
            if constexpr (SP2) {
            PG8_LDB(B0, 0, 0); PG8_LDB(B1, 0, 1); PG8_SCHED; PG8_LDA(At, 0, 0); PG8_STAGE(PG8_SA(1, 1), a1 + hstep, voffA);
            PG8_WAIT_V(8); PG8_WAIT_L(0); PG8_BAR; PG8_MMA(0, 0, At, B0); PG8_MMA(0, 1, At, B1); PG8_BAR; PG8_SCHED;
            PG8_LDA(At, 0, 1); PG8_STAGE(PG8_SB(0, 0), b2, voffB); PG8_STAGE(PG8_SB(0, 1), b2 + hstep, voffB); PG8_STAGE(PG8_SA(0, 0), a2, voffA);
            PG8_WAIT_V(8); PG8_WAIT_L(0); PG8_BAR; PG8_MMA(1, 0, At, B0); PG8_MMA(1, 1, At, B1); PG8_BAR; PG8_SCHED;
            PG8_LDB(B0, 1, 0); PG8_LDB(B1, 1, 1); PG8_SCHED; PG8_LDA(At, 1, 0); PG8_STAGE(PG8_SA(0, 1), a2 + hstep, voffA);
            PG8_WAIT_V(8); PG8_WAIT_L(0); PG8_BAR; PG8_MMA(0, 0, At, B0); PG8_MMA(0, 1, At, B1); PG8_BAR; PG8_SCHED;
            PG8_LDA(At, 1, 1); PG8_STAGE(PG8_SB(1, 0), b3, voffB); PG8_STAGE(PG8_SB(1, 1), b3 + hstep, voffB); PG8_STAGE(PG8_SA(1, 0), a3, voffA);
            PG8_WAIT_V(8); PG8_WAIT_L(0); PG8_BAR; PG8_MMA(1, 0, At, B0); PG8_MMA(1, 1, At, B1); PG8_BAR; PG8_SCHED;
            } else {
            PG8_LDB(B0, 0, 0); PG8_SCHED; PG8_LDA(At, 0, 0); PG8_STAGE(PG8_SA(1, 1), a1 + hstep, voffA);
            PG8_WAIT_L(8); PG8_BAR; PG8_WAIT_L(0); PG8_MMA(0, 0, At, B0); PG8_BAR; PG8_SCHED;
            PG8_LDB(B1, 0, 1); PG8_STAGE(PG8_SB(0, 0), b2, voffB);
            PG8_BAR; PG8_WAIT_L(0); PG8_MMA(0, 1, At, B1); PG8_BAR;
            PG8_LDA(At, 0, 1); PG8_STAGE(PG8_SA(0, 0), a2, voffA);
            PG8_BAR; PG8_WAIT_L(0); PG8_MMA(1, 0, At, B0); PG8_BAR; PG8_SCHED;
            PG8_STAGE(PG8_SB(0, 1), b2 + hstep, voffB);
            PG8_WAIT_V(6); PG8_BAR; PG8_MMA(1, 1, At, B1); PG8_BAR;
            PG8_LDB(B0, 1, 0); PG8_SCHED; PG8_LDA(At, 1, 0); PG8_STAGE(PG8_SA(0, 1), a2 + hstep, voffA);
            PG8_WAIT_L(8); PG8_BAR; PG8_WAIT_L(0); PG8_MMA(0, 0, At, B0); PG8_BAR; PG8_SCHED;
            PG8_LDB(B1, 1, 1); PG8_STAGE(PG8_SB(1, 0), b3, voffB);
            PG8_BAR; PG8_WAIT_L(0); PG8_MMA(0, 1, At, B1); PG8_BAR;
            PG8_LDA(At, 1, 1); PG8_STAGE(PG8_SA(1, 0), a3, voffA);
            PG8_BAR; PG8_WAIT_L(0); PG8_MMA(1, 0, At, B0); PG8_BAR; PG8_SCHED;
            PG8_STAGE(PG8_SB(1, 1), b3 + hstep, voffB);
            PG8_WAIT_V(6); PG8_BAR; PG8_MMA(1, 1, At, B1); PG8_BAR;
            }
        }
        if constexpr (ALIGN_EPI) { if (wr == 0) PG8_BAR; }
        if constexpr (!Epi::AFTER_DRAIN) { E(acc, cur, wr, wc, fr, fq); S.done(cur); }
        if (!has_next) break;
#pragma unroll
        for (int a = 0; a < 2; ++a)
#pragma unroll
            for (int b = 0; b < 2; ++b)
#pragma unroll
                for (int m = 0; m < 4; ++m)
#pragma unroll
                    for (int n = 0; n < 2; ++n) acc[a][b][m][n] = (f32x4){0.f, 0.f, 0.f, 0.f};
        cur = nxt; cA = nA; cB = nB; ++ui;
        if constexpr (ALIGN_EPI) { if (wr == 1) PG8_BAR; }
    }
    PG8_WAIT_V(0);
    if constexpr (!ALIGN_EPI) { if (wr == 0) PG8_BAR; }
    PG8_BAR;
    if constexpr (Epi::AFTER_DRAIN) { E.fused(acc, cur, wr, wc, fr, fq, lds, wid, lane); S.done(cur); }
#undef PG8_SA
#undef PG8_SB
#undef PG8_STAGE
#undef PG8_LDA
#undef PG8_LDB
#undef PG8_MMA
#undef PG8_WAIT_V
#undef PG8_WAIT_L
#undef PG8_BAR
#undef PG8_SCHED
}
}

#define LAS __attribute__((address_space(3)))
typedef unsigned short bf16;
typedef unsigned v4u __attribute__((ext_vector_type(4)));
typedef unsigned v2u __attribute__((ext_vector_type(2)));
typedef float f32x4 __attribute__((ext_vector_type(4)));

constexpr int D = 1024, SEQ = 2048, NBATCH = 32, M_ALL = NBATCH * SEQ;
constexpr int MC = M_ALL / 2;
constexpr int FF = 2816, RET_IN = 6144, QW = 3072, KVW = 6144;
constexpr float RMS_EPS = 1e-6f, GN_EPS = 1e-6f;
constexpr size_t MiB = 1u << 20;
constexpr size_t WS_CTL = 0, CTL_ZERO_BYTES = 1 * MiB;
constexpr size_t WS_MS = 512 * 1024;
constexpr size_t WS_RCOS = 1 * MiB, WS_RSIN = 2 * MiB;
constexpr size_t WS_ACOS = 3 * MiB, WS_ASIN = 3 * MiB + 65536;
constexpr size_t WS_RS = 3 * MiB + 512 * 1024;
constexpr size_t WS_W = 4 * MiB;
constexpr size_t W_RETIN = 0, W_RETOUT = W_RETIN + 2ull * RET_IN * D, W_KV = W_RETOUT + 2ull * D * 2048, W_Q = W_KV + (size_t)KVW * D,
                 W_O = W_Q + 2ull * QW * D, W_UP = W_O + 2ull * D * D, W_DOWN = W_UP + 4ull * 2 * FF * D, W_END = W_DOWN + 4ull * D * FF;
static_assert(W_END * 2 <= 127 * MiB, "weights");
constexpr size_t WS_XB = 132 * MiB;
constexpr size_t WS_BIG = 264 * MiB;
constexpr size_t WS_Q = 648 * MiB;
constexpr size_t WS_O = 840 * MiB;
constexpr size_t WS_MB = 904 * MiB;
constexpr size_t WS_END = 968 * MiB;

struct Params {
    const float* x; const float* ret_w_in; const float* ret_w_out; const float* ret_gn; const float* kv_norm; const float* w_kv; const float* w_q; const float* w_o;
    const float* n_mix_pre; const float* n_mix_post; const float* n_ffn_pre; const float* n_ffn_post; const float* w_up; const float* conv_w; const float* conv_b; const float* w_down;
    float* out; unsigned char* ws;
};

__device__ __forceinline__ float bf2f(unsigned short b) { return __uint_as_float(((unsigned)b) << 16); }
__device__ __forceinline__ unsigned f2bf(float f) { unsigned u = __float_as_uint(f); return (u + 0x7fffu + ((u >> 16) & 1u)) >> 16; }
__device__ __forceinline__ unsigned pk2(float lo, float hi) { return f2bf(lo) | (f2bf(hi) << 16); }
__device__ __forceinline__ float wave_sum(float v) {
#pragma unroll
    for (int o = 1; o < 64; o <<= 1) v += __shfl_xor(v, o);
    return v;
}
__device__ __forceinline__ float wave_max(float v) {
#pragma unroll
    for (int o = 1; o < 64; o <<= 1) v = fmaxf(v, __shfl_xor(v, o));
    return v;
}
#define LDS_WAIT() asm volatile("s_waitcnt lgkmcnt(0)" ::: "memory")

namespace pg8 {
struct EpiRS {
    static constexpr bool PERM = true, AFTER_DRAIN = false;
    bf16_t* O; const float* rs; float* ms; int ldc; int pad;
    __device__ __forceinline__ void operator()(const f32x4 (&acc)[2][2][4][2], const Unit& u, int wr, int wc, int fr, int fq) const {
        const int row0 = u.pm * BM + wr * 64 + fr, col0 = u.pn * BM + wc * 32 + 8 * fq;
#pragma unroll
        for (int ai = 0; ai < 2; ++ai)
#pragma unroll
            for (int m = 0; m < 4; ++m) {
                const int row = row0 + ai * HALF + m * 16; const float s = rs ? rs[row] : 1.f; float ss = 0.f;
                bf16_t* rowp = O + (size_t)row * ldc + col0;
#pragma unroll
                for (int bj = 0; bj < 2; ++bj) { const f32x4 v0 = acc[ai][bj][m][0] * s, v1 = acc[ai][bj][m][1] * s;
                    ss += (v0[0] * v0[0] + v0[1] * v0[1]) + (v0[2] * v0[2] + v0[3] * v0[3]) + (v1[0] * v1[0] + v1[1] * v1[1]) + (v1[2] * v1[2] + v1[3] * v1[3]);
                    u32x4 w; w.x = cvt_pk_bf16(v0[0], v0[1]); w.y = cvt_pk_bf16(v0[2], v0[3]); w.z = cvt_pk_bf16(v1[0], v1[1]); w.w = cvt_pk_bf16(v1[2], v1[3]);
                    *(u32x4*)(rowp + bj * HALF) = w; }
                if (ms) { ss += __shfl_xor(ss, 16); ss += __shfl_xor(ss, 32); if (fq == 0) unsafeAtomicAdd(ms + row, ss); }
            }
    }
};
struct EpiUp {
    static constexpr bool PERM = true, AFTER_DRAIN = false;
    bf16_t* G2; bf16_t* V2; const float* rs;
    __device__ __forceinline__ void operator()(const f32x4 (&acc)[2][2][4][2], const Unit& u, int wr, int wc, int fr, int fq) const {
        const int row0 = u.pm * BM + wr * 64 + fr, f0 = u.pn * HALF + wc * 32 + 8 * fq;
#pragma unroll
        for (int ai = 0; ai < 2; ++ai)
#pragma unroll
            for (int m = 0; m < 4; ++m) {
                const int row = row0 + ai * HALF + m * 16; const float s = rs[row];
#pragma unroll
                for (int bj = 0; bj < 2; ++bj) { const f32x4 v0 = acc[ai][bj][m][0] * s, v1 = acc[ai][bj][m][1] * s;
                    u32x4 w; w.x = cvt_pk_bf16(v0[0], v0[1]); w.y = cvt_pk_bf16(v0[2], v0[3]); w.z = cvt_pk_bf16(v1[0], v1[1]); w.w = cvt_pk_bf16(v1[2], v1[3]);
                    *(u32x4*)((bj ? V2 : G2) + (size_t)row * FF + f0) = w; }
            }
    }
};
}

template <class Epi>
__device__ __forceinline__ void gemm_call(LAS unsigned char* lds, const bf16* A, const bf16* Bt, int M, int N, int K, const Epi& E, int G, int bid) {
    pg8::Gemm g{A, Bt, M, N, K}; pg8::StaticOrder S; S.init(M, N, G, bid);
    pg8::gemm_phase<Epi, pg8::StaticOrder, true, true>(lds, g, S, E);
}

__device__ __forceinline__ void transpose_item(const float* W, int K, int N, bf16* WT, const float* gain, int mode, int rot_limit, LAS float* scr, int item, int lane) {
    const int nblk = N / 32, kb = item / nblk, nb = item % nblk, k0 = 64 * kb, n0 = 32 * nb;
    int src0 = n0;
    if (mode == 1) { const int pn = n0 >> 8, bj = (n0 >> 7) & 1, i0 = n0 & 127; src0 = bj * FF + 128 * pn + i0; }
#pragma unroll 8
    for (int i = 0; i < 32; ++i) { const int kk = 2 * i + (lane >> 5); const float g = gain ? gain[k0 + kk] : 1.f; scr[kk * 33 + (lane & 31)] = W[(size_t)(k0 + kk) * N + src0 + (lane & 31)] * g; }
    LDS_WAIT(); asm volatile("" ::: "memory");
    const int c = lane & 7;
    const bool rot = (n0 < rot_limit) && ((n0 & 63) == 0);
#pragma unroll
    for (int j = 0; j < 4; ++j) { const int n = (lane >> 3) + 8 * j; const int sn = (rot && n < 16) ? ((n & 1) * 8 + (n >> 1)) : n; const LAS float* s = scr + (8 * c) * 33 + sn;
        v4u o; o.x = pk2(s[0 * 33], s[1 * 33]); o.y = pk2(s[2 * 33], s[3 * 33]); o.z = pk2(s[4 * 33], s[5 * 33]); o.w = pk2(s[6 * 33], s[7 * 33]);
        *(v4u*)(WT + (size_t)(n0 + n) * K + k0 + 8 * c) = o; }
    LDS_WAIT(); asm volatile("" ::: "memory");
}

__device__ __forceinline__ void ph_prologue(const Params& p, LAS unsigned char* lds, int G, int bid) {
    const int tid = threadIdx.x, lane = tid & 63, wave = tid >> 6;
    LAS float* scr = (LAS float*)(lds + wave * 16384);
    const int gw = bid * 8 + wave, NGW = G * 8;
    bf16* WB = (bf16*)(p.ws + WS_W);
    constexpr int I_RETIN = 16 * 192, I_RETOUT = 32 * 32, I_KV = 16 * 192, I_Q = 16 * 96, I_O = 16 * 32, I_UP = 16 * 176, I_DOWN = 44 * 32;
    constexpr int NITEMS = 2 * I_RETIN + 2 * I_RETOUT + I_KV + 2 * I_Q + 2 * I_O + 4 * I_UP + 4 * I_DOWN;
    for (int it = gw; it < NITEMS; it += NGW) {
        int r = it;
        if (r < 2 * I_RETIN) { const int l = r / I_RETIN; transpose_item(p.ret_w_in + (size_t)l * D * RET_IN, D, RET_IN, WB + W_RETIN + (size_t)l * RET_IN * D, p.n_mix_pre + l * D, 0, 0, scr, r % I_RETIN, lane); continue; } r -= 2 * I_RETIN;
        if (r < 2 * I_RETOUT) { const int l = r / I_RETOUT; transpose_item(p.ret_w_out + (size_t)l * 2048 * D, 2048, D, WB + W_RETOUT + (size_t)l * D * 2048, nullptr, 0, 0, scr, r % I_RETOUT, lane); continue; } r -= 2 * I_RETOUT;
        if (r < I_KV) { transpose_item(p.w_kv, D, KVW, WB + W_KV, p.kv_norm, 0, 3072, scr, r, lane); continue; } r -= I_KV;
        if (r < 2 * I_Q) { const int l = r / I_Q; transpose_item(p.w_q + (size_t)l * D * QW, D, QW, WB + W_Q + (size_t)l * QW * D, p.n_mix_pre + (2 + l) * D, 0, QW, scr, r % I_Q, lane); continue; } r -= 2 * I_Q;
        if (r < 2 * I_O) { const int l = r / I_O; transpose_item(p.w_o + (size_t)l * D * D, D, D, WB + W_O + (size_t)l * D * D, nullptr, 0, 0, scr, r % I_O, lane); continue; } r -= 2 * I_O;
        if (r < 4 * I_UP) { const int l = r / I_UP; transpose_item(p.w_up + (size_t)l * D * 2 * FF, D, 2 * FF, WB + W_UP + (size_t)l * 2 * FF * D, p.n_ffn_pre + l * D, 1, 0, scr, r % I_UP, lane); continue; } r -= 4 * I_UP;
        { const int l = r / I_DOWN; transpose_item(p.w_down + (size_t)l * FF * D, FF, D, WB + W_DOWN + (size_t)l * D * FF, nullptr, 0, 0, scr, r % I_DOWN, lane); }
    }
    float* rcos = (float*)(p.ws + WS_RCOS); float* rsin = (float*)(p.ws + WS_RSIN); float* acos_ = (float*)(p.ws + WS_ACOS); float* asin_ = (float*)(p.ws + WS_ASIN);
    const int gt = bid * 512 + tid, NGT = G * 512;
    for (int i = gt; i < 2048 * 128; i += NGT) { const int pos = i >> 7, j = i & 127;
        const float inv = (float)(1.0 / pow(10000.0, (double)j / 127.0)); const float ang = (float)pos * inv;
        rcos[i] = (float)cos((double)ang); rsin[i] = (float)sin((double)ang); }
    for (int i = gt; i < 2048 * 8; i += NGT) { const int pos = i >> 3, j = i & 7;
        const float inv = (float)pow(500000.0, -(double)(2 * j) / 16.0); const float ang = (float)pos * inv;
        acos_[i] = (float)cos((double)ang); asin_[i] = (float)sin((double)ang); }
    bf16* XB = (bf16*)(p.ws + WS_XB); float* RS = (float*)(p.ws + WS_RS);
    for (int m = gw; m < M_ALL; m += NGW) {
        const f32x4* xr = (const f32x4*)(p.x + (size_t)m * D) + lane; f32x4 v[4]; float s = 0.f;
#pragma unroll
        for (int j = 0; j < 4; ++j) { v[j] = xr[64 * j]; s += (v[j][0] * v[j][0] + v[j][1] * v[j][1]) + (v[j][2] * v[j][2] + v[j][3] * v[j][3]); }
        s = wave_sum(s);
        v2u* o = (v2u*)(XB + (size_t)m * D) + lane;
#pragma unroll
        for (int j = 0; j < 4; ++j) { v2u w; w.x = pk2(v[j][0], v[j][1]); w.y = pk2(v[j][2], v[j][3]); o[64 * j] = w; }
        if (lane == 0) RS[m] = 1.0f / sqrtf(s * (1.0f / D) + RMS_EPS);
    }
}

__device__ __forceinline__ void ph_thin(const Params& p, int half, const float* gpost, int G, int bid) {
    const int tid = threadIdx.x, lane = tid & 63, wave = tid >> 6, gw = bid * 8 + wave, NGW = G * 8;
    bf16* XB = (bf16*)(p.ws + WS_XB) + (size_t)half * MC * D; const bf16* MB = (const bf16*)(p.ws + WS_MB);
    float* RS = (float*)(p.ws + WS_RS) + half * MC;
    f32x4 g[4];
#pragma unroll
    for (int j = 0; j < 4; ++j) g[j] = ((const f32x4*)gpost)[lane + 64 * j];
    for (int m = gw; m < MC; m += NGW) {
        v2u* xp = (v2u*)(XB + (size_t)m * D) + lane; const v2u* mp = (const v2u*)(MB + (size_t)m * D) + lane; float s = 0.f;
        v2u mvv[4]; float sm = 0.f;
#pragma unroll
        for (int j = 0; j < 4; ++j) { mvv[j] = mp[64 * j]; const float a0 = bf2f(mvv[j].x & 0xffff), a1 = bf2f(mvv[j].x >> 16), a2 = bf2f(mvv[j].y & 0xffff), a3 = bf2f(mvv[j].y >> 16); sm += (a0 * a0 + a1 * a1) + (a2 * a2 + a3 * a3); }
        const float r = 1.0f / sqrtf(wave_sum(sm) * (1.0f / D) + RMS_EPS);
#pragma unroll
        for (int j = 0; j < 4; ++j) { const v2u xv = xp[64 * j], mv = mvv[j];
            const float x0 = bf2f(xv.x & 0xffff) + g[j][0] * r * bf2f(mv.x & 0xffff), x1 = bf2f(xv.x >> 16) + g[j][1] * r * bf2f(mv.x >> 16);
            const float x2 = bf2f(xv.y & 0xffff) + g[j][2] * r * bf2f(mv.y & 0xffff), x3 = bf2f(xv.y >> 16) + g[j][3] * r * bf2f(mv.y >> 16);
            v2u w; w.x = pk2(x0, x1); w.y = pk2(x2, x3); xp[64 * j] = w;
            const float y0 = bf2f(w.x & 0xffff), y1 = bf2f(w.x >> 16), y2 = bf2f(w.y & 0xffff), y3 = bf2f(w.y >> 16);
            s += (y0 * y0 + y1 * y1) + (y2 * y2 + y3 * y3); }
        s = wave_sum(s);
        if (lane == 0) RS[m] = 1.0f / sqrtf(s * (1.0f / D) + RMS_EPS);
    }
}
__device__ __forceinline__ void ph_final(const Params& p, int G, int bid) {
    const bf16* XB = (const bf16*)(p.ws + WS_XB); const size_t n4 = (size_t)M_ALL * D / 4;
    for (size_t i = (size_t)bid * 512 + threadIdx.x; i < n4; i += (size_t)G * 512) { const v2u w = ((const v2u*)XB)[i];
        f32x4 o; o[0] = bf2f(w.x & 0xffff); o[1] = bf2f(w.x >> 16); o[2] = bf2f(w.y & 0xffff); o[3] = bf2f(w.y >> 16); ((f32x4*)p.out)[i] = o; }
}

__device__ __forceinline__ void ph_rot_ret(const Params& p, int G, int bid) {
    bf16* Q = (bf16*)(p.ws + WS_BIG); const float* rc = (const float*)(p.ws + WS_RCOS); const float* rsn = (const float*)(p.ws + WS_RSIN);
    const size_t total = (size_t)MC * 8 * 128;
    for (size_t i = (size_t)bid * 512 + threadIdx.x; i < total; i += (size_t)G * 512) {
        const int j = (int)(i & 127), hh = (int)((i >> 7) & 7), row = (int)(i >> 10), pos = row & (SEQ - 1);
        const float c = rc[pos * 128 + j], s = rsn[pos * 128 + j]; const float sc = hh >= 4 ? 0.0625f : 1.0f;
        bf16* base = Q + (size_t)row * RET_IN + hh * 256 + j;
        const float t1 = bf2f(base[0]), t2 = bf2f(base[128]);
        base[0] = (bf16)f2bf((t1 * c - t2 * s) * sc); base[128] = (bf16)f2bf((t2 * c + t1 * s) * sc);
    }
}
__device__ __forceinline__ void ph_retention_naive(const Params& p, LAS unsigned char* lds, int G, int bid) {
    const int tid = threadIdx.x, lane = tid & 63, wave = tid >> 6;
    const bf16* QKV = (const bf16*)(p.ws + WS_BIG); bf16* Y = (bf16*)(p.ws + WS_Q);
    constexpr int TB = 32;
    LAS bf16* Lq = (LAS bf16*)lds;
    LAS bf16* Lk = (LAS bf16*)(lds + TB * 256 * 2);
    LAS bf16* Lv = (LAS bf16*)(lds + 2 * TB * 256 * 2);
    LAS float* Lp = (LAS float*)(lds + 2 * TB * 256 * 2 + TB * 64 * 2);
    for (int u = bid; u < 16 * 4 * 8; u += G) {
        const int sl = u & 7, h = (u >> 3) & 3, b = u >> 5;
        const float gamma = 1.0f - exp2f(-5.0f - (float)h);
        float S[32];
#pragma unroll
        for (int i = 0; i < 32; ++i) S[i] = 0.f;
        const size_t row0 = (size_t)b * SEQ;
        for (int t0 = 0; t0 < SEQ; t0 += TB) {
            __syncthreads();
            for (int c = tid; c < TB * 32; c += 512) { const int tt = c >> 5, cc = c & 31; const bf16* src = QKV + (row0 + t0 + tt) * RET_IN + h * 256 + cc * 8;
                *(LAS v4u*)(Lq + tt * 256 + cc * 8) = *(const v4u*)src; *(LAS v4u*)(Lk + tt * 256 + cc * 8) = *(const v4u*)(src + 1024); }
            for (int c = tid; c < TB * 8; c += 512) { const int tt = c >> 3, cc = c & 7; *(LAS v4u*)(Lv + tt * 64 + cc * 8) = *(const v4u*)(QKV + (row0 + t0 + tt) * RET_IN + 2048 + h * 512 + sl * 64 + cc * 8); }
            __syncthreads();
            for (int tt = 0; tt < TB; ++tt) {
                const float v = bf2f(Lv[tt * 64 + lane]); float acc = 0.f;
#pragma unroll
                for (int i8 = 0; i8 < 4; ++i8) { const v4u kq = *(LAS v4u*)(Lk + tt * 256 + wave * 32 + i8 * 8), qq = *(LAS v4u*)(Lq + tt * 256 + wave * 32 + i8 * 8);
#pragma unroll
                    for (int e = 0; e < 4; ++e) { const unsigned kw = kq[e], qw = qq[e];
                        S[i8 * 8 + 2 * e] = S[i8 * 8 + 2 * e] * gamma + __uint_as_float(kw << 16) * v; acc += __uint_as_float(qw << 16) * S[i8 * 8 + 2 * e];
                        S[i8 * 8 + 2 * e + 1] = S[i8 * 8 + 2 * e + 1] * gamma + __uint_as_float(kw & 0xffff0000u) * v; acc += __uint_as_float(qw & 0xffff0000u) * S[i8 * 8 + 2 * e + 1]; } }
                Lp[(tt * 8 + wave) * 64 + lane] = acc;
            }
            __syncthreads();
            for (int o = tid; o < TB * 64; o += 512) { const int tt = o >> 6, c = o & 63; float s = 0.f;
#pragma unroll
                for (int w = 0; w < 8; ++w) s += Lp[(tt * 8 + w) * 64 + c];
                Y[(row0 + t0 + tt) * 2048 + h * 512 + sl * 64 + c] = (bf16)f2bf(s); }
        }
    }
}
__device__ __forceinline__ void ph_gn_gate(const Params& p, int layer, int G, int bid) {
    const int tid = threadIdx.x, lane = tid & 63, wave = tid >> 6, gw = bid * 8 + wave, NGW = G * 8;
    const bf16* QKV = (const bf16*)(p.ws + WS_BIG); bf16* Y = (bf16*)(p.ws + WS_Q); const float* gn = p.ret_gn + layer * 2048;
    for (int i = gw; i < MC * 4; i += NGW) { const int row = i >> 2, h = i & 3;
        v4u* yp = (v4u*)(Y + (size_t)row * 2048 + h * 512) + lane; const v4u yv = *yp; const v4u gv = *((const v4u*)(QKV + (size_t)row * RET_IN + 4096 + h * 512) + lane);
        float y[8], g[8];
#pragma unroll
        for (int e = 0; e < 4; ++e) { y[2 * e] = __uint_as_float(yv[e] << 16); y[2 * e + 1] = __uint_as_float(yv[e] & 0xffff0000u); g[2 * e] = __uint_as_float(gv[e] << 16); g[2 * e + 1] = __uint_as_float(gv[e] & 0xffff0000u); }
        float s = 0.f;
#pragma unroll
        for (int e = 0; e < 8; ++e) s += y[e];
        const float mu = wave_sum(s) * (1.0f / 512.0f); float q = 0.f;
#pragma unroll
        for (int e = 0; e < 8; ++e) { y[e] -= mu; q += y[e] * y[e]; }
        const float rstd = 1.0f / sqrtf(wave_sum(q) * (1.0f / 512.0f) + GN_EPS);
        float o[8];
#pragma unroll
        for (int e = 0; e < 8; ++e) { const float gg = g[e]; const float sil = gg / (1.0f + __expf(-gg)); o[e] = sil * (y[e] * rstd * gn[h * 512 + lane * 8 + e]); }
        v4u w; w.x = pk2(o[0], o[1]); w.y = pk2(o[2], o[3]); w.z = pk2(o[4], o[5]); w.w = pk2(o[6], o[7]); *yp = w;
    }
}

__device__ __forceinline__ float gelu_tanh(float x) { const float u = 0.7978845608028654f * (x + 0.044715f * x * x * x); return 0.5f * x * (1.0f + tanhf(u)); }
__device__ __forceinline__ void ph_conv_act(const Params& p, int layer, int G, int bid) {
    const bf16* G2 = (const bf16*)p.out; bf16* V2 = (bf16*)(p.ws + WS_Q);
    const float* cw = p.conv_w + (size_t)layer * 3 * FF; const float* cb = p.conv_b + (size_t)layer * FF;
    const size_t total = (size_t)MC * (FF / 2);
    for (size_t i = (size_t)bid * 512 + threadIdx.x; i < total; i += (size_t)G * 512) {
        const int row = (int)(i / (FF / 2)), j = 2 * (int)(i % (FF / 2)), t = row & (SEQ - 1);
        const unsigned g0 = *(const unsigned*)(G2 + (size_t)row * FF + j);
        const unsigned g1 = t >= 1 ? *(const unsigned*)(G2 + (size_t)(row - 1) * FF + j) : 0u;
        const unsigned g2 = t >= 2 ? *(const unsigned*)(G2 + (size_t)(row - 2) * FF + j) : 0u;
        const unsigned vv = *(const unsigned*)(V2 + (size_t)row * FF + j);
        const float c0 = cb[j] + cw[j] * bf2f(g2 & 0xffff) + cw[FF + j] * bf2f(g1 & 0xffff) + cw[2 * FF + j] * bf2f(g0 & 0xffff);
        const float c1 = cb[j + 1] + cw[j + 1] * bf2f(g2 >> 16) + cw[FF + j + 1] * bf2f(g1 >> 16) + cw[2 * FF + j + 1] * bf2f(g0 >> 16);
        *(unsigned*)(V2 + (size_t)row * FF + j) = pk2(gelu_tanh(c0) * bf2f(vv & 0xffff), gelu_tanh(c1) * bf2f(vv >> 16));
    }
}

__device__ __forceinline__ void ph_rot_att(const Params& p, bf16* buf, int pitch, int nheads, int G, int bid) {
    const float* ac = (const float*)(p.ws + WS_ACOS); const float* as = (const float*)(p.ws + WS_ASIN);
    const size_t total = (size_t)MC * nheads * 8;
    for (size_t i = (size_t)bid * 512 + threadIdx.x; i < total; i += (size_t)G * 512) {
        const int j = (int)(i & 7); const size_t rh = i >> 3; const int hs = (int)(rh % nheads), row = (int)(rh / nheads), pos = row & (SEQ - 1);
        const float c = ac[pos * 8 + j], s = as[pos * 8 + j];
        unsigned* pp = (unsigned*)(buf + (size_t)row * pitch + hs * 64 + 2 * j); const unsigned w = *pp;
        const float t1 = bf2f(w & 0xffff), t2 = bf2f(w >> 16);
        *pp = pk2(t1 * c - t2 * s, t2 * c + t1 * s);
    }
}
__device__ __forceinline__ void ph_attn_naive(const Params& p, LAS unsigned char* lds, int G, int bid) {
    const int tid = threadIdx.x, lane = tid & 63, wave = tid >> 6, gw = bid * 8 + wave, NGW = G * 8;
    const bf16* Qb = (const bf16*)(p.ws + WS_Q); const bf16* KV = (const bf16*)(p.ws + WS_BIG); bf16* O = (bf16*)(p.ws + WS_O);
    LAS float* P = (LAS float*)lds + wave * 400;
    for (int task = gw; task < MC * 16; task += NGW) {
        const int row = task >> 4, h = task & 15, t = row & (SEQ - 1); const size_t brow = (size_t)(row - t);
        float sc[3][3]; float mx = -3.0e38f;
#pragma unroll
        for (int g = 0; g < 3; ++g) { const int dil = g == 0 ? 1 : (g == 1 ? 4 : 16);
            const v4u* qp = (const v4u*)(Qb + (size_t)row * QW + (g * 16 + h) * 64);
            v4u q[8];
#pragma unroll
            for (int c = 0; c < 8; ++c) q[c] = qp[c];
#pragma unroll
            for (int jj = 0; jj < 3; ++jj) { const int j = lane + 64 * jj; const int kp = t - j * dil; const bool valid = (j <= 128) && (kp >= 0);
                float s = -3.0e38f;
                if (valid) { const v4u* kptr = (const v4u*)(KV + (brow + kp) * KVW + (g * 16 + h) * 64); float a = 0.f;
#pragma unroll
                    for (int c = 0; c < 8; ++c) { const v4u kv = kptr[c];
#pragma unroll
                        for (int e = 0; e < 4; ++e) { a += __uint_as_float(kv[e] << 16) * __uint_as_float(q[c][e] << 16); a += __uint_as_float(kv[e] & 0xffff0000u) * __uint_as_float(q[c][e] & 0xffff0000u); } }
                    s = a * 0.125f; }
                sc[g][jj] = s; mx = fmaxf(mx, s); } }
        mx = wave_max(mx); float l = 0.f;
#pragma unroll
        for (int g = 0; g < 3; ++g)
#pragma unroll
            for (int jj = 0; jj < 3; ++jj) { const int j = lane + 64 * jj; const float e = sc[g][jj] > -1.0e38f ? __expf(sc[g][jj] - mx) : 0.f; l += e; if (j <= 128) P[g * 129 + j] = e; }
        l = wave_sum(l);
        LDS_WAIT(); __builtin_amdgcn_wave_barrier();
        float o = 0.f;
#pragma unroll
        for (int g = 0; g < 3; ++g) { const int dil = g == 0 ? 1 : (g == 1 ? 4 : 16); const int jmax = min(128, t / dil);
            const bf16* vb = KV + 3072 + (g * 16 + h) * 64 + lane;
#pragma unroll 4
            for (int j = 0; j <= jmax; ++j) o += P[g * 129 + j] * bf2f(vb[(brow + t - j * dil) * KVW]); }
        O[(size_t)row * D + h * 64 + lane] = (bf16)f2bf(o / l);
        LDS_WAIT(); __builtin_amdgcn_wave_barrier();
    }
}

enum { PH_PRO = 0, PH_G_RETIN, PH_ROT_RET, PH_RET, PH_GN, PH_G_RETOUT, PH_THIN, PH_G_UP, PH_CONV, PH_G_DOWN, PH_G_KV, PH_ROT_K, PH_G_Q, PH_ROT_Q, PH_ATT, PH_G_O, PH_FINAL };
constexpr int LDS_BYTES = 147456;
template <int PH> __global__ void __launch_bounds__(512, 2) k_phase(Params p, int half, int layer, int sub) {
    extern __shared__ __attribute__((aligned(16))) unsigned char lds_raw[];
    LAS unsigned char* lds = (LAS unsigned char*)lds_raw;
    const int G = gridDim.x, bid = blockIdx.x;
    bf16* WB = (bf16*)(p.ws + WS_W); const bf16* XBh = (const bf16*)(p.ws + WS_XB) + (size_t)half * MC * D;
    const float* RSh = (const float*)(p.ws + WS_RS) + half * MC;
    if constexpr (PH == PH_PRO) ph_prologue(p, lds, G, bid);
    if constexpr (PH == PH_G_RETIN) { pg8::EpiRS E{(bf16*)(p.ws + WS_BIG), RSh, nullptr, RET_IN, 0}; gemm_call(lds, XBh, WB + W_RETIN + (size_t)layer * RET_IN * D, MC, RET_IN, D, E, G, bid); }
    if constexpr (PH == PH_ROT_RET) ph_rot_ret(p, G, bid);
    if constexpr (PH == PH_RET) ph_retention_naive(p, lds, G, bid);
    if constexpr (PH == PH_GN) ph_gn_gate(p, layer, G, bid);
    if constexpr (PH == PH_G_RETOUT) { pg8::EpiRS E{(bf16*)(p.ws + WS_MB), nullptr, nullptr, D, 0}; gemm_call(lds, (const bf16*)(p.ws + WS_Q), WB + W_RETOUT + (size_t)layer * D * 2048, MC, D, 2048, E, G, bid); }
    if constexpr (PH == PH_THIN) ph_thin(p, half, (sub ? p.n_ffn_post : p.n_mix_post) + layer * D, G, bid);
    if constexpr (PH == PH_G_UP) { pg8::EpiUp E{(bf16*)p.out, (bf16*)(p.ws + WS_Q), RSh}; gemm_call(lds, XBh, WB + W_UP + (size_t)layer * 2 * FF * D, MC, 2 * FF, D, E, G, bid); }
    if constexpr (PH == PH_CONV) ph_conv_act(p, layer, G, bid);
    if constexpr (PH == PH_G_DOWN) { pg8::EpiRS E{(bf16*)(p.ws + WS_MB), nullptr, nullptr, D, 0}; gemm_call(lds, (const bf16*)(p.ws + WS_Q), WB + W_DOWN + (size_t)layer * D * FF, MC, D, FF, E, G, bid); }
    if constexpr (PH == PH_G_KV) { pg8::EpiRS E{(bf16*)(p.ws + WS_BIG), RSh, nullptr, KVW, 0}; gemm_call(lds, XBh, WB + W_KV, MC, KVW, D, E, G, bid); }
    if constexpr (PH == PH_ROT_K) ph_rot_att(p, (bf16*)(p.ws + WS_BIG), KVW, 48, G, bid);
    if constexpr (PH == PH_G_Q) { pg8::EpiRS E{(bf16*)(p.ws + WS_Q), RSh, nullptr, QW, 0}; gemm_call(lds, XBh, WB + W_Q + (size_t)(layer - 2) * QW * D, MC, QW, D, E, G, bid); }
    if constexpr (PH == PH_ROT_Q) ph_rot_att(p, (bf16*)(p.ws + WS_Q), QW, 48, G, bid);
    if constexpr (PH == PH_ATT) ph_attn_naive(p, lds, G, bid);
    if constexpr (PH == PH_G_O) { pg8::EpiRS E{(bf16*)(p.ws + WS_MB), nullptr, nullptr, D, 0}; gemm_call(lds, (const bf16*)(p.ws + WS_O), WB + W_O + (size_t)(layer - 2) * D * D, MC, D, D, E, G, bid); }
    if constexpr (PH == PH_FINAL) ph_final(p, G, bid);
}

template <int PH> static void launch_phase(const Params& p, int half, int layer, int sub, hipStream_t stream) {
    static bool attr = false;
    if (!attr) { (void)hipFuncSetAttribute((const void*)k_phase<PH>, hipFuncAttributeMaxDynamicSharedMemorySize, LDS_BYTES); attr = true; }
    hipLaunchKernelGGL((k_phase<PH>), dim3(256), dim3(512), LDS_BYTES, stream, p, half, layer, sub);
}

extern "C" void kernel_launch(void* const* d_in, const int* in_sizes, int n_in, void* d_out, int out_size, void* d_ws, size_t ws_size, hipStream_t stream) {
    if (n_in != 16 || in_sizes[0] != M_ALL * D || out_size != M_ALL * D || ws_size < WS_END) {
        fprintf(stderr, "kernel_launch: unexpected shapes: n_in %d in0 %d out %d ws %zu (need %zu)\n", n_in, n_in > 0 ? in_sizes[0] : -1, out_size, ws_size, (size_t)WS_END); return; }
    Params p{};
    p.x = (const float*)d_in[0]; p.ret_w_in = (const float*)d_in[1]; p.ret_w_out = (const float*)d_in[2]; p.ret_gn = (const float*)d_in[3]; p.kv_norm = (const float*)d_in[4];
    p.w_kv = (const float*)d_in[5]; p.w_q = (const float*)d_in[6]; p.w_o = (const float*)d_in[7]; p.n_mix_pre = (const float*)d_in[8]; p.n_mix_post = (const float*)d_in[9];
    p.n_ffn_pre = (const float*)d_in[10]; p.n_ffn_post = (const float*)d_in[11]; p.w_up = (const float*)d_in[12]; p.conv_w = (const float*)d_in[13]; p.conv_b = (const float*)d_in[14]; p.w_down = (const float*)d_in[15];
    p.out = (float*)d_out; p.ws = (unsigned char*)d_ws;
    (void)hipMemsetAsync((char*)d_ws + WS_CTL, 0, CTL_ZERO_BYTES, stream);
    launch_phase<PH_PRO>(p, 0, 0, 0, stream);
    for (int half = 0; half < 2; ++half) {
        for (int l = 0; l < 2; ++l) {
            launch_phase<PH_G_RETIN>(p, half, l, 0, stream);
            launch_phase<PH_ROT_RET>(p, half, l, 0, stream);
            launch_phase<PH_RET>(p, half, l, 0, stream);
            launch_phase<PH_GN>(p, half, l, 0, stream);
            launch_phase<PH_G_RETOUT>(p, half, l, 0, stream);
            launch_phase<PH_THIN>(p, half, l, 0, stream);
            launch_phase<PH_G_UP>(p, half, l, 0, stream);
            launch_phase<PH_CONV>(p, half, l, 0, stream);
            launch_phase<PH_G_DOWN>(p, half, l, 0, stream);
            launch_phase<PH_THIN>(p, half, l, 1, stream);
        }
        launch_phase<PH_G_KV>(p, half, 0, 0, stream);
        launch_phase<PH_ROT_K>(p, half, 0, 0, stream);
        for (int l = 2; l < 4; ++l) {
            launch_phase<PH_G_Q>(p, half, l, 0, stream);
            launch_phase<PH_ROT_Q>(p, half, l, 0, stream);
            launch_phase<PH_ATT>(p, half, l, 0, stream);
            launch_phase<PH_G_O>(p, half, l, 0, stream);
            launch_phase<PH_THIN>(p, half, l, 0, stream);
            launch_phase<PH_G_UP>(p, half, l, 0, stream);
            launch_phase<PH_CONV>(p, half, l, 0, stream);
            launch_phase<PH_G_DOWN>(p, half, l, 0, stream);
            launch_phase<PH_THIN>(p, half, l, 1, stream);
        }
    }
    launch_phase<PH_FINAL>(p, 0, 0, 0, stream);
}
```

```cpp
#include <hip/hip_runtime.h>
#include <cstdio>
#include <cstdint>
__device__ __forceinline__ int otid(int wv) { int l; asm volatile("v_mbcnt_lo_u32_b32 %0, -1, 0\n\tv_mbcnt_hi_u32_b32 %0, -1, %0" : "=v"(l)); return (wv << 6) | l; }
namespace pg8 {
#define PG8_LAS __attribute__((address_space(3)))
typedef unsigned short bf16_t;
typedef short bf16x8 __attribute__((ext_vector_type(8)));
typedef float f32x4 __attribute__((ext_vector_type(4)));
typedef unsigned u32x4 __attribute__((ext_vector_type(4)));
constexpr int BM = 256, BK = 64, HALF = 128, HTB = HALF * BK * 2  , STAGE_BYTES = 8 * HTB, NXCD = 8, WGM = 8;

__host__ __device__ __forceinline__ int lds_byte(int r, int c) { const int st = (r >> 4) * 2 + (c >> 5), rr = r & 15, cc = c & 31, ob = rr * 64 + cc * 2; return st * 1024 + (ob ^ (((ob >> 9) & 1) << 5)); }
__host__ __device__ __forceinline__ void stage_rc(int b, int& R, int& C) { const int st = b / 1024, sb = b % 1024, swz = sb ^ (((sb >> 9) & 1) << 5); R = (st >> 1) * 16 + swz / 64; C = (st & 1) * 32 + (swz % 64) / 2; }
__host__ __device__ __forceinline__ int perm32(int rho) { const int n = rho >> 4, i = rho & 15; return 8 * (i >> 2) + 4 * n + (i & 3); }

struct Unit { int pm, pn; };
struct Gemm { const bf16_t* A; const bf16_t* Bt; int M, N, K; };

struct StaticOrder {
    int nM, nN, nwg, G, c;
    __host__ __device__ void init(int M, int N, int G_, int c_) { nM = M / BM; nN = N / BM; nwg = nM * nN; G = G_; c = c_; }
    __host__ __device__ bool next(int i, Unit& u) const {
        const long L = (long)i * G + c; if (L >= nwg) return false;
        int wgid = (int)L; { const int q = nwg / NXCD, r = nwg % NXCD, xcd = wgid % NXCD, off = wgid / NXCD; wgid = (xcd < r ? xcd * (q + 1) : r * (q + 1) + (xcd - r) * q) + off; }
        const int nig = WGM * nN, gid = wgid / nig, fm = gid * WGM, gsz = (nM - fm) < WGM ? (nM - fm) : WGM;
        u.pm = fm + ((wgid % nig) % gsz); u.pn = (wgid % nig) / gsz; return true;
    }
    __device__ __forceinline__ void a_ready(const Unit&) const {}
    __device__ __forceinline__ void done(const Unit&) const {}
};
typedef float cvt_f32x2 __attribute__((ext_vector_type(2))); typedef __bf16 cvt_bf16x2 __attribute__((ext_vector_type(2)));
__device__ __forceinline__ unsigned cvt_pk_bf16(float lo, float hi) { const cvt_f32x2 v = {lo, hi}; return __builtin_bit_cast(unsigned, __builtin_convertvector(v, cvt_bf16x2)); }
typedef int i32x4 __attribute__((ext_vector_type(4)));
typedef int i32x8 __attribute__((ext_vector_type(8)));
__device__ __forceinline__ i32x8 cat8(bf16x8 a, bf16x8 b) { const i32x4 x = __builtin_bit_cast(i32x4, a), y = __builtin_bit_cast(i32x4, b); return __builtin_shufflevector(x, y, 0, 1, 2, 3, 4, 5, 6, 7); }
template <class Epi, class Sched, bool ALIGN_EPI = false, bool SP2 = false, int QM = 0>
__device__ __forceinline__ void gemm_phase(PG8_LAS unsigned char* lds, const Gemm g, const Sched& S, const Epi& E, int wv) {
    const int tid = otid(wv), wid = __builtin_amdgcn_readfirstlane(tid >> 6), lane = tid & 63, wr = wid >> 2, wc = wid & 3, fr = lane & 15, fq = lane >> 4;
    constexpr bool F8 = (QM == 1), I8 = (QM == 2); const int K = g.K, KB = (QM != 0) ? K : 2 * K  , nt = KB / (BK * 2);
    unsigned voffA[2], voffB[2];
#pragma unroll
    for (int i = 0; i < 2; ++i) { int R, C; stage_rc(tid * 16 + i * 8192, R, C); const int Rb = Epi::PERM ? ((R & ~31) + perm32(R & 31)) : R;
        voffA[i] = (unsigned)(R * KB + C * 2); voffB[i] = (unsigned)(Rb * KB + C * 2); }
    const size_t kstep = (size_t)(BK * 2);
    const size_t hstep = (size_t)HALF * KB;
    const size_t tstep = 2 * hstep;
    const unsigned ldsw = (unsigned)wid * 1024u;
    const int aoff = lds_byte(wr * 64 + fr, fq * 8), boff = lds_byte(wc * 32 + fr, fq * 8);
#define PG8_SA(b, h) (((b) * 2 + (h)) * HTB)
#define PG8_SB(b, h) ((4 + (b) * 2 + (h)) * HTB)
#define PG8_STAGE(bufoff, gbase, voff) do { const char* _gb = (const char*)(gbase); asm volatile("" : "+s"(_gb));   \
        _Pragma("unroll") for (int _i = 0; _i < 2; ++_i) \
        __builtin_amdgcn_global_load_lds((const unsigned*)(_gb + (voff)[_i]), (PG8_LAS unsigned*)(lds + (bufoff) + ldsw + _i * 8192), 16, 0, 0); } while (0)
#define PG8_LDA(dst, b, h) do { _Pragma("unroll") for (int m = 0; m < 4; ++m) _Pragma("unroll") for (int k = 0; k < 2; ++k) dst[m][k] = *(const PG8_LAS bf16x8*)(lds + PG8_SA(b, h) + aoff + m * 2048 + k * 1024); } while (0)
#define PG8_LDB(dst, b, h) do { _Pragma("unroll") for (int n = 0; n < 2; ++n) _Pragma("unroll") for (int k = 0; k < 2; ++k) dst[n][k] = *(const PG8_LAS bf16x8*)(lds + PG8_SB(b, h) + boff + n * 2048 + k * 1024); } while (0)
#define PG8_MMA(ai, bj, At, Bt) do { __builtin_amdgcn_s_setprio(1); _Pragma("unroll") for (int m = 0; m < 4; ++m) _Pragma("unroll") for (int n = 0; n < 2; ++n) { \
        if constexpr (F8) acc[ai][bj][m][n] = __builtin_amdgcn_mfma_scale_f32_16x16x128_f8f6f4(cat8(Bt[n][0], Bt[n][1]), cat8(At[m][0], At[m][1]), acc[ai][bj][m][n], 0, 0, 0, 0, 0, 0); \
        else if constexpr (I8) { _Pragma("unroll") for (int k = 0; k < 2; ++k) acc[ai][bj][m][n] = __builtin_bit_cast(f32x4, __builtin_amdgcn_mfma_i32_16x16x64_i8(__builtin_bit_cast(i32x4, Bt[n][k]), __builtin_bit_cast(i32x4, At[m][k]), __builtin_bit_cast(i32x4, acc[ai][bj][m][n]), 0, 0, 0)); } \
        else { _Pragma("unroll") for (int k = 0; k < 2; ++k) acc[ai][bj][m][n] = __builtin_amdgcn_mfma_f32_16x16x32_bf16(Bt[n][k], At[m][k], acc[ai][bj][m][n], 0, 0, 0); } } \
        __builtin_amdgcn_s_setprio(0); } while (0)
#define PG8_WAIT_V(n) asm volatile("s_waitcnt vmcnt(" #n ")" ::: "memory")
#define PG8_WAIT_L(n) asm volatile("s_waitcnt lgkmcnt(" #n ")" ::: "memory")
#define PG8_BAR __builtin_amdgcn_s_barrier()
#define PG8_SCHED __builtin_amdgcn_sched_barrier(0)
    Unit cur, nxt; int ui = 0;
    if (!S.next(0, cur)) return;
    const char* cA = (const char*)g.A + (size_t)cur.pm * tstep; const char* cB = (const char*)g.Bt + (size_t)cur.pn * tstep;
    S.a_ready(cur);
    if constexpr (SP2) {
        PG8_STAGE(PG8_SB(0, 0), cB, voffB); PG8_STAGE(PG8_SB(0, 1), cB + hstep, voffB); PG8_STAGE(PG8_SA(0, 0), cA, voffA); PG8_STAGE(PG8_SA(0, 1), cA + hstep, voffA);
        if (wr == 1) PG8_BAR;
        PG8_WAIT_V(2); PG8_BAR;
        PG8_STAGE(PG8_SB(1, 0), cB + kstep, voffB); PG8_STAGE(PG8_SA(1, 0), cA + kstep, voffA); PG8_STAGE(PG8_SB(1, 1), cB + hstep + kstep, voffB);
        PG8_WAIT_V(6); PG8_BAR;
    } else {
        PG8_STAGE(PG8_SB(0, 0), cB, voffB); PG8_STAGE(PG8_SA(0, 0), cA, voffA); PG8_STAGE(PG8_SB(0, 1), cB + hstep, voffB); PG8_STAGE(PG8_SA(0, 1), cA + hstep, voffA);
        if (wr == 1) PG8_BAR;
        PG8_WAIT_V(4); PG8_BAR;
        PG8_STAGE(PG8_SB(1, 0), cB + kstep, voffB); PG8_STAGE(PG8_SA(1, 0), cA + kstep, voffA); PG8_STAGE(PG8_SB(1, 1), cB + hstep + kstep, voffB);
        PG8_WAIT_V(6); PG8_BAR;
    }
    if constexpr (F8) {
        const int tid2 = otid(wv);
#pragma unroll
        for (int i = 0; i < 2; ++i) { int R, C; stage_rc(tid2 * 16 + i * 8192, R, C); const int Rb = Epi::PERM ? ((R & ~31) + perm32(R & 31)) : R;
            voffA[i] = (unsigned)(R * KB + C * 2); voffB[i] = (unsigned)(Rb * KB + C * 2); }
    }
    f32x4 acc[2][2][4][2];
#pragma unroll
    for (int a = 0; a < 2; ++a)
#pragma unroll
        for (int b = 0; b < 2; ++b)
#pragma unroll
            for (int m = 0; m < 4; ++m)
#pragma unroll
                for (int n = 0; n < 2; ++n) acc[a][b][m][n] = (f32x4){0.f, 0.f, 0.f, 0.f};
    bf16x8 At[4][2], B0[2][2], B1[2][2];
    for (;;) {
        const bool has_next = S.next(ui + 1, nxt);
        const char* nA = has_next ? (const char*)g.A + (size_t)nxt.pm * tstep : cA; const char* nB = has_next ? (const char*)g.Bt + (size_t)nxt.pn * tstep : cB;
        for (int t = 0; t < nt; t += 2) {
            const bool last = (t == nt - 2);
            const char* a1 = cA + (size_t)(t + 1) * kstep;
            const char* a2 = last ? nA : cA + (size_t)(t + 2) * kstep; const char* b2 = last ? nB : cB + (size_t)(t + 2) * kstep;
            const char* a3 = a2 + kstep; const char* b3 = b2 + kstep;
            if (last && has_next) S.a_ready(nxt);
            if constexpr (SP2) {
            PG8_LDB(B0, 0, 0); PG8_LDB(B1, 0, 1); PG8_SCHED; PG8_LDA(At, 0, 0); PG8_STAGE(PG8_SA(1, 1), a1 + hstep, voffA);
            PG8_WAIT_V(8); PG8_WAIT_L(0); PG8_BAR; PG8_MMA(0, 0, At, B0); PG8_MMA(0, 1, At, B1); PG8_BAR; PG8_SCHED;
            PG8_LDA(At, 0, 1); PG8_STAGE(PG8_SB(0, 0), b2, voffB); PG8_STAGE(PG8_SB(0, 1), b2 + hstep, voffB); PG8_STAGE(PG8_SA(0, 0), a2, voffA);
            PG8_WAIT_V(8); PG8_WAIT_L(0); PG8_BAR; PG8_MMA(1, 0, At, B0); PG8_MMA(1, 1, At, B1); PG8_BAR; PG8_SCHED;
            PG8_LDB(B0, 1, 0); PG8_LDB(B1, 1, 1); PG8_SCHED; PG8_LDA(At, 1, 0); PG8_STAGE(PG8_SA(0, 1), a2 + hstep, voffA);
            PG8_WAIT_V(8); PG8_WAIT_L(0); PG8_BAR; PG8_MMA(0, 0, At, B0); PG8_MMA(0, 1, At, B1); PG8_BAR; PG8_SCHED;
            PG8_LDA(At, 1, 1); PG8_STAGE(PG8_SB(1, 0), b3, voffB); PG8_STAGE(PG8_SB(1, 1), b3 + hstep, voffB); PG8_STAGE(PG8_SA(1, 0), a3, voffA);
            PG8_WAIT_V(8); PG8_WAIT_L(0); PG8_BAR; PG8_MMA(1, 0, At, B0); PG8_MMA(1, 1, At, B1); PG8_BAR; PG8_SCHED;
            } else {
            PG8_LDB(B0, 0, 0); PG8_SCHED; PG8_LDA(At, 0, 0); PG8_STAGE(PG8_SA(1, 1), a1 + hstep, voffA);
            PG8_WAIT_L(8); PG8_BAR; PG8_WAIT_L(0); PG8_MMA(0, 0, At, B0); PG8_BAR; PG8_SCHED;
            PG8_LDB(B1, 0, 1); PG8_STAGE(PG8_SB(0, 0), b2, voffB);
            PG8_BAR; PG8_WAIT_L(0); PG8_MMA(0, 1, At, B1); PG8_BAR;
            PG8_LDA(At, 0, 1); PG8_STAGE(PG8_SA(0, 0), a2, voffA);
            PG8_BAR; PG8_WAIT_L(0); PG8_MMA(1, 0, At, B0); PG8_BAR; PG8_SCHED;
            PG8_STAGE(PG8_SB(0, 1), b2 + hstep, voffB);
            PG8_WAIT_V(6); PG8_BAR; PG8_MMA(1, 1, At, B1); PG8_BAR;
            PG8_LDB(B0, 1, 0); PG8_SCHED; PG8_LDA(At, 1, 0); PG8_STAGE(PG8_SA(0, 1), a2 + hstep, voffA);
            PG8_WAIT_L(8); PG8_BAR; PG8_WAIT_L(0); PG8_MMA(0, 0, At, B0); PG8_BAR; PG8_SCHED;
            PG8_LDB(B1, 1, 1); PG8_STAGE(PG8_SB(1, 0), b3, voffB);
            PG8_BAR; PG8_WAIT_L(0); PG8_MMA(0, 1, At, B1); PG8_BAR;
            PG8_LDA(At, 1, 1); PG8_STAGE(PG8_SA(1, 0), a3, voffA);
            PG8_BAR; PG8_WAIT_L(0); PG8_MMA(1, 0, At, B0); PG8_BAR; PG8_SCHED;
            PG8_STAGE(PG8_SB(1, 1), b3 + hstep, voffB);
            PG8_WAIT_V(6); PG8_BAR; PG8_MMA(1, 1, At, B1); PG8_BAR;
            }
        }
        if constexpr (ALIGN_EPI) { if (wr == 0) PG8_BAR; }
        if constexpr (!Epi::AFTER_DRAIN) { E(acc, cur, wr, wc, fr, fq); S.done(cur); }
        if (!has_next) break;
#pragma unroll
        for (int a = 0; a < 2; ++a)
#pragma unroll
            for (int b = 0; b < 2; ++b)
#pragma unroll
                for (int m = 0; m < 4; ++m)
#pragma unroll
                    for (int n = 0; n < 2; ++n) acc[a][b][m][n] = (f32x4){0.f, 0.f, 0.f, 0.f};
        cur = nxt; cA = nA; cB = nB; ++ui;
        if constexpr (ALIGN_EPI) { if (wr == 1) PG8_BAR; }
    }
    PG8_WAIT_V(0);
    if constexpr (!ALIGN_EPI) { if (wr == 0) PG8_BAR; }
    PG8_BAR;
    if constexpr (Epi::AFTER_DRAIN) { E.fused(acc, cur, wr, wc, fr, fq, lds, wid, lane); S.done(cur); }
#undef PG8_SA
#undef PG8_SB
#undef PG8_STAGE
#undef PG8_LDA
#undef PG8_LDB
#undef PG8_MMA
#undef PG8_WAIT_V
#undef PG8_WAIT_L
#undef PG8_BAR
#undef PG8_SCHED
}
}
#define LAS __attribute__((address_space(3)))
#define XB_TMO      128
#define XB_XCNT(j)  (256  + 64 * (j))
#define XB_XSUB(j)  (1280 + 64 * (j))
#define XB_XGEN(j)  (2304 + 64 * (j))
#define XB_TOP      3328
#define XB_TOPGEN   3392
#define XCD_BAR_WORDS 3456
#define XB_SPIN_CAP (1u << 18)

__device__ __forceinline__ unsigned xb_ld(unsigned* p)              { return __hip_atomic_load(p, __ATOMIC_RELAXED, __HIP_MEMORY_SCOPE_AGENT); }
__device__ __forceinline__ unsigned xb_add(unsigned* p, unsigned v) { return __hip_atomic_fetch_add(p, v, __ATOMIC_RELAXED, __HIP_MEMORY_SCOPE_AGENT); }
__device__ __forceinline__ unsigned xb_xcc_id() { return (unsigned)__builtin_amdgcn_s_getreg((3 << 11) | 20) & 0xFu; }
#define XB_SPIN(cond, bar) do { unsigned _sp = 0; while (cond) { __builtin_amdgcn_s_sleep(1); \
    if ((++_sp & 255u) == 0u) { if (xb_ld(&(bar)[XB_TMO])) break; if (_sp > XB_SPIN_CAP) { atomicAdd(&(bar)[XB_TMO], 1u); break; } } } } while (0)

struct XcdBarrier {
    int wv;
    unsigned* bar; unsigned x;
    volatile LAS unsigned* st;
};

__device__ __forceinline__ XcdBarrier xcd_barrier_post(unsigned* bar, volatile LAS unsigned* st, int wv) {
    XcdBarrier b; b.wv = wv; b.bar = bar; b.x = xb_xcc_id(); b.st = st;
    if (otid(wv) == 0) (void)xb_add(&bar[XB_XCNT(b.x)], 1u);
    return b;
}
__device__ __forceinline__ void xcd_barrier_complete(unsigned* bar, unsigned x, unsigned& nloc, unsigned& nx) {
    const unsigned G = gridDim.x * gridDim.y * gridDim.z;
    unsigned sum, cnt, mine, sp = 0u;
    for (;;) {
        sum = 0u; cnt = 0u; mine = 0u;
#pragma unroll
        for (unsigned j = 0; j < 16; ++j) { const unsigned c = xb_ld(&bar[XB_XCNT(j)]); sum += c; cnt += (c > 0u) ? 1u : 0u; mine = (j == x) ? c : mine; }
        if (sum == G) break;
        __builtin_amdgcn_s_sleep(1);
        if ((++sp & 255u) == 0u) { if (xb_ld(&bar[XB_TMO])) break; if (sp > XB_SPIN_CAP) { atomicAdd(&bar[XB_TMO], 1u); break; } }
    }
    nloc = mine > 0u ? mine : 1u; nx = cnt > 0u ? cnt : 1u;
}

__device__ __forceinline__ void xcd_barrier(const XcdBarrier& b) {
    asm volatile("s_waitcnt vmcnt(0)" ::: "memory");
    __syncthreads();
    if (otid(b.wv) == 0) {
        unsigned* bar = b.bar;
        __builtin_amdgcn_s_waitcnt(0);
        unsigned nloc = b.st[0], nx = b.st[1];
        if (nloc == 0u) { xcd_barrier_complete(bar, b.x, nloc, nx); b.st[0] = nloc; b.st[1] = nx; }
        const unsigned old = xb_add(&bar[XB_XSUB(b.x)], 1u);
        const unsigned gen = old / nloc;
        if (old + 1u == (gen + 1u) * nloc) {
            __builtin_amdgcn_fence(__ATOMIC_RELEASE, "agent");
            asm volatile("s_waitcnt vmcnt(0)" ::: "memory");
            const unsigned og = xb_add(&bar[XB_TOP], 1u);
            const unsigned tg = og / nx;
            if (og + 1u == (tg + 1u) * nx) xb_add(&bar[XB_TOPGEN], 1u);
            else XB_SPIN(xb_ld(&bar[XB_TOPGEN]) == tg, bar);
            __builtin_amdgcn_fence(__ATOMIC_ACQUIRE, "agent");
            xb_add(&bar[XB_XGEN(b.x)], 1u);
            asm volatile("s_waitcnt vmcnt(0)" ::: "memory");
        } else {
            XB_SPIN(xb_ld(&bar[XB_XGEN(b.x)]) == gen, bar);
            __builtin_amdgcn_fence(__ATOMIC_ACQUIRE, "agent");
            asm volatile("s_waitcnt vmcnt(0)" ::: "memory");
        }
    }
    __syncthreads();
}


typedef unsigned short bf16;
typedef unsigned v4u __attribute__((ext_vector_type(4)));
typedef unsigned v2u __attribute__((ext_vector_type(2)));
typedef float f32x4 __attribute__((ext_vector_type(4)));

constexpr int D = 1024, SEQ = 2048, NBATCH = 32, M_ALL = NBATCH * SEQ;
constexpr int MC = M_ALL / 2;
constexpr int FF = 2816, RET_IN = 6144, QW = 3072, KVW = 6144;
constexpr float RMS_EPS = 1e-6f, GN_EPS = 1e-6f;
constexpr size_t MiB = 1u << 20;
constexpr size_t WS_CTL = 0;
constexpr size_t WS_RCOS = 1 * MiB, WS_RSIN = 2 * MiB;
constexpr size_t WS_ACOS = 3 * MiB, WS_ASIN = 3 * MiB + 65536;
constexpr size_t WS_RS = 3 * MiB + 512 * 1024;
constexpr size_t WS_SA = 3 * MiB + 768 * 1024;
constexpr size_t WS_WSC = 65536;
constexpr int WSC_KV = 4 * 2 * 2816, WSC_Q = WSC_KV + 6144, WSC_RET = WSC_Q + 2 * 3072;
constexpr size_t WS_W = 4 * MiB;
constexpr size_t W_RETIN = 0, W_RETOUT = W_RETIN + 2ull * RET_IN * D, W_KV = W_RETOUT + 2ull * D * 2048, W_Q = W_KV + (size_t)KVW * D,
                 W_O = W_Q + 2ull * QW * D, W_UP = W_O + 2ull * D * D, W_DOWN = W_UP + 4ull * 2 * FF * D, W_END = W_DOWN + 4ull * D * FF;
static_assert(W_END * 2 <= 127 * MiB, "weights");
constexpr size_t WS_XB = 132 * MiB;
constexpr size_t WS_GS = 260 * MiB;
constexpr size_t WS_BIG = 264 * MiB;
constexpr size_t WS_Q = 648 * MiB;
constexpr size_t WS_MBF = 776 * MiB;
constexpr size_t WS_O = 840 * MiB;
constexpr size_t WS_MB = 904 * MiB;
constexpr size_t WS_HALO = 968 * MiB;
constexpr size_t WS_P0 = 986 * MiB;
constexpr size_t WS_END = 1002 * MiB;
constexpr int RQP = 4096;

struct Params {
    const float* x; const float* ret_w_in; const float* ret_w_out; const float* ret_gn; const float* kv_norm; const float* w_kv; const float* w_q; const float* w_o;
    const float* n_mix_pre; const float* n_mix_post; const float* n_ffn_pre; const float* n_ffn_post; const float* w_up; const float* conv_w; const float* conv_b; const float* w_down;
    float* out; unsigned char* ws;
};

__device__ __forceinline__ float bf2f(unsigned short b) { return __uint_as_float(((unsigned)b) << 16); }
__device__ __forceinline__ unsigned f2bf(float f) { unsigned u = __float_as_uint(f); return (u + 0x7fffu + ((u >> 16) & 1u)) >> 16; }
__device__ __forceinline__ unsigned pk2(float lo, float hi) { return f2bf(lo) | (f2bf(hi) << 16); }
__device__ __forceinline__ float dpp_add(float v, int ctrl_sel) {
    int r;
    if (ctrl_sel == 0) r = __builtin_amdgcn_update_dpp(0, __builtin_bit_cast(int, v), 0xB1, 0xF, 0xF, false);
    else if (ctrl_sel == 1) r = __builtin_amdgcn_update_dpp(0, __builtin_bit_cast(int, v), 0x4E, 0xF, 0xF, false);
    else if (ctrl_sel == 2) r = __builtin_amdgcn_update_dpp(0, __builtin_bit_cast(int, v), 0x141, 0xF, 0xF, false);
    else r = __builtin_amdgcn_update_dpp(0, __builtin_bit_cast(int, v), 0x140, 0xF, 0xF, false);
    return v + __builtin_bit_cast(float, r);
}
__device__ __forceinline__ float wave_max(float v) {
    v = fmaxf(v, __builtin_bit_cast(float, __builtin_amdgcn_update_dpp(0, __builtin_bit_cast(int, v), 0xB1, 0xF, 0xF, false)));
    v = fmaxf(v, __builtin_bit_cast(float, __builtin_amdgcn_update_dpp(0, __builtin_bit_cast(int, v), 0x4E, 0xF, 0xF, false)));
    v = fmaxf(v, __builtin_bit_cast(float, __builtin_amdgcn_update_dpp(0, __builtin_bit_cast(int, v), 0x141, 0xF, 0xF, false)));
    v = fmaxf(v, __builtin_bit_cast(float, __builtin_amdgcn_update_dpp(0, __builtin_bit_cast(int, v), 0x140, 0xF, 0xF, false)));
    { const unsigned u = __builtin_bit_cast(unsigned, v); auto r = __builtin_amdgcn_permlane16_swap(u, u, false, false); v = fmaxf(__builtin_bit_cast(float, (unsigned)r[0]), __builtin_bit_cast(float, (unsigned)r[1])); }
    { const unsigned u = __builtin_bit_cast(unsigned, v); auto r = __builtin_amdgcn_permlane32_swap(u, u, false, false); v = fmaxf(__builtin_bit_cast(float, (unsigned)r[0]), __builtin_bit_cast(float, (unsigned)r[1])); }
    return v;
}
__device__ __forceinline__ unsigned pk4_i8(float a, float b, float c, float d) {
    const unsigned ua = __float_as_uint(a + 12582912.0f), ub = __float_as_uint(b + 12582912.0f), uc = __float_as_uint(c + 12582912.0f), ud = __float_as_uint(d + 12582912.0f);
    const unsigned lo = __builtin_amdgcn_perm(ub, ua, 0x0c0c0400u), hi = __builtin_amdgcn_perm(ud, uc, 0x0c0c0400u);
    return __builtin_amdgcn_perm(hi, lo, 0x05040100u);
}
__device__ __forceinline__ float xmax32(float v) { const unsigned u = __builtin_bit_cast(unsigned, v); auto r = __builtin_amdgcn_permlane32_swap(u, u, false, false); return fmaxf(__builtin_bit_cast(float, (unsigned)r[0]), __builtin_bit_cast(float, (unsigned)r[1])); }
__device__ __forceinline__ float xsum32(float v) { const unsigned u = __builtin_bit_cast(unsigned, v); auto r = __builtin_amdgcn_permlane32_swap(u, u, false, false); return __builtin_bit_cast(float, (unsigned)r[0]) + __builtin_bit_cast(float, (unsigned)r[1]); }
__device__ __forceinline__ float xor32(float v) { int l; asm volatile("v_mbcnt_lo_u32_b32 %0, -1, 0\n\tv_mbcnt_hi_u32_b32 %0, -1, %0" : "=v"(l)); return __builtin_bit_cast(float, __builtin_amdgcn_ds_bpermute((l ^ 32) << 2, __builtin_bit_cast(int, v))); }
__device__ __forceinline__ float wave_sum(float v) {
    v = dpp_add(v, 0); v = dpp_add(v, 1); v = dpp_add(v, 2); v = dpp_add(v, 3);
    { const unsigned u = __builtin_bit_cast(unsigned, v); auto r = __builtin_amdgcn_permlane16_swap(u, u, false, false); v = __builtin_bit_cast(float, (unsigned)r[0]) + __builtin_bit_cast(float, (unsigned)r[1]); }
    { const unsigned u = __builtin_bit_cast(unsigned, v); auto r = __builtin_amdgcn_permlane32_swap(u, u, false, false); v = __builtin_bit_cast(float, (unsigned)r[0]) + __builtin_bit_cast(float, (unsigned)r[1]); }
    return v;
}
#define LDS_WAIT() asm volatile("s_waitcnt lgkmcnt(0)" ::: "memory")

namespace pg8 {
struct EpiRS {
    static constexpr bool PERM = true, AFTER_DRAIN = false;
    bf16_t* O; int ldc; int pad;
    __device__ __forceinline__ void operator()(const f32x4 (&acc)[2][2][4][2], const Unit& u, int wr, int wc, int fr, int fq) const {
        const int row0 = u.pm * BM + wr * 64 + fr, col0 = u.pn * BM + wc * 32 + 8 * fq;
#pragma unroll
        for (int ai = 0; ai < 2; ++ai)
#pragma unroll
            for (int m = 0; m < 4; ++m) {
                bf16_t* rowp = O + (size_t)(row0 + ai * HALF + m * 16) * ldc + col0;
#pragma unroll
                for (int bj = 0; bj < 2; ++bj) { const f32x4 v0 = acc[ai][bj][m][0], v1 = acc[ai][bj][m][1];
                    u32x4 w; w.x = cvt_pk_bf16(v0[0], v0[1]); w.y = cvt_pk_bf16(v0[2], v0[3]); w.z = cvt_pk_bf16(v1[0], v1[1]); w.w = cvt_pk_bf16(v1[2], v1[3]);
                    *(u32x4*)(rowp + bj * HALF) = w; }
            }
    }
};

struct EpiRetIn {
    static constexpr bool PERM = true, AFTER_DRAIN = false;
    bf16_t* O; const float* rs; const float* rc; const float* rsn; int ldc; int pad;
    __device__ __forceinline__ void operator()(const f32x4 (&acc)[2][2][4][2], const Unit& u, int wr, int wc, int fr_, int fq_) const {
        const int ln_ = otid(0); const int fr = ln_ & 15, fq = ln_ >> 4; (void)fr_; (void)fq_;
        const int row0 = u.pm * BM + wr * 64 + fr, j0 = wc * 32 + 8 * fq, col0 = u.pn * BM + j0;
        const bool rot = u.pn < 8; const float ksc = (u.pn >= 4 && u.pn < 8) ? 0.0625f : 1.0f;
#pragma unroll
        for (int ab = 0; ab < 4; ++ab) { const int ai = ab >> 1, mb = 2 * (ab & 1);
            float sv[4]; f32x4 c0[4], c1[4], s0[4], s1[4];
#pragma unroll
            for (int m = mb; m < mb + 2; ++m) { const int row = row0 + ai * HALF + m * 16; sv[m] = rs[row] * ksc;
                if (rot) { const int pos = row & 2047; const float* cp = rc + pos * 128 + j0; const float* sp = rsn + pos * 128 + j0;
                    c0[m] = *(const f32x4*)cp; c1[m] = *(const f32x4*)(cp + 4); s0[m] = *(const f32x4*)sp; s1[m] = *(const f32x4*)(sp + 4); } }
#pragma unroll
            for (int m = mb; m < mb + 2; ++m) {
                const int row = row0 + ai * HALF + m * 16; const float s = sv[m];
                f32x4 a0 = acc[ai][0][m][0], a1 = acc[ai][0][m][1], b0 = acc[ai][1][m][0], b1 = acc[ai][1][m][1];
                if (rot) { const f32x4 n0 = a0 * c0[m] - b0 * s0[m], n1 = a1 * c1[m] - b1 * s1[m], q0 = b0 * c0[m] + a0 * s0[m], q1 = b1 * c1[m] + a1 * s1[m];
                    a0 = n0; a1 = n1; b0 = q0; b1 = q1; }
                a0 = a0 * s; a1 = a1 * s; b0 = b0 * s; b1 = b1 * s;
                bf16_t* rowp = O + ((size_t)((row >> 11) * 16 + u.pn) * 2048 + (row & 2047)) * 256 + j0;
                u32x4 w; w.x = cvt_pk_bf16(a0[0], a0[1]); w.y = cvt_pk_bf16(a0[2], a0[3]); w.z = cvt_pk_bf16(a1[0], a1[1]); w.w = cvt_pk_bf16(a1[2], a1[3]); __builtin_nontemporal_store(w, (u32x4*)rowp);
                u32x4 x; x.x = cvt_pk_bf16(b0[0], b0[1]); x.y = cvt_pk_bf16(b0[2], b0[3]); x.z = cvt_pk_bf16(b1[0], b1[1]); x.w = cvt_pk_bf16(b1[2], b1[3]); __builtin_nontemporal_store(x, (u32x4*)(rowp + HALF));
            }
        }
    }
};
struct EpiGate8 {
    static constexpr bool PERM = true, AFTER_DRAIN = false;
    bf16_t* Y; const float* sa; const float* sw; PG8_LAS float* st; const float* gain;
    __device__ __forceinline__ void operator()(const f32x4 (&acc)[2][2][4][2], const Unit& u, int wr, int wc, int fr_, int fq_) const {
        const int ln_ = otid(0); const int fr = ln_ & 15, fq = ln_ >> 4; (void)fr_; (void)fq_;
        const int row0 = u.pm * BM + wr * 64 + fr, col0 = u.pn * BM + wc * 32 + 8 * fq, head = u.pn >> 1;
        if ((u.pn & 1) == 0) {
            const int wid = wr * 4 + wc;
#pragma unroll
            for (int jb = 0; jb < 2; ++jb) {
                u32x4 yr[16];
#pragma unroll
                for (int k = 0; k < 16; ++k) yr[k] = *((const u32x4*)(Y + (size_t)(u.pm * BM + wid * 32 + jb * 16 + k) * 2048 + head * 512) + ln_);
#pragma unroll
                for (int k = 0; k < 16; ++k) {
                    float y[8];
#pragma unroll
                    for (int e = 0; e < 4; ++e) { y[2 * e] = __uint_as_float(yr[k][e] << 16); y[2 * e + 1] = __uint_as_float(yr[k][e] & 0xffff0000u); }
                    float sm = 0.f;
#pragma unroll
                    for (int e = 0; e < 8; ++e) sm += y[e];
                    const float mu = ::wave_sum(sm) * (1.0f / 512.0f); float q = 0.f;
#pragma unroll
                    for (int e = 0; e < 8; ++e) { const float d = y[e] - mu; q += d * d; }
                    const float rstd = 1.0f / sqrtf(::wave_sum(q) * (1.0f / 512.0f) + 1e-6f);
                    if (ln_ == 0) { PG8_LAS float* d = st + (wid * 32 + jb * 16 + k) * 2; d[0] = mu; d[1] = rstd; }
                }
            }
            asm volatile("s_waitcnt lgkmcnt(0)" ::: "memory"); __builtin_amdgcn_s_barrier(); asm volatile("" ::: "memory");
        }
        float gn[2][8], cs[2][8];
#pragma unroll
        for (int bj = 0; bj < 2; ++bj) { const f32x4 a = *(const f32x4*)(gain + col0 + bj * HALF), b = *(const f32x4*)(gain + col0 + bj * HALF + 4), c = *(const f32x4*)(sw + col0 + bj * HALF), d = *(const f32x4*)(sw + col0 + bj * HALF + 4);
#pragma unroll
            for (int e = 0; e < 4; ++e) { gn[bj][e] = a[e]; gn[bj][4 + e] = b[e]; cs[bj][e] = c[e]; cs[bj][4 + e] = d[e]; } }
#pragma unroll
        for (int ai = 0; ai < 2; ++ai) {
            float sv[4], muv[4], rsv[4]; u32x4 yv[4][2];
#pragma unroll
            for (int m = 0; m < 4; ++m) { const int row = row0 + ai * HALF + m * 16; sv[m] = sa[row];
                const PG8_LAS float* sp = st + (wr * 64 + fr + ai * HALF + m * 16) * 2; muv[m] = sp[0]; rsv[m] = sp[1];
                const bf16_t* rowp = Y + (size_t)row * 2048 + col0; yv[m][0] = *(const u32x4*)rowp; yv[m][1] = *(const u32x4*)(rowp + HALF); }
#pragma unroll
            for (int m = 0; m < 4; ++m) {
                const int row = row0 + ai * HALF + m * 16; const float s = sv[m], mu = muv[m], rstd = rsv[m];
                bf16_t* rowp = Y + (size_t)row * 2048 + col0;
#pragma unroll
                for (int bj = 0; bj < 2; ++bj) { float o[8];
#pragma unroll
                    for (int e = 0; e < 8; ++e) { const float g = (float)__float_as_int(acc[ai][bj][m][e >> 2][e & 3]) * s * cs[bj][e]; const unsigned w = yv[m][bj][e >> 1]; const float y = __uint_as_float((e & 1) ? (w & 0xffff0000u) : (w << 16));
                        const float sil = g * __builtin_amdgcn_rcpf(1.0f + __builtin_amdgcn_exp2f(-1.4426950408889634f * g)); o[e] = sil * ((y - mu) * rstd * gn[bj][e]); }
                    u32x4 w; w.x = cvt_pk_bf16(o[0], o[1]); w.y = cvt_pk_bf16(o[2], o[3]); w.z = cvt_pk_bf16(o[4], o[5]); w.w = cvt_pk_bf16(o[6], o[7]);
                    *(u32x4*)(rowp + bj * HALF) = w; }
            }
        }
    }
};
struct PairOrder {
    StaticOrder so;
    __host__ __device__ void init(int M, int N, int G_, int c_) { so.init(M, N / 2, G_, c_); }
    __host__ __device__ bool next(int i, Unit& u) const { Unit h; if (!so.next(i >> 1, h)) return false; u.pm = h.pm; u.pn = 2 * h.pn + (i & 1); return true; }
    __device__ __forceinline__ void a_ready(const Unit&) const {}
    __device__ __forceinline__ void done(const Unit&) const {}
};
struct EpiAttRot {
    static constexpr bool PERM = true, AFTER_DRAIN = false;
    bf16_t* O; const float* rs; const float* ac; const float* as; int ldc; int rot_tiles;
    __device__ __forceinline__ void operator()(const f32x4 (&acc)[2][2][4][2], const Unit& u, int wr, int wc, int fr, int fq) const {
        const int row0 = u.pm * BM + wr * 64 + fr, col0 = u.pn * BM + wc * 32 + 8 * fq;
        const bool wrot = (u.pn < rot_tiles) && ((wc & 1) == 0); const bool lrot = fq < 2;
#pragma unroll
        for (int ai = 0; ai < 2; ++ai)
#pragma unroll
            for (int m = 0; m < 4; ++m) {
                const int row = row0 + ai * HALF + m * 16; const float s = rs[row];
                f32x4 cc = (f32x4){1.f, 1.f, 1.f, 1.f}, ss = (f32x4){0.f, 0.f, 0.f, 0.f};
                if (wrot) { const int pos = row & 2047; const f32x4 c = *(const f32x4*)(ac + pos * 8 + 4 * (fq & 1)), sn = *(const f32x4*)(as + pos * 8 + 4 * (fq & 1));
                    if (lrot) { cc = c; ss = sn; } }
                bf16_t* rowp = O + (size_t)row * ldc + col0;
#pragma unroll
                for (int bj = 0; bj < 2; ++bj) { const f32x4 v0 = acc[ai][bj][m][0], v1 = acc[ai][bj][m][1];
                    const float n0 = (v0[0] * cc[0] - v0[1] * ss[0]) * s, n1 = (v0[1] * cc[0] + v0[0] * ss[0]) * s, n2 = (v0[2] * cc[1] - v0[3] * ss[1]) * s, n3 = (v0[3] * cc[1] + v0[2] * ss[1]) * s;
                    const float n4 = (v1[0] * cc[2] - v1[1] * ss[2]) * s, n5 = (v1[1] * cc[2] + v1[0] * ss[2]) * s, n6 = (v1[2] * cc[3] - v1[3] * ss[3]) * s, n7 = (v1[3] * cc[3] + v1[2] * ss[3]) * s;
                    u32x4 w; w.x = cvt_pk_bf16(n0, n1); w.y = cvt_pk_bf16(n2, n3); w.z = cvt_pk_bf16(n4, n5); w.w = cvt_pk_bf16(n6, n7);
                    *(u32x4*)(rowp + bj * HALF) = w; }
            }
    }
};

struct EpiAttRot8 {
    static constexpr bool PERM = true, AFTER_DRAIN = false;
    bf16_t* O; const float* sa; const float* sw; const float* ac; const float* as; int ldc; int rot_tiles;
    __device__ __forceinline__ void operator()(const f32x4 (&acc)[2][2][4][2], const Unit& u, int wr, int wc, int fr_, int fq_) const {
        const int ln_ = otid(0); const int fr = ln_ & 15, fq = ln_ >> 4; (void)fr_; (void)fq_;
        const int row0 = u.pm * BM + wr * 64 + fr, col0 = u.pn * BM + wc * 32 + 8 * fq;
        const bool iskv = ldc == 6144;
        size_t cbase[2]; int grp[2];
#pragma unroll
        for (int bj = 0; bj < 2; ++bj) { const int n = col0 + bj * HALF; const int part = (iskv && n >= 3072) ? 1 : 0, nn = n - 3072 * part, gh = nn >> 6, d = nn & 63;
            grp[bj] = (gh >> 4) + ((!iskv && gh < 16) ? 1 : 0)  ; cbase[bj] = (iskv ? (size_t)(gh * 2 + part) : (size_t)gh) * 131072 + d; }
        const bool wrot = (u.pn < rot_tiles) && ((wc & 1) == 0); const bool lrot = fq < 2;
        float cs[2][8];
#pragma unroll
        for (int bj = 0; bj < 2; ++bj) { const f32x4 a = *(const f32x4*)(sw + col0 + bj * HALF), b = *(const f32x4*)(sw + col0 + bj * HALF + 4);
#pragma unroll
            for (int e = 0; e < 4; ++e) { cs[bj][e] = a[e]; cs[bj][4 + e] = b[e]; } }
#pragma unroll
        for (int ai = 0; ai < 2; ++ai) {
            float sv[4]; f32x4 ccv[4], ssv[4];
#pragma unroll
            for (int m = 0; m < 4; ++m) { const int row = row0 + ai * HALF + m * 16; sv[m] = sa[row];
                ccv[m] = (f32x4){1.f, 1.f, 1.f, 1.f}; ssv[m] = (f32x4){0.f, 0.f, 0.f, 0.f};
                if (wrot) { const int pos = row & 2047; const f32x4 c = *(const f32x4*)(ac + pos * 8 + 4 * (fq & 1)), sn = *(const f32x4*)(as + pos * 8 + 4 * (fq & 1));
                    if (lrot) { ccv[m] = c; ssv[m] = sn; } } }
#pragma unroll
            for (int m = 0; m < 4; ++m) {
                const int row = row0 + ai * HALF + m * 16; const float s = sv[m];
                const f32x4 cc = ccv[m], ss = ssv[m];
                const int tk = row & 2047; bf16_t* rowb = O + (size_t)(row >> 11) * (iskv ? 48 * 2 * 131072 : 48 * 131072);
#pragma unroll
                for (int bj = 0; bj < 2; ++bj) { float t[8];
                    const int slot = grp[bj] == 0 ? tk : (grp[bj] == 1 ? (((tk & 3) << 9) | (tk >> 2)) : (((tk & 15) << 7) | (tk >> 4)));
#pragma unroll
                    for (int e = 0; e < 8; ++e) t[e] = (float)__float_as_int(acc[ai][bj][m][e >> 2][e & 3]) * cs[bj][e];
                    u32x4 w;
                    if (!wrot) {
                        w.x = cvt_pk_bf16(t[0] * s, t[1] * s); w.y = cvt_pk_bf16(t[2] * s, t[3] * s); w.z = cvt_pk_bf16(t[4] * s, t[5] * s); w.w = cvt_pk_bf16(t[6] * s, t[7] * s);
                    } else {
                    const float n0 = (t[0] * cc[0] - t[1] * ss[0]) * s, n1 = (t[1] * cc[0] + t[0] * ss[0]) * s, n2 = (t[2] * cc[1] - t[3] * ss[1]) * s, n3 = (t[3] * cc[1] + t[2] * ss[1]) * s;
                    const float n4 = (t[4] * cc[2] - t[5] * ss[2]) * s, n5 = (t[5] * cc[2] + t[4] * ss[2]) * s, n6 = (t[6] * cc[3] - t[7] * ss[3]) * s, n7 = (t[7] * cc[3] + t[6] * ss[3]) * s;
                    w.x = cvt_pk_bf16(n0, n1); w.y = cvt_pk_bf16(n2, n3); w.z = cvt_pk_bf16(n4, n5); w.w = cvt_pk_bf16(n6, n7);
                    }
                    *(u32x4*)(rowb + cbase[bj] + (size_t)slot * 64) = w; }
            }
        }
    }
};

__device__ __forceinline__ float dpp_ror1(float x) { return __builtin_bit_cast(float, __builtin_amdgcn_update_dpp(0, __builtin_bit_cast(int, x), 0x121, 0xF, 0xF, false)); }
__device__ __forceinline__ float dpp_ror2(float x) { return __builtin_bit_cast(float, __builtin_amdgcn_update_dpp(0, __builtin_bit_cast(int, x), 0x122, 0xF, 0xF, false)); }
typedef float gf2 __attribute__((ext_vector_type(2)));
__device__ __forceinline__ gf2 gelu_tanh_mul2(gf2 x, gf2 v) {
    const gf2 p = x * x * (gf2){0.10294324f, 0.10294324f} + (gf2){2.30220819f, 2.30220819f};
    const gf2 a = -x * p;
    gf2 t; t.x = __builtin_amdgcn_exp2f(a.x); t.y = __builtin_amdgcn_exp2f(a.y);
    const gf2 d = t + (gf2){1.0f, 1.0f};
    gf2 r; r.x = __builtin_amdgcn_rcpf(d.x); r.y = __builtin_amdgcn_rcpf(d.y);
    return x * v * r;
}
__device__ __forceinline__ float gelu_tanh_mul(float x, float v) { const float t = __builtin_amdgcn_exp2f(-x * (2.30220819f + 0.10294324f * x * x)); return x * v * __builtin_amdgcn_rcpf(1.0f + t); }
struct EpiUpConv {
    static constexpr bool PERM = true, AFTER_DRAIN = false; static constexpr int NST = 8;
    bf16_t* H; const float* sa; const float* sw; const float* cw; const float* cb; float* halo_g; PG8_LAS float* hl;
    static __device__ __forceinline__ f32x4 cvt4(const f32x4 a, float s) { f32x4 r;
#pragma unroll
        for (int e = 0; e < 4; ++e) r[e] = (float)__float_as_int(a[e]) * s;
        return r; }
    __device__ __forceinline__ void operator()(const f32x4 (&acc)[2][2][4][2], const Unit& u, int wr, int wc, int fr_, int fq_) const {
        const int ln_ = otid(0); const int fr = ln_ & 15, fq = ln_ >> 4; (void)fr_; (void)fq_;
        const int c0 = wc * 32 + 8 * fq, f0 = u.pn * HALF + c0, row0 = u.pm * BM + wr * 64 + 4 * fr;
        float* hb = halo_g + ((size_t)u.pm * 22 + u.pn) * 768 + c0;
        float sv[2][4];
#pragma unroll
        for (int ai = 0; ai < 2; ++ai) { const f32x4 t = *(const f32x4*)(sa + row0 + ai * HALF);
#pragma unroll
            for (int m = 0; m < 4; ++m) sv[ai][m] = t[m]; }
        float w0[8], w1[8], w2[8], bb[8], sv8[8];
#pragma unroll
        for (int e = 0; e < 8; ++e) { const float sg = sw[f0 + e]; w0[e] = cw[f0 + e] * sg; w1[e] = cw[FF + f0 + e] * sg; w2[e] = cw[2 * FF + f0 + e] * sg; bb[e] = cb[f0 + e]; sv8[e] = sw[FF + f0 + e]; }
#pragma unroll
        for (int ai = 0; ai < 2; ++ai)
            if (fr == 15) {
#pragma unroll
                for (int k = 0; k < 2; ++k) { PG8_LAS float* d = hl + ((2 * ai + wr) * 2 + k) * 128 + c0; const float s = sv[ai][2 + k];
                    *(PG8_LAS f32x4*)d = cvt4(acc[ai][0][2 + k][0], s); *(PG8_LAS f32x4*)(d + 4) = cvt4(acc[ai][0][2 + k][1], s); } }
        asm volatile("s_waitcnt lgkmcnt(0)" ::: "memory"); __builtin_amdgcn_s_barrier(); asm volatile("" ::: "memory");
#pragma unroll
        for (int ai = 0; ai < 2; ++ai) {
            const int gid = 2 * ai + wr;
            float hm1[8], hm2[8];
#pragma unroll
            for (int e = 0; e < 8; ++e) { hm1[e] = 0.f; hm2[e] = 0.f; }
            if (gid > 0) { const PG8_LAS float* s2 = hl + ((gid - 1) * 2 + 0) * 128 + c0; const PG8_LAS float* s1 = hl + ((gid - 1) * 2 + 1) * 128 + c0;
                const f32x4 a = *(const PG8_LAS f32x4*)s2, b = *(const PG8_LAS f32x4*)(s2 + 4), c = *(const PG8_LAS f32x4*)s1, d = *(const PG8_LAS f32x4*)(s1 + 4);
#pragma unroll
                for (int e = 0; e < 4; ++e) { hm2[e] = a[e]; hm2[4 + e] = b[e]; hm1[e] = c[e]; hm1[4 + e] = d[e]; } }
            float o[4][8];
#pragma unroll
            for (int e = 0; e < 8; e += 2) {
                gf2 g[4], v[4];
#pragma unroll
                for (int m = 0; m < 4; ++m) {
                    g[m] = (gf2){(float)__float_as_int(acc[ai][0][m][e >> 2][e & 3]), (float)__float_as_int(acc[ai][0][m][e >> 2][(e & 3) + 1])} * sv[ai][m];
                    v[m] = (gf2){(float)__float_as_int(acc[ai][1][m][e >> 2][e & 3]), (float)__float_as_int(acc[ai][1][m][e >> 2][(e & 3) + 1])} * sv[ai][m] * (gf2){sv8[e], sv8[e + 1]}; }
                gf2 q3, q2; q3.x = dpp_ror1(g[3].x); q3.y = dpp_ror1(g[3].y); q2.x = dpp_ror1(g[2].x); q2.y = dpp_ror1(g[2].y);
                const gf2 tm1 = fr >= 1 ? q3 : (gf2){hm1[e], hm1[e + 1]}, tm2 = fr >= 1 ? q2 : (gf2){hm2[e], hm2[e + 1]};
                const gf2 W0 = {w0[e], w0[e + 1]}, W1 = {w1[e], w1[e + 1]}, W2 = {w2[e], w2[e + 1]}, BB = {bb[e], bb[e + 1]};
                const gf2 r0 = gelu_tanh_mul2(BB + W0 * tm2 + W1 * tm1 + W2 * g[0], v[0]);
                const gf2 r1 = gelu_tanh_mul2(BB + W0 * tm1 + W1 * g[0] + W2 * g[1], v[1]);
                const gf2 r2 = gelu_tanh_mul2(BB + W0 * g[0] + W1 * g[1] + W2 * g[2], v[2]);
                const gf2 r3 = gelu_tanh_mul2(BB + W0 * g[1] + W1 * g[2] + W2 * g[3], v[3]);
                o[0][e] = r0.x; o[0][e + 1] = r0.y; o[1][e] = r1.x; o[1][e + 1] = r1.y; o[2][e] = r2.x; o[2][e + 1] = r2.y; o[3][e] = r3.x; o[3][e + 1] = r3.y;
            }
#pragma unroll
            for (int m = 0; m < 4; ++m) {
                u32x4 w; w.x = cvt_pk_bf16(o[m][0], o[m][1]); w.y = cvt_pk_bf16(o[m][2], o[m][3]); w.z = cvt_pk_bf16(o[m][4], o[m][5]); w.w = cvt_pk_bf16(o[m][6], o[m][7]);
                __builtin_nontemporal_store(w, (u32x4*)(H + (size_t)(row0 + ai * HALF + m) * FF + f0));
            }
        }
        if (wr == 1 && fr == 15) {
#pragma unroll
            for (int k = 0; k < 2; ++k) { const float s = sv[1][2 + k]; float* gd = hb + k * 128; *(f32x4*)gd = cvt4(acc[1][0][2 + k][0], s); *(f32x4*)(gd + 4) = cvt4(acc[1][0][2 + k][1], s); } }
        if (wr == 0 && fr == 0) {
#pragma unroll
            for (int k = 0; k < 2; ++k) { const float s = sv[0][k]; float* gd = hb + (2 + k) * 128; *(f32x4*)gd = cvt4(acc[0][0][k][0], s); *(f32x4*)(gd + 4) = cvt4(acc[0][0][k][1], s);
                float* vd = hb + (4 + k) * 128; *(f32x4*)vd = cvt4(acc[0][1][k][0], s); *(f32x4*)(vd + 4) = cvt4(acc[0][1][k][1], s); } }
    }
};

struct EpiGate {
    static constexpr bool PERM = true, AFTER_DRAIN = false;
    bf16_t* Y; const float* rs; const float* gs; const float* gain;
    __device__ __forceinline__ void operator()(const f32x4 (&acc)[2][2][4][2], const Unit& u, int wr, int wc, int fr, int fq) const {
        const int row0 = u.pm * BM + wr * 64 + fr, col0 = u.pn * BM + wc * 32 + 8 * fq, head = u.pn >> 1;
        float gn[2][8];
#pragma unroll
        for (int bj = 0; bj < 2; ++bj) { const f32x4 a = *(const f32x4*)(gain + col0 + bj * HALF), b = *(const f32x4*)(gain + col0 + bj * HALF + 4);
#pragma unroll
            for (int e = 0; e < 4; ++e) { gn[bj][e] = a[e]; gn[bj][4 + e] = b[e]; } }
#pragma unroll
        for (int ai = 0; ai < 2; ++ai)
#pragma unroll
            for (int m = 0; m < 4; ++m) {
                const int row = row0 + ai * HALF + m * 16; const float s = rs[row]; const float mu = gs[(row * 4 + head) * 2], rstd = gs[(row * 4 + head) * 2 + 1];
                bf16_t* rowp = Y + (size_t)row * 2048 + col0;
#pragma unroll
                for (int bj = 0; bj < 2; ++bj) { const u32x4 yv = *(const u32x4*)(rowp + bj * HALF); float o[8];
#pragma unroll
                    for (int e = 0; e < 8; ++e) { const float g = acc[ai][bj][m][e >> 2][e & 3] * s; const unsigned w = yv[e >> 1]; const float y = __uint_as_float((e & 1) ? (w & 0xffff0000u) : (w << 16));
                        const float sil = g * __builtin_amdgcn_rcpf(1.0f + __builtin_amdgcn_exp2f(-1.4426950408889634f * g)); o[e] = sil * ((y - mu) * rstd * gn[bj][e]); }
                    u32x4 w; w.x = cvt_pk_bf16(o[0], o[1]); w.y = cvt_pk_bf16(o[2], o[3]); w.z = cvt_pk_bf16(o[4], o[5]); w.w = cvt_pk_bf16(o[6], o[7]);
                    *(u32x4*)(rowp + bj * HALF) = w; }
            }
    }
};
}

template <class Epi, int QM = 0>
__device__ __forceinline__ void gemm_call(LAS unsigned char* lds, const bf16* A, const bf16* Bt, int M, int N, int K, const Epi& E, int G, int bid, int wv) {
    pg8::Gemm g{A, Bt, M, N, K}; pg8::StaticOrder S; S.init(M, N, G, bid);
    pg8::gemm_phase<Epi, pg8::StaticOrder, true, true, QM>(lds, g, S, E, wv);
}
template <class Epi, int QM>
__device__ __forceinline__ void gemm_call_pair(LAS unsigned char* lds, const bf16* A, const bf16* Bt, int M, int N, int K, const Epi& E, int G, int bid, int wv) {
    pg8::Gemm g{A, Bt, M, N, K}; pg8::PairOrder S; S.init(M, N, G, bid);
    pg8::gemm_phase<Epi, pg8::PairOrder, true, true, QM>(lds, g, S, E, wv);
}
__device__ __forceinline__ unsigned pk4_fp8(float a, float b, float c, float d) { int w = 0; w = __builtin_amdgcn_cvt_pk_fp8_f32(a, b, w, false); w = __builtin_amdgcn_cvt_pk_fp8_f32(c, d, w, true); return (unsigned)w; }
constexpr float W8_SCALE = 32.0f;

struct TItem { const float* W; int K, N; bf16* WT; const float* gain; int mode, rot_limit, item; const float* wsc  ; };
__device__ __forceinline__ void transpose_load(const TItem& t, int lane, float (&v)[32]) {
    const int nblk = t.N / 32, kb = t.item / nblk, nb = t.item % nblk, k0 = 64 * kb, n0 = 32 * nb;
    int src0 = n0;
    if (t.mode == 1) { const int pn = n0 >> 8, bj = (n0 >> 7) & 1, i0 = n0 & 127; src0 = bj * FF + 128 * pn + i0; }
#pragma unroll
    for (int i = 0; i < 32; ++i) { const int kk = 2 * i + (lane >> 5); const float g = t.gain ? t.gain[k0 + kk] : 1.f; v[i] = t.W[(size_t)(k0 + kk) * t.N + src0 + (lane & 31)] * g; }
}
__device__ __forceinline__ void transpose_finish(const TItem& t, LAS float* scr, int lane, const float (&v)[32]) {
    const int K = t.K; bf16* WT = t.WT; const float* wsc = t.wsc;
    const int nblk = t.N / 32, kb = t.item / nblk, nb = t.item % nblk, k0 = 64 * kb, n0 = 32 * nb;
    int src0 = n0;
    if (t.mode == 1) { const int pn = n0 >> 8, bj = (n0 >> 7) & 1, i0 = n0 & 127; src0 = bj * FF + 128 * pn + i0; }
#pragma unroll
    for (int i = 0; i < 32; ++i) { const int kk = 2 * i + (lane >> 5); scr[kk * 33 + (lane & 31)] = v[i]; }
    LDS_WAIT(); asm volatile("" ::: "memory");
    const int c = lane & 7;
    const bool rot = (n0 < t.rot_limit) && ((n0 & 63) == 0);
#pragma unroll
    for (int j = 0; j < 4; ++j) { const int n = (lane >> 3) + 8 * j; const int sn = (rot && n < 16) ? ((n & 1) * 8 + (n >> 1)) : n; const LAS float* s = scr + (8 * c) * 33 + sn;
        if (wsc) { const float sc = wsc[src0 + n], iv = sc > 0.f ? 1.0f / sc : 0.f;
            v2u o; o.x = pk4_i8(s[0 * 33] * iv, s[1 * 33] * iv, s[2 * 33] * iv, s[3 * 33] * iv); o.y = pk4_i8(s[4 * 33] * iv, s[5 * 33] * iv, s[6 * 33] * iv, s[7 * 33] * iv);
            *(v2u*)((unsigned char*)WT + (size_t)(n0 + n) * K + k0 + 8 * c) = o; continue; }
        v4u o; o.x = pk2(s[0 * 33], s[1 * 33]); o.y = pk2(s[2 * 33], s[3 * 33]); o.z = pk2(s[4 * 33], s[5 * 33]); o.w = pk2(s[6 * 33], s[7 * 33]);
        *(v4u*)(WT + (size_t)(n0 + n) * K + k0 + 8 * c) = o; }
    LDS_WAIT(); asm volatile("" ::: "memory");
}

__device__ __forceinline__ void ph_wmax(const Params& p, LAS unsigned char* lds, int G, int bid, int wv) {
    const int tid = otid(wv), lane = tid & 63, wave = tid >> 6;
    LAS float* part = (LAS float*)lds;
    float* WSC = (float*)(p.ws + WS_WSC);
    for (int it = bid; it < 4 * 44 + 48 + 2 * 24 + 2 * 16; it += G) {
        const float* Wb; const float* gk; int pitch, c, obase, rot_limit;
        if (it < 176) { const int l = it / 44; c = it % 44; Wb = p.w_up + (size_t)l * D * 2 * FF; gk = p.n_ffn_pre + l * D; pitch = 2 * FF; obase = l * 2 * FF; rot_limit = 0; }
        else if (it < 224) { c = it - 176; Wb = p.w_kv; gk = p.kv_norm; pitch = KVW; obase = WSC_KV; rot_limit = 3072; }
        else if (it >= 272) { const int l = (it - 272) / 16; c = 32 + (it - 272) % 16  ; Wb = p.ret_w_in + (size_t)l * D * RET_IN; gk = p.n_mix_pre + l * D; pitch = RET_IN; obase = WSC_RET + l * RET_IN; rot_limit = 0; }
        else { const int l = (it - 224) / 24; c = (it - 224) % 24; Wb = p.w_q + (size_t)l * D * QW; gk = p.n_mix_pre + (2 + l) * D; pitch = QW; obase = WSC_Q + l * QW; rot_limit = QW; }
        const float* W = Wb + 128 * c + 2 * lane;
        float m0 = 0.f, m1 = 0.f;
#pragma unroll 32
        for (int k = wave * 128; k < wave * 128 + 128; ++k) { const float gg = gk[k]; const float2 w = *(const float2*)(W + (size_t)k * pitch); m0 = fmaxf(m0, fabsf(w.x * gg)); m1 = fmaxf(m1, fabsf(w.y * gg)); }
        part[wave * 128 + 2 * lane] = m0; part[wave * 128 + 2 * lane + 1] = m1;
        __syncthreads();
        if (tid < 128) { float m = part[tid];
#pragma unroll
            for (int w = 1; w < 8; ++w) m = fmaxf(m, part[w * 128 + tid]);
            const int sc_ = 128 * c + tid, hj = sc_ & 63; int oc = sc_;
            if (sc_ < rot_limit && hj < 16) oc = (sc_ & ~63) + (hj < 8 ? 2 * hj : 2 * (hj - 8) + 1);
            WSC[obase + oc] = m * (1.0f / 127.0f); }
        __syncthreads();
    }
}
__device__ __forceinline__ void ph_prologue(const Params& p, LAS unsigned char* lds, int G, int bid, int wv) {
    const int tid = otid(wv), lane = tid & 63, wave = tid >> 6;
    LAS float* scr = (LAS float*)(lds + wave * 16384);
    const int gw = bid * 8 + wave, NGW = G * 8;
    bf16* WB = (bf16*)(p.ws + WS_W);
    constexpr int I_RETIN = 16 * 192, I_RETOUT = 32 * 32, I_KV = 16 * 192, I_Q = 16 * 96, I_O = 16 * 32, I_UP = 16 * 176, I_DOWN = 44 * 32;
    constexpr int NITEMS = 2 * I_RETIN + 2 * I_RETOUT + I_KV + 2 * I_Q + 2 * I_O + 4 * I_UP + 4 * I_DOWN;
    const float* WSCb = (const float*)(p.ws + WS_WSC);
    auto decode = [&](int it) -> TItem {
        int r = it;
        if (r < 2 * I_RETIN) { const int l = r / I_RETIN; const int itx = r % I_RETIN; const bool gate = (itx % 192) >= 128;
            bf16* base = WB + W_RETIN + (size_t)l * RET_IN * D;
            return TItem{p.ret_w_in + (size_t)l * D * RET_IN, D, RET_IN, gate ? (bf16*)((unsigned char*)base + (size_t)RQP * D) : base, p.n_mix_pre + l * D, 0, 0, itx, gate ? WSCb + WSC_RET + l * RET_IN : nullptr}; } r -= 2 * I_RETIN;
        if (r < 2 * I_RETOUT) { const int l = r / I_RETOUT; return TItem{p.ret_w_out + (size_t)l * 2048 * D, 2048, D, WB + W_RETOUT + (size_t)l * D * 2048, nullptr, 0, 0, r % I_RETOUT, nullptr}; } r -= 2 * I_RETOUT;
        if (r < I_KV) return TItem{p.w_kv, D, KVW, WB + W_KV, p.kv_norm, 0, 3072, r, WSCb + WSC_KV}; r -= I_KV;
        if (r < 2 * I_Q) { const int l = r / I_Q; return TItem{p.w_q + (size_t)l * D * QW, D, QW, (bf16*)((unsigned char*)(WB + W_Q) + (size_t)l * QW * D), p.n_mix_pre + (2 + l) * D, 0, QW, r % I_Q, WSCb + WSC_Q + l * QW}; } r -= 2 * I_Q;
        if (r < 2 * I_O) { const int l = r / I_O; return TItem{p.w_o + (size_t)l * D * D, D, D, WB + W_O + (size_t)l * D * D, nullptr, 0, 0, r % I_O, nullptr}; } r -= 2 * I_O;
        if (r < 4 * I_UP) { const int l = r / I_UP; return TItem{p.w_up + (size_t)l * D * 2 * FF, D, 2 * FF, (bf16*)((unsigned char*)(WB + W_UP) + (size_t)l * 2 * FF * D), p.n_ffn_pre + l * D, 1, 0, r % I_UP, WSCb + l * 2 * FF}; } r -= 4 * I_UP;
        { const int l = r / I_DOWN; return TItem{p.w_down + (size_t)l * FF * D, FF, D, WB + W_DOWN + (size_t)l * D * FF, nullptr, 0, 0, r % I_DOWN, nullptr}; }
    };
    if (gw < NITEMS) {
        TItem cur = decode(gw); float v[32]; transpose_load(cur, lane, v);
        for (int it = gw; it < NITEMS; it += NGW) {
            const int nit = it + NGW < NITEMS ? it + NGW : it;
            const TItem nx = decode(nit); float vn[32]; transpose_load(nx, lane, vn);
            transpose_finish(cur, scr, lane, v);
            cur = nx;
#pragma unroll
            for (int i = 0; i < 32; ++i) v[i] = vn[i];
        }
    }
    float* rcos = (float*)(p.ws + WS_RCOS); float* rsin = (float*)(p.ws + WS_RSIN); float* acos_ = (float*)(p.ws + WS_ACOS); float* asin_ = (float*)(p.ws + WS_ASIN);
    const int gt = bid * 512 + tid, NGT = G * 512;
    for (int i = gt; i < 2048 * 128; i += NGT) { const int pos = i >> 7, j = i & 127;
        const float inv = (float)(1.0 / pow(10000.0, (double)j / 127.0)); const float ang = (float)pos * inv;
        rcos[i] = (float)cos((double)ang); rsin[i] = (float)sin((double)ang); }
    for (int i = gt; i < 2048 * 8; i += NGT) { const int pos = i >> 3, j = i & 7;
        const float inv = (float)pow(500000.0, -(double)(2 * j) / 16.0); const float ang = (float)pos * inv;
        acos_[i] = (float)cos((double)ang); asin_[i] = (float)sin((double)ang); }
    bf16* XB = (bf16*)(p.ws + WS_XB); float* RS = (float*)(p.ws + WS_RS); float* SA = (float*)(p.ws + WS_SA); unsigned char* A8 = p.ws + WS_MB;
    f32x4 v[4];
#pragma unroll
    for (int j = 0; j < 4; ++j) v[j] = ((const f32x4*)(p.x + (size_t)gw * D) + lane)[64 * j];
    for (int m = gw; m < M_ALL; m += NGW) {
        const int mn = m + NGW < M_ALL ? m + NGW : m;
        f32x4 vn[4];
#pragma unroll
        for (int j = 0; j < 4; ++j) vn[j] = ((const f32x4*)(p.x + (size_t)mn * D) + lane)[64 * j];
        float s = 0.f;
#pragma unroll
        for (int j = 0; j < 4; ++j) s += (v[j][0] * v[j][0] + v[j][1] * v[j][1]) + (v[j][2] * v[j][2] + v[j][3] * v[j][3]);
        s = wave_sum(s);
        v2u* o = (v2u*)(XB + (size_t)m * D) + lane;
#pragma unroll
        for (int j = 0; j < 4; ++j) { v2u w; w.x = pk2(v[j][0], v[j][1]); w.y = pk2(v[j][2], v[j][3]); o[64 * j] = w; }
        const float rn = 1.0f / sqrtf(s * (1.0f / D) + RMS_EPS);
        if (lane == 0) RS[m] = rn;
        float am = 0.f;
#pragma unroll
        for (int j = 0; j < 4; ++j) am = fmaxf(fmaxf(am, fmaxf(fabsf(v[j][0]), fabsf(v[j][1]))), fmaxf(fabsf(v[j][2]), fabsf(v[j][3])));
        am = wave_max(am);
        const float iv = am > 0.f ? 127.0f / am : 0.f;
        if (lane == 0) SA[m] = rn * am * (1.0f / 127.0f);
        unsigned* a8 = (unsigned*)(A8 + (size_t)m * D) + lane;
#pragma unroll
        for (int j = 0; j < 4; ++j) a8[64 * j] = pk4_i8(v[j][0] * iv, v[j][1] * iv, v[j][2] * iv, v[j][3] * iv);
#pragma unroll
        for (int j = 0; j < 4; ++j) v[j] = vn[j];
    }
}

__device__ __forceinline__ void thin_row(bf16* xrow, const bf16* mrow, float* rsp, float* orow, unsigned char* a8row, float* sap, const f32x4 (&g)[4], const v4u (&xv)[2], const v4u (&mv)[2], int lane) {
    float mf[16], xf[16]; float sm = 0.f;
#pragma unroll
    for (int j = 0; j < 2; ++j)
#pragma unroll
        for (int e = 0; e < 4; ++e) { mf[8 * j + 2 * e] = __uint_as_float(mv[j][e] << 16); mf[8 * j + 2 * e + 1] = __uint_as_float(mv[j][e] & 0xffff0000u);
            xf[8 * j + 2 * e] = __uint_as_float(xv[j][e] << 16); xf[8 * j + 2 * e + 1] = __uint_as_float(xv[j][e] & 0xffff0000u); }
#pragma unroll
    for (int e = 0; e < 16; ++e) sm += mf[e] * mf[e];
    const float r = 1.0f / sqrtf(wave_sum(sm) * (1.0f / D) + RMS_EPS);
    float s = 0.f; v4u wk[2];
#pragma unroll
    for (int j = 0; j < 2; ++j) { float y[8];
#pragma unroll
        for (int e = 0; e < 8; ++e) y[e] = xf[8 * j + e] + g[2 * j + (e >> 2)][e & 3] * r * mf[8 * j + e];
        v4u w; w.x = pk2(y[0], y[1]); w.y = pk2(y[2], y[3]); w.z = pk2(y[4], y[5]); w.w = pk2(y[6], y[7]);
        *((v4u*)(xrow + 512 * j) + lane) = w; wk[j] = w;
        if (orow) { __builtin_nontemporal_store((f32x4){y[0], y[1], y[2], y[3]}, (f32x4*)(orow + 512 * j) + 2 * lane); __builtin_nontemporal_store((f32x4){y[4], y[5], y[6], y[7]}, (f32x4*)(orow + 512 * j) + 2 * lane + 1); }
#pragma unroll
        for (int e = 0; e < 4; ++e) { const float a = __uint_as_float(w[e] << 16), b = __uint_as_float(w[e] & 0xffff0000u); s += a * a + b * b; } }
    s = wave_sum(s);
    const float rn = 1.0f / sqrtf(s * (1.0f / D) + RMS_EPS);
    if (lane == 0) *rsp = rn;
    if (a8row) {
        float f[16]; float am = 0.f;
#pragma unroll
        for (int j = 0; j < 2; ++j)
#pragma unroll
            for (int e = 0; e < 4; ++e) { f[8 * j + 2 * e] = __uint_as_float(wk[j][e] << 16); f[8 * j + 2 * e + 1] = __uint_as_float(wk[j][e] & 0xffff0000u); }
#pragma unroll
        for (int e = 0; e < 16; ++e) am = fmaxf(am, fabsf(f[e]));
        am = wave_max(am);
        const float iv = am > 0.f ? 127.0f / am : 0.f;
        if (lane == 0) *sap = rn * am * (1.0f / 127.0f);
#pragma unroll
        for (int j = 0; j < 2; ++j) { v2u o; o.x = pk4_i8(f[8 * j] * iv, f[8 * j + 1] * iv, f[8 * j + 2] * iv, f[8 * j + 3] * iv); o.y = pk4_i8(f[8 * j + 4] * iv, f[8 * j + 5] * iv, f[8 * j + 6] * iv, f[8 * j + 7] * iv);
            *((v2u*)(a8row + 512 * j) + lane) = o; }
    }
}
__device__ __forceinline__ void ph_thin(const Params& p, int row0, int nrows, const bf16* MB, const float* gpost, float* outf, unsigned char* a8, bool a8perm  , int G, int bid, int wv) {
    const int tid = otid(wv), lane = tid & 63, wave = tid >> 6, gw = bid * 8 + wave, NGW = G * 8;
    bf16* XB = (bf16*)(p.ws + WS_XB) + (size_t)row0 * D;
    float* RS = (float*)(p.ws + WS_RS) + row0; float* SA = (float*)(p.ws + WS_SA) + row0;
    f32x4 g[4];
#pragma unroll
    for (int j = 0; j < 2; ++j) { g[2 * j] = ((const f32x4*)(gpost + 512 * j))[2 * lane]; g[2 * j + 1] = ((const f32x4*)(gpost + 512 * j))[2 * lane + 1]; }
    for (int m = gw; m < nrows; m += 2 * NGW) {
        const int m2 = m + NGW; const bool has2 = m2 < nrows; const int mb = has2 ? m2 : m;
        v4u xa[2], ma[2], xb[2], mbv[2];
#pragma unroll
        for (int j = 0; j < 2; ++j) { xa[j] = *((const v4u*)(XB + (size_t)m * D + 512 * j) + lane); ma[j] = *((const v4u*)(MB + (size_t)m * D + 512 * j) + lane);
            xb[j] = *((const v4u*)(XB + (size_t)mb * D + 512 * j) + lane); mbv[j] = *((const v4u*)(MB + (size_t)mb * D + 512 * j) + lane); }
        thin_row(XB + (size_t)m * D, MB + (size_t)m * D, RS + m, outf ? outf + (size_t)m * D : nullptr, a8 ? a8 + (size_t)(a8perm ? ((m & ~63) | ((m & 3) << 4) | ((m >> 2) & 15)) : m) * D : nullptr, SA + m, g, xa, ma, lane);
        if (has2) thin_row(XB + (size_t)m2 * D, MB + (size_t)m2 * D, RS + m2, outf ? outf + (size_t)m2 * D : nullptr, a8 ? a8 + (size_t)(a8perm ? ((m2 & ~63) | ((m2 & 3) << 4) | ((m2 >> 2) & 15)) : m2) * D : nullptr, SA + m2, g, xb, mbv, lane);
    }
}
__device__ __forceinline__ void conv_fix_local(const Params& p, int layer, bf16* H, int nrows, int G, int bid, int wv) {
    const int tid = otid(wv);
    const float* halo = (const float*)(p.ws + WS_HALO);
    const float* cw = p.conv_w + (size_t)layer * 3 * FF; const float* cb = p.conv_b + (size_t)layer * FF; const float* sw = (const float*)(p.ws + WS_WSC) + layer * 2 * FF;
    pg8::StaticOrder S; S.init(nrows, D, G, bid); pg8::Unit u;
    for (int i = 0; S.next(i, u); ++i) {
        const int pm = u.pm; if ((pm & 7) == 0) continue;
        float ov[11];
#pragma unroll
        for (int q = 0; q < 11; ++q) { const int e = tid + 512 * q; const int j = e >= FF ? 1 : 0, f = e - j * FF, pn = f >> 7, c = f & 127;
            const float* cur = halo + ((size_t)pm * 22 + pn) * 768; const float* prv = halo + ((size_t)(pm - 1) * 22 + pn) * 768;
            const float g0 = cur[(2 + j) * 128 + c], gm1 = j ? cur[2 * 128 + c] : prv[128 + c], gm2 = j ? prv[128 + c] : prv[c], v = cur[(4 + j) * 128 + c];
            const float cv = cb[f] + sw[f] * (cw[f] * gm2 + cw[FF + f] * gm1 + cw[2 * FF + f] * g0);
            ov[q] = pg8::gelu_tanh_mul(cv, v * sw[FF + f]); }
#pragma unroll
        for (int q = 0; q < 11; ++q) { const int e = tid + 512 * q; const int j = e >= FF ? 1 : 0, f = e - j * FF; H[(size_t)(pm * 256 + j) * FF + f] = (bf16)f2bf(ov[q]); }
    }
    asm volatile("s_waitcnt vmcnt(0)" ::: "memory"); __syncthreads();
}

__device__ __forceinline__ void ph_gn_stats(const Params& p, int G, int bid, int wv) {
    const int tid = otid(wv), lane = tid & 63, wave = tid >> 6, gw = bid * 8 + wave, NGW = G * 8;
    const bf16* Y = (const bf16*)p.out; float* GS = (float*)(p.ws + WS_GS);
    for (int row = gw; row < M_ALL; row += NGW) {
        v4u yv[4];
#pragma unroll
        for (int hd = 0; hd < 4; ++hd) yv[hd] = *((const v4u*)(Y + (size_t)row * 2048 + hd * 512) + lane);
        float mu4[4], rs4[4];
#pragma unroll
        for (int hd = 0; hd < 4; ++hd) {
            float y[8];
#pragma unroll
            for (int e = 0; e < 4; ++e) { y[2 * e] = __uint_as_float(yv[hd][e] << 16); y[2 * e + 1] = __uint_as_float(yv[hd][e] & 0xffff0000u); }
            float s = 0.f;
#pragma unroll
            for (int e = 0; e < 8; ++e) s += y[e];
            const float mu = wave_sum(s) * (1.0f / 512.0f); float q = 0.f;
#pragma unroll
            for (int e = 0; e < 8; ++e) { const float d = y[e] - mu; q += d * d; }
            mu4[hd] = mu; rs4[hd] = 1.0f / sqrtf(wave_sum(q) * (1.0f / 512.0f) + GN_EPS);
        }
        if (lane == 0) { *(f32x4*)(GS + (size_t)row * 8) = (f32x4){mu4[0], rs4[0], mu4[1], rs4[1]}; *(f32x4*)(GS + (size_t)row * 8 + 4) = (f32x4){mu4[2], rs4[2], mu4[3], rs4[3]}; }
    }
}

typedef float f32x16 __attribute__((ext_vector_type(16)));
typedef short s16x8 __attribute__((ext_vector_type(8)));
typedef float af2 __attribute__((ext_vector_type(2)));
constexpr float RESCALE_THR = 8.0f;
typedef short s16x4 __attribute__((ext_vector_type(4)));
__device__ __forceinline__ int vt_off(int row, int ch) { return 1024 * (row >> 3) + 512 * (ch >> 2) + 64 * (row & 7) + 16 * ((ch & 3) ^ ((row >> 2) & 3)); }
__device__ __forceinline__ unsigned cvtpk(float lo, float hi) { return pg8::cvt_pk_bf16(lo, hi); }


template <int DIL>
__device__ __forceinline__ void attn_group(const s16x8 (&qf)[4], const bf16* kbase  , int qpos, int ntiles, int base, int n_inner, int step_inner, int step_outer, int n_win, int first_causal,
                                           f32x16& o0, f32x16& o1, float& m, float& lsum, LAS unsigned char* vbuf, int lane,
                                           v4u (&kc)[4], v4u (&vc)[4]  , const bf16* nsrc  ) {
    const int r32 = lane & 31, hi = lane >> 5;
    constexpr float C2 = 0.125f * 1.4426950408889634f;
    const int vrow = lane >> 3, vch = lane & 7;
    int woff[4];
#pragma unroll
    for (int i = 0; i < 4; ++i) woff[i] = vt_off(vrow + 8 * i, vch);
    const int g1 = (lane >> 4) & 1, q4 = (lane >> 2) & 3, pp = lane & 3;
    int ca = 0, cj = 0, kp_cur = base;
    for (int u = 0; u < ntiles; ++u) {
        const int kp0 = kp_cur, cj_cur = cj;
        int nj = cj + 1, na = ca; if (nj == n_inner) { nj = 0; na = ca + 1; }
        const bool more = u + 1 < ntiles; const int kpn = more ? base + na * step_outer + nj * step_inner : kp0;
        ca = na; cj = nj; kp_cur = kpn;
        LAS unsigned char* kb = vbuf; LAS unsigned char* vb = kb + 4096;
#pragma unroll
        for (int i = 0; i < 4; ++i) { *(LAS v4u*)(kb + woff[i]) = kc[i]; *(LAS v4u*)(vb + woff[i]) = vc[i]; }
        __builtin_amdgcn_wave_barrier();
        const int sln = DIL == 1 ? kpn : (DIL == 4 ? (((kpn & 3) << 9) | (kpn >> 2)) : (((kpn & 15) << 7) | (kpn >> 4)));
        const bf16* nb = more ? kbase + (size_t)sln * 64 : nsrc;
#pragma unroll
        for (int i = 0; i < 4; ++i) { const bf16* src = nb + (vrow + 8 * i) * 64 + 8 * vch; kc[i] = *(const v4u*)src; vc[i] = *(const v4u*)(src + 131072); }
        f32x16 S;
#pragma unroll
        for (int r = 0; r < 16; ++r) S[r] = 0.f;
#pragma unroll
        for (int s = 0; s < 4; ++s) { const s16x8 kf = *(LAS s16x8*)(kb + vt_off(r32, 2 * s + hi)); S = __builtin_amdgcn_mfma_f32_32x32x16_bf16(kf, qf[s], S, 0, 0, 0); }
        const bool t_causal = (DIL == 16) ? (cj_cur == n_inner - 1) : (u >= first_causal);
        const int dbase = qpos - kp0 - 4 * hi * DIL;
        bool lv = true; if (DIL == 16) lv = (dbase & 15) == 0;
        if (t_causal) { const int a = (DIL == 16) ? (lv ? dbase : -1) : dbase;
#pragma unroll
            for (int r = 0; r < 16; ++r) { const int kr = ((r & 3) + 8 * (r >> 2)) * DIL; S[r] = (kr <= a) ? S[r] : -INFINITY; }
        } else if (u < n_win) { const int bw = dbase - 128 * DIL;
#pragma unroll
            for (int r = 0; r < 16; ++r) { const int kr = ((r & 3) + 8 * (r >> 2)) * DIL; S[r] = (kr >= bw) ? S[r] : -INFINITY; }
        }
        float tmax = S[0];
#pragma unroll
        for (int r = 1; r < 16; ++r) tmax = fmaxf(tmax, S[r]);
        const bool pmask = (DIL == 16) && !t_causal;
        if (pmask) tmax = lv ? tmax : -INFINITY;
        tmax = xmax32(tmax);
        const float mnew = fmaxf(m, tmax * C2);
        if (__builtin_amdgcn_ballot_w64(mnew > m + RESCALE_THR) != 0) {
            const float alpha = __builtin_amdgcn_exp2f(m - mnew); m = mnew; lsum *= alpha;
#pragma unroll
            for (int r = 0; r < 16; ++r) { o0[r] *= alpha; o1[r] *= alpha; }
        }
        float ps;
        { af2 ps2 = {0.f, 0.f}; const af2 c2 = {C2, C2}, nm = {-m, -m};
#pragma unroll
          for (int r = 0; r < 16; r += 2) { const af2 a = (af2){S[r], S[r + 1]} * c2 + nm; af2 ev; ev.x = __builtin_amdgcn_exp2f(a.x); ev.y = __builtin_amdgcn_exp2f(a.y); S[r] = ev.x; S[r + 1] = ev.y; ps2 += ev; }
          ps = ps2.x + ps2.y; }
        if (pmask) ps = lv ? ps : 0.f;
        lsum += ps;
        s16x8 pb[2];
#pragma unroll
        for (int s = 0; s < 2; ++s) { v4u w; w.x = cvtpk(S[8 * s + 0], S[8 * s + 1]); w.y = cvtpk(S[8 * s + 2], S[8 * s + 3]); w.z = cvtpk(S[8 * s + 4], S[8 * s + 5]); w.w = cvtpk(S[8 * s + 6], S[8 * s + 7]);
            if (pmask) { const unsigned lm = lv ? 0xffffffffu : 0u; w.x &= lm; w.y &= lm; w.z &= lm; w.w &= lm; }
            pb[s] = __builtin_bit_cast(s16x8, w); }
#pragma unroll
        for (int dt = 0; dt < 2; ++dt)
#pragma unroll
            for (int s = 0; s < 2; ++s) {
                s16x4 lo = __builtin_amdgcn_ds_read_tr16_b64_v4i16((LAS s16x4*)(vb + vt_off(16 * s + 4 * hi + q4, 4 * dt + 2 * g1 + (pp >> 1)) + 8 * (pp & 1)));
                s16x4 hi4 = __builtin_amdgcn_ds_read_tr16_b64_v4i16((LAS s16x4*)(vb + vt_off(16 * s + 8 + 4 * hi + q4, 4 * dt + 2 * g1 + (pp >> 1)) + 8 * (pp & 1)));
                const s16x8 va = (s16x8){lo[0], lo[1], lo[2], lo[3], hi4[0], hi4[1], hi4[2], hi4[3]};
                if (dt == 0) o0 = __builtin_amdgcn_mfma_f32_32x32x16_bf16(va, pb[s], o0, 0, 0, 0);
                else o1 = __builtin_amdgcn_mfma_f32_32x32x16_bf16(va, pb[s], o1, 0, 0, 0);
            }
    }
    asm volatile("s_waitcnt lgkmcnt(0)" ::: "memory"); __builtin_amdgcn_wave_barrier();
}
__device__ __forceinline__ void attn_pair0(const s16x8 (&qa)[4], const s16x8 (&qb)[4], const bf16* kbase, int qposA, int ntiles, int base, int n_win, bool rot  ,
                                           f32x16& a0, f32x16& a1, float& ma, float& la, f32x16& b0, f32x16& b1, float& mb, float& lb,
                                           LAS unsigned char* vbuf, int lane, v4u (&kc)[4], v4u (&vc)[4], const bf16* nsrc) {
    const int r32 = lane & 31, hi = lane >> 5;
    constexpr float C2 = 0.125f * 1.4426950408889634f;
    const int vrow = lane >> 3, vch = lane & 7;
    int woff[4];
#pragma unroll
    for (int i = 0; i < 4; ++i) woff[i] = vt_off(vrow + 8 * i, vch);
    const int g1 = (lane >> 4) & 1, q4 = (lane >> 2) & 3, pp = lane & 3;
    for (int v = 0; v < ntiles; ++v) {
        const int u = rot ? ((v + 4) & 7) : v, un = rot ? ((v + 5) & 7) : v + 1;
        const int kp0 = base + 32 * u; const bool more = v + 1 < ntiles;
        LAS unsigned char* kb = vbuf; LAS unsigned char* vb = kb + 4096;
#pragma unroll
        for (int i = 0; i < 4; ++i) { *(LAS v4u*)(kb + woff[i]) = kc[i]; *(LAS v4u*)(vb + woff[i]) = vc[i]; }
        __builtin_amdgcn_wave_barrier();
        const bf16* nb = more ? kbase + (size_t)(base + 32 * un) * 64 : nsrc;
#pragma unroll
        for (int i = 0; i < 4; ++i) { const bf16* src = nb + (vrow + 8 * i) * 64 + 8 * vch; kc[i] = *(const v4u*)src; vc[i] = *(const v4u*)(src + 131072); }
        f32x16 SA, SB;
#pragma unroll
        for (int r = 0; r < 16; ++r) { SA[r] = 0.f; SB[r] = 0.f; }
#pragma unroll
        for (int s = 0; s < 4; ++s) { const s16x8 kf = *(LAS s16x8*)(kb + vt_off(r32, 2 * s + hi));
            SA = __builtin_amdgcn_mfma_f32_32x32x16_bf16(kf, qa[s], SA, 0, 0, 0); SB = __builtin_amdgcn_mfma_f32_32x32x16_bf16(kf, qb[s], SB, 0, 0, 0); }
        const int dA = qposA - kp0 - 4 * hi;
        if (u >= n_win) {
#pragma unroll
            for (int r = 0; r < 16; ++r) { const int kr = (r & 3) + 8 * (r >> 2); SA[r] = (kr <= dA) ? SA[r] : -INFINITY; SB[r] = (kr <= dA + 1) ? SB[r] : -INFINITY; }
        } else { const int bw = dA - 128;
#pragma unroll
            for (int r = 0; r < 16; ++r) { const int kr = (r & 3) + 8 * (r >> 2); SA[r] = (kr >= bw) ? SA[r] : -INFINITY; SB[r] = (kr >= bw + 1) ? SB[r] : -INFINITY; }
        }
        float tA = SA[0], tB = SB[0];
#pragma unroll
        for (int r = 1; r < 16; ++r) { tA = fmaxf(tA, SA[r]); tB = fmaxf(tB, SB[r]); }
        tA = xmax32(tA); tB = xmax32(tB);
        const float mnA = fmaxf(ma, tA * C2), mnB = fmaxf(mb, tB * C2);
        if (__builtin_amdgcn_ballot_w64((mnA > ma + RESCALE_THR) | (mnB > mb + RESCALE_THR)) != 0) {
            const float alA = __builtin_amdgcn_exp2f(ma - mnA), alB = __builtin_amdgcn_exp2f(mb - mnB); ma = mnA; mb = mnB; la *= alA; lb *= alB;
#pragma unroll
            for (int r = 0; r < 16; ++r) { a0[r] *= alA; a1[r] *= alA; b0[r] *= alB; b1[r] *= alB; }
        }
        float psA, psB;
        { af2 pa2 = {0.f, 0.f}, pb2 = {0.f, 0.f}; const af2 c2 = {C2, C2}, nma = {-ma, -ma}, nmb = {-mb, -mb};
#pragma unroll
          for (int r = 0; r < 16; r += 2) {
              const af2 xa = (af2){SA[r], SA[r + 1]} * c2 + nma; af2 ea; ea.x = __builtin_amdgcn_exp2f(xa.x); ea.y = __builtin_amdgcn_exp2f(xa.y); SA[r] = ea.x; SA[r + 1] = ea.y; pa2 += ea;
              const af2 xb = (af2){SB[r], SB[r + 1]} * c2 + nmb; af2 eb; eb.x = __builtin_amdgcn_exp2f(xb.x); eb.y = __builtin_amdgcn_exp2f(xb.y); SB[r] = eb.x; SB[r + 1] = eb.y; pb2 += eb; }
          psA = pa2.x + pa2.y; psB = pb2.x + pb2.y; }
        la += psA; lb += psB;
        s16x8 pa[2], pb[2];
#pragma unroll
        for (int s = 0; s < 2; ++s) { v4u w; w.x = cvtpk(SA[8 * s + 0], SA[8 * s + 1]); w.y = cvtpk(SA[8 * s + 2], SA[8 * s + 3]); w.z = cvtpk(SA[8 * s + 4], SA[8 * s + 5]); w.w = cvtpk(SA[8 * s + 6], SA[8 * s + 7]); pa[s] = __builtin_bit_cast(s16x8, w);
            v4u x; x.x = cvtpk(SB[8 * s + 0], SB[8 * s + 1]); x.y = cvtpk(SB[8 * s + 2], SB[8 * s + 3]); x.z = cvtpk(SB[8 * s + 4], SB[8 * s + 5]); x.w = cvtpk(SB[8 * s + 6], SB[8 * s + 7]); pb[s] = __builtin_bit_cast(s16x8, x); }
#pragma unroll
        for (int dt = 0; dt < 2; ++dt)
#pragma unroll
            for (int s = 0; s < 2; ++s) {
                s16x4 lo = __builtin_amdgcn_ds_read_tr16_b64_v4i16((LAS s16x4*)(vb + vt_off(16 * s + 4 * hi + q4, 4 * dt + 2 * g1 + (pp >> 1)) + 8 * (pp & 1)));
                s16x4 hi4 = __builtin_amdgcn_ds_read_tr16_b64_v4i16((LAS s16x4*)(vb + vt_off(16 * s + 8 + 4 * hi + q4, 4 * dt + 2 * g1 + (pp >> 1)) + 8 * (pp & 1)));
                const s16x8 va = (s16x8){lo[0], lo[1], lo[2], lo[3], hi4[0], hi4[1], hi4[2], hi4[3]};
                if (dt == 0) { a0 = __builtin_amdgcn_mfma_f32_32x32x16_bf16(va, pa[s], a0, 0, 0, 0); b0 = __builtin_amdgcn_mfma_f32_32x32x16_bf16(va, pb[s], b0, 0, 0, 0); }
                else { a1 = __builtin_amdgcn_mfma_f32_32x32x16_bf16(va, pa[s], a1, 0, 0, 0); b1 = __builtin_amdgcn_mfma_f32_32x32x16_bf16(va, pb[s], b1, 0, 0, 0); }
            }
    }
    asm volatile("s_waitcnt lgkmcnt(0)" ::: "memory"); __builtin_amdgcn_wave_barrier();
}
__device__ __forceinline__ void tile_first(const bf16* krows, v4u (&kc)[4], v4u (&vc)[4], int lane) {
    const int vrow = lane >> 3, vch = lane & 7;
#pragma unroll
    for (int i = 0; i < 4; ++i) { const bf16* src = krows + (vrow + 8 * i) * 64 + 8 * vch; kc[i] = *(const v4u*)src; vc[i] = *(const v4u*)(src + 131072); }
}

__device__ __forceinline__ void ph_attn_g2(const Params& p, LAS unsigned char* lds, int G, int bid, int wv) {
    const int tid = otid(wv), lane = tid & 63, wave = __builtin_amdgcn_readfirstlane(tid >> 6);
    const int r32 = lane & 31, hi = lane >> 5;
    const bf16* Qb = (const bf16*)(p.ws + WS_Q); const bf16* KV = (const bf16*)(p.ws + WS_BIG); bf16* O2 = (bf16*)((unsigned char*)p.out + 192 * MiB); float* ML = (float*)(p.ws + WS_GS);
    LAS unsigned char* vbuf = lds + wave * 16384;
    const int vcu = (bid & 7) * (G >> 3) + (bid >> 3);
    const int NW = G * 8, gw = vcu * 8 + wave;
    v4u kc[4], vc[4];
    s16x8 qf[4];
    { const int x = gw >> 2, r16 = x & 15, bh = x >> 4, t0 = gw & 3; tile_first(KV + ((size_t)((bh >> 4) * 48 + 32 + (bh & 15)) * 2 * 2048 + r16 * 128) * 64, kc, vc, lane);
      const bf16* q0 = Qb + ((size_t)((bh >> 4) * 48 + 32 + (bh & 15)) * 2048 + r16 * 128 + 32 * t0 + r32) * 64 + 8 * hi;
#pragma unroll
      for (int s = 0; s < 4; ++s) qf[s] = *(const s16x8*)(q0 + 16 * s); }
    for (int T = gw, k = 0; T < 16 * 16 * 16 * 4; T += NW, ++k) {
        const int traw = T & 3, t = (k & 1) ? 3 - traw : traw, x = T >> 2, r16 = x & 15, bh = x >> 4, h = bh & 15, b = bh >> 4;
        const int bhn = (T + NW < 16 * 16 * 16 * 4) ? bh + (NW >> 6) : bh;
        const bf16* nsrc = KV + ((size_t)((bhn >> 4) * 48 + 32 + (bhn & 15)) * 2 * 2048 + r16 * 128) * 64;
        const int qpos = r16 + 16 * (32 * t + r32); const size_t brow = (size_t)b * SEQ;
        f32x16 o0, o1;
#pragma unroll
        for (int r = 0; r < 16; ++r) { o0[r] = 0.f; o1[r] = 0.f; }
        float m = -1.0e30f, lsum = 0.f;
        const bf16* kb = KV + (size_t)(b * 48 + 32 + h) * 2 * 131072;
        const int tn = (T + NW < 16 * 16 * 16 * 4) ? 3 - t : t;
        const bf16* qn = Qb + ((size_t)((bhn >> 4) * 48 + 32 + (bhn & 15)) * 2048 + r16 * 128 + 32 * tn + r32) * 64 + 8 * hi;
        s16x8 qfn[4];
#pragma unroll
        for (int s = 0; s < 4; ++s) qfn[s] = *(const s16x8*)(qn + 16 * s);
        attn_group<16>(qf, kb, qpos, t + 1, r16, t + 1, 512, 0, 0, 0, o0, o1, m, lsum, vbuf, lane, kc, vc, nsrc);
        const float l = xsum32(lsum);
        bf16* orow = O2 + ((size_t)bh * 2048 + r16 * 128 + 32 * t + r32) * 64 + 4 * hi;
#pragma unroll
        for (int rg = 0; rg < 4; ++rg) {
            v2u w0; w0.x = cvtpk(o0[4 * rg], o0[4 * rg + 1]); w0.y = cvtpk(o0[4 * rg + 2], o0[4 * rg + 3]); *(v2u*)(orow + 8 * rg) = w0;
            v2u w1; w1.x = cvtpk(o1[4 * rg], o1[4 * rg + 1]); w1.y = cvtpk(o1[4 * rg + 2], o1[4 * rg + 3]); *(v2u*)(orow + 32 + 8 * rg) = w1;
        }
        if (hi == 0) { float* ml = ML + ((size_t)((bh * 16 + r16) * 128 + 32 * t + r32)) * 2; v2u w; w.x = __float_as_uint(m); w.y = __float_as_uint(l); *(v2u*)ml = w; }
#pragma unroll
        for (int s = 0; s < 4; ++s) qf[s] = qfn[s];
    }
}
__device__ __forceinline__ void y_state(const bf16* o2, const float* ml, int hi, f32x16& o0, f32x16& o1, float& m, float& l) {
#pragma unroll
    for (int rg = 0; rg < 4; ++rg) { const v2u w0 = *(const v2u*)(o2 + 8 * rg), w1 = *(const v2u*)(o2 + 32 + 8 * rg);
        o0[4 * rg] = __uint_as_float(w0.x << 16); o0[4 * rg + 1] = __uint_as_float(w0.x & 0xffff0000u); o0[4 * rg + 2] = __uint_as_float(w0.y << 16); o0[4 * rg + 3] = __uint_as_float(w0.y & 0xffff0000u);
        o1[4 * rg] = __uint_as_float(w1.x << 16); o1[4 * rg + 1] = __uint_as_float(w1.x & 0xffff0000u); o1[4 * rg + 2] = __uint_as_float(w1.y << 16); o1[4 * rg + 3] = __uint_as_float(w1.y & 0xffff0000u); }
    const v2u mlv = *(const v2u*)ml; m = __uint_as_float(mlv.x); l = hi == 0 ? __uint_as_float(mlv.y) : 0.f;
}
__device__ __forceinline__ void y_store(bf16* orow0  , int hi, const f32x16& o0, const f32x16& o1, float lsum) {
    const float l = xsum32(lsum); const float inv = 1.0f / l;
#pragma unroll
    for (int pr2 = 0; pr2 < 2; ++pr2) {
        { const unsigned ax = cvtpk(o0[8 * pr2] * inv, o0[8 * pr2 + 1] * inv), ay = cvtpk(o0[8 * pr2 + 2] * inv, o0[8 * pr2 + 3] * inv), bx = cvtpk(o0[8 * pr2 + 4] * inv, o0[8 * pr2 + 5] * inv), by = cvtpk(o0[8 * pr2 + 6] * inv, o0[8 * pr2 + 7] * inv);
          auto sx = __builtin_amdgcn_permlane32_swap(ax, bx, false, false); auto sy = __builtin_amdgcn_permlane32_swap(ay, by, false, false);
          v4u w; w.x = sx[0]; w.y = sy[0]; w.z = sx[1]; w.w = sy[1]; *(v4u*)(orow0 + 16 * pr2 + 8 * hi) = w; }
        { const unsigned ax = cvtpk(o1[8 * pr2] * inv, o1[8 * pr2 + 1] * inv), ay = cvtpk(o1[8 * pr2 + 2] * inv, o1[8 * pr2 + 3] * inv), bx = cvtpk(o1[8 * pr2 + 4] * inv, o1[8 * pr2 + 5] * inv), by = cvtpk(o1[8 * pr2 + 6] * inv, o1[8 * pr2 + 7] * inv);
          auto sx = __builtin_amdgcn_permlane32_swap(ax, bx, false, false); auto sy = __builtin_amdgcn_permlane32_swap(ay, by, false, false);
          v4u w; w.x = sx[0]; w.y = sy[0]; w.z = sx[1]; w.w = sy[1]; *(v4u*)(orow0 + 32 + 16 * pr2 + 8 * hi) = w; }
    }
}
constexpr int HO_O2 = 65536, HO_ML = 132096;
__device__ __forceinline__ void y_state_lds(const LAS unsigned char* o2, int sw7  , const LAS unsigned char* ml, int hi, f32x16& o0, f32x16& o1, float& m, float& l) {
#pragma unroll
    for (int rg = 0; rg < 4; ++rg) { const v2u w0 = *(const LAS v2u*)(o2 + 16 * (rg ^ sw7)), w1 = *(const LAS v2u*)(o2 + 16 * ((4 + rg) ^ sw7));
        o0[4 * rg] = __uint_as_float(w0.x << 16); o0[4 * rg + 1] = __uint_as_float(w0.x & 0xffff0000u); o0[4 * rg + 2] = __uint_as_float(w0.y << 16); o0[4 * rg + 3] = __uint_as_float(w0.y & 0xffff0000u);
        o1[4 * rg] = __uint_as_float(w1.x << 16); o1[4 * rg + 1] = __uint_as_float(w1.x & 0xffff0000u); o1[4 * rg + 2] = __uint_as_float(w1.y << 16); o1[4 * rg + 3] = __uint_as_float(w1.y & 0xffff0000u); }
    const v2u mlv = *(const LAS v2u*)ml; m = __uint_as_float(mlv.x); l = hi == 0 ? __uint_as_float(mlv.y) : 0.f;
}
__device__ __forceinline__ void ph_attn_xy(const Params& p, LAS unsigned char* lds, int G, int bid, int wv) {
    const int tid = otid(wv), lane = tid & 63, wave = __builtin_amdgcn_readfirstlane(tid >> 6);
    const int r32 = lane & 31, hi = lane >> 5;
    const bf16* Qb = (const bf16*)(p.ws + WS_Q); const bf16* KV = (const bf16*)(p.ws + WS_BIG); bf16* O = (bf16*)(p.ws + WS_O); bf16* O2 = (bf16*)((unsigned char*)p.out + 192 * MiB); float* ML = (float*)(p.ws + WS_GS);
    LAS unsigned char* vbuf = lds + wave * 8192;
    const int vcu = (bid & 7) * (G >> 3) + (bid >> 3);
    const int NW = G * 8, gw = vcu * 8 + wave;
    constexpr int NT = 16 * 16 * 16 * 2;
    v4u kc[4], vc[4];
    { const int bh = (gw >> 1) >> 4; tile_first(KV + ((size_t)((bh >> 4) * 48 + 32 + (bh & 15)) * 2 * 2048 + wave * 128) * 64, kc, vc, lane); }
    for (int T = gw, k = 0; T < NT; T += NW, ++k) {
        const int pr = T & 1, x = T >> 1, craw = x & 15, bh = x >> 4, c = (k & 1) ? 15 - craw : craw, h = bh & 15, b = bh >> 4;
        const int jq = c >> 2;
        const bf16* kb = KV + (size_t)(b * 48 + h) * 2 * 131072; const bf16* kb1 = kb + (size_t)16 * 2 * 131072; const bf16* kb2 = kb + (size_t)32 * 2 * 131072;
        const int j0 = (c == 0) ? 4 : 0, j1 = (4 - c) > 0 ? (4 - c) : 0;
        for (int xi = 0; xi < 2; ++xi) {
            const int r16 = wave + 8 * xi, qpos = r16 + 16 * (32 * jq + r32);
            const bf16* qrow = Qb + ((size_t)(b * 48 + 32 + h) * 2048 + r16 * 128 + 32 * jq + r32) * 64 + 8 * hi;
            s16x8 qf[4];
#pragma unroll
            for (int s = 0; s < 4; ++s) qf[s] = *(const s16x8*)(qrow + 16 * s);
            f32x16 o0, o1;
#pragma unroll
            for (int r = 0; r < 16; ++r) { o0[r] = 0.f; o1[r] = 0.f; }
            float m = -1.0e30f, lsum = 0.f;
            const bf16* nsrc = xi == 0 ? kb2 + (size_t)((wave + 8) * 128) * 64 : kb + (size_t)((c & 1) ? 128 * c : 128 * c - 128 + 32 * j0) * 64;
            attn_group<16>(qf, kb2, qpos, jq + 1, r16, jq + 1, 512, 0, 0, 0, o0, o1, m, lsum, vbuf, lane, kc, vc, nsrc);
            const float l = xsum32(lsum);
            LAS unsigned char* orow = lds + HO_O2 + (r16 * 32 + r32) * 128 + 8 * hi; const int sw7 = r32 & 7;
#pragma unroll
            for (int rg = 0; rg < 4; ++rg) {
                v2u w0; w0.x = cvtpk(o0[4 * rg], o0[4 * rg + 1]); w0.y = cvtpk(o0[4 * rg + 2], o0[4 * rg + 3]); *(LAS v2u*)(orow + 16 * (rg ^ sw7)) = w0;
                v2u w1; w1.x = cvtpk(o1[4 * rg], o1[4 * rg + 1]); w1.y = cvtpk(o1[4 * rg + 2], o1[4 * rg + 3]); *(LAS v2u*)(orow + 16 * ((4 + rg) ^ sw7)) = w1;
            }
            if (hi == 0) { v2u w; w.x = __float_as_uint(m); w.y = __float_as_uint(l); *(LAS v2u*)(lds + HO_ML + (r16 * 32 + r32) * 8) = w; }
        }
        asm volatile("s_waitcnt lgkmcnt(0)" ::: "memory"); __syncthreads();
        const bool hasn = T + NW < NT; const int bhn = hasn ? bh + (NW >> 5) : bh;
        const bf16* nsrc_task = KV + ((size_t)((bhn >> 4) * 48 + 32 + (bhn & 15)) * 2 * 2048 + wave * 128) * 64;
        const int qposA = 128 * c + 2 * pr + 4 * r32, qposB = qposA + 1; const size_t brow = (size_t)b * SEQ;
        const bf16* qrowA = Qb + ((size_t)(b * 48 + h) * 2048 + (2 * pr) * 512 + 32 * c + r32) * 64 + 8 * hi;
        s16x8 qa[4], qb[4], q1a[4], q1b[4];
#pragma unroll
        for (int s = 0; s < 4; ++s) { qa[s] = *(const s16x8*)(qrowA + 16 * s); qb[s] = *(const s16x8*)(qrowA + 512 * 64 + 16 * s); }
        f32x16 a0, a1, b0, b1; float ma, la, mb, lb;
        { const int rowA = (qposA & 15) * 32 + (qposA >> 4) - 32 * jq, rowB = (qposB & 15) * 32 + (qposB >> 4) - 32 * jq;
          y_state_lds(lds + HO_O2 + rowA * 128 + 8 * hi, rowA & 7, lds + HO_ML + rowA * 8, hi, a0, a1, ma, la);
          y_state_lds(lds + HO_O2 + rowB * 128 + 8 * hi, rowB & 7, lds + HO_ML + rowB * 8, hi, b0, b1, mb, lb); }
        asm volatile("s_waitcnt lgkmcnt(0)" ::: "memory"); __syncthreads();
        const int s1 = 32 * c - 128 + 32 * j1;
        attn_pair0(qa, qb, kb, qposA, 8 - j0, 128 * c - 128 + 32 * j0, 4 - j0, (c & 1) != 0, a0, a1, ma, la, b0, b1, mb, lb, vbuf, lane, kc, vc, kb1 + (size_t)((2 * pr) * 512 + s1) * 64);
#pragma unroll
        for (int s = 0; s < 4; ++s) { q1a[s] = *(const s16x8*)(qrowA + (size_t)16 * 131072 + 16 * s); q1b[s] = *(const s16x8*)(qrowA + (size_t)16 * 131072 + 512 * 64 + 16 * s); }
        attn_group<4>(q1a, kb1, qposA, 5 - j1, 2 * pr + 4 * s1, 8, 128, 0, j1 == 0 ? 1 : 0, 4 - j1, a0, a1, ma, la, vbuf, lane, kc, vc, kb1 + (size_t)((2 * pr + 1) * 512 + s1) * 64);
        y_store(O + (brow + qposA) * D + h * 64, hi, a0, a1, la);
        attn_group<4>(q1b, kb1, qposB, 5 - j1, 2 * pr + 1 + 4 * s1, 8, 128, 0, j1 == 0 ? 1 : 0, 4 - j1, b0, b1, mb, lb, vbuf, lane, kc, vc, nsrc_task);
        y_store(O + (brow + qposB) * D + h * 64, hi, b0, b1, lb);
    }
}

__device__ __forceinline__ unsigned off_a(unsigned row, unsigned ch) { return 2048u * (row >> 3) + 512u * (ch >> 2) + 64u * (row & 7) + 16u * ((ch & 3) ^ ((row >> 2) & 3)); }
constexpr int RT_BUF = 49152, RT_Q = 0, RT_K = 16384, RT_V = 32768, RT_P0 = 98304, RT_P0SZ = 2048;

__device__ __forceinline__ void ret_stage(LAS unsigned char* lds, int buf, const bf16* rowbase  , const bf16* p0src  , int h, int dvh, int wave, int lane) {
    (void)p0src;
#pragma unroll
    for (int i = 0; i < 6; ++i) {
        const int idx = wave + 8 * i, img = idx >> 4, t = (idx >> 3) & 1, k = idx & 7;
        const int row = 8 * (k >> 1) + ((lane >> 2) & 7), chh = 2 * (k & 1) + (lane >> 5), ch = 4 * chh + ((lane & 3) ^ ((row >> 2) & 3));
        const int plane = img == 0 ? h : (img == 1 ? 4 + h : 8 + 2 * h + dvh);
        const bf16* src = rowbase + ((size_t)plane * 2048 + row) * 256 + 128 * t + 8 * ch;
        __builtin_amdgcn_global_load_lds((const unsigned*)src, (LAS unsigned*)(lds + buf * RT_BUF + img * 16384 + t * 8192 + k * 1024), 16, 0, 0);
    }
}
__device__ __forceinline__ void ph_ret_p0(const Params& p, int G, int bid, int wv) {
    const int tid = otid(wv), lane = tid & 63, wave = tid >> 6, r32 = lane & 31, hi = lane >> 5;
    const bf16* QKV = (const bf16*)(p.ws + WS_BIG); bf16* P0 = (bf16*)(p.ws + WS_P0);
    for (int t = bid * 8 + wave; t < NBATCH * 4 * 64; t += G * 8) {
        const int c = t & 63, h = (t >> 6) & 3, b = t >> 8;
        const bf16* qr = QKV + ((size_t)(b * 16 + h) * 2048 + c * 32 + r32) * 256 + 8 * hi;
        const bf16* kr = qr + (size_t)4 * 2048 * 256;
        f32x16 S;
#pragma unroll
        for (int r = 0; r < 16; ++r) S[r] = 0.f;
#pragma unroll
        for (int s = 0; s < 16; ++s) { const s16x8 a = *(const s16x8*)(kr + 16 * s), bq = *(const s16x8*)(qr + 16 * s); S = __builtin_amdgcn_mfma_f32_32x32x16_bf16(a, bq, S, 0, 0, 0); }
        bf16* dst = P0 + (size_t)t * 1024 + r32 * 32;
#pragma unroll
        for (int rg = 0; rg < 4; ++rg) { float v[4];
#pragma unroll
            for (int e = 0; e < 4; ++e) { const int key = e + 8 * rg + 4 * hi; v[e] = key <= r32 ? S[4 * rg + e] : 0.f; }
            v2u w; w.x = cvtpk(v[0], v[1]); w.y = cvtpk(v[2], v[3]);
            *(v2u*)(dst + 8 * rg + 4 * hi) = w; }
    }
}
__device__ __forceinline__ void ph_retention(const Params& p, LAS unsigned char* lds, int G, int bid, int wv) {
    const int tid = otid(wv), lane = tid & 63, wave = __builtin_amdgcn_readfirstlane(tid >> 6), r32 = lane & 31, hi = lane >> 5;
    const bf16* QKV = (const bf16*)(p.ws + WS_BIG); bf16* Y = (bf16*)p.out;
    const unsigned blk = (lane >> 4) & 1, q4 = (lane & 15) >> 2, pp = lane & 3;
    const unsigned xq = (r32 >> 2) & 3, lq = 2048u * (r32 >> 3) + 64u * (r32 & 7) + 8u * hi;
    const unsigned ltr = 2048u * hi + 64u * q4 + 8u * (pp & 1), ctr = 2u * blk + (pp >> 1);
    for (int ub = bid; ub < NBATCH * 8; ub += G) {
        const int unit = 16 * (ub >> 4) + 2 * (ub & 7) + ((ub >> 3) & 1);
        const int dvh = unit & 1, h = (unit >> 1) & 3, b = unit >> 3;
        const float lg = log2f(1.0f - exp2f(-5.0f - (float)h));
        const bf16* base = QKV + (size_t)b * 16 * 2048 * 256;
        bf16* ybase = Y + (size_t)b * SEQ * 2048 + h * 512 + dvh * 256 + wave * 32 + r32;
        f32x16 St[8];
#pragma unroll
        for (int kt = 0; kt < 8; ++kt)
#pragma unroll
            for (int r = 0; r < 16; ++r) St[kt][r] = 0.f;
        __syncthreads();
        const bf16* p0b = (const bf16*)(p.ws + WS_P0) + (size_t)((b * 4 + h) * 64) * 1024;
        ret_stage(lds, 0, base, p0b, h, dvh, wave, lane);
        asm volatile("s_waitcnt vmcnt(0) lgkmcnt(0)" ::: "memory");
        __syncthreads();
        for (int c = 0; c < SEQ / 32; ++c) {
            const int buf = c & 1;
            if (c + 1 < SEQ / 32) {
                ret_stage(lds, buf ^ 1, base + (size_t)(c + 1) * 32 * 256, p0b + (size_t)(c + 1) * 1024, h, dvh, wave, lane);
            }
            float lgc = lg; asm volatile("" : "+v"(lgc));
            LAS unsigned char* Lb = lds + buf * RT_BUF;
            LAS unsigned char* Lp = lds + RT_P0 + buf * RT_P0SZ + r32 * 64 + 16 * hi;
            LAS unsigned char* q0 = Lb + RT_Q + lq + 16u * (0u ^ xq); LAS unsigned char* q1 = Lb + RT_Q + lq + 16u * (1u ^ xq);
            LAS unsigned char* q2 = Lb + RT_Q + lq + 16u * (2u ^ xq); LAS unsigned char* q3 = Lb + RT_Q + lq + 16u * (3u ^ xq);
            LAS unsigned char* k0 = Lb + RT_K + ltr + 16u * (ctr ^ (2u * hi)); LAS unsigned char* k1 = Lb + RT_K + ltr + 16u * (ctr ^ (2u * hi + 1u));
            LAS unsigned char* v0 = Lb + RT_V + (wave >> 2) * 8192 + (wave & 3) * 512 + ltr + 16u * (ctr ^ (2u * hi)); LAS unsigned char* v1 = Lb + RT_V + (wave >> 2) * 8192 + (wave & 3) * 512 + ltr + 16u * (ctr ^ (2u * hi + 1u));
            s16x8 vf[2];
#pragma unroll
            for (int ks = 0; ks < 2; ++ks) {
                const s16x4 lo = __builtin_amdgcn_ds_read_tr16_b64_v4i16((LAS s16x4*)(v0 + 4096 * ks));
                const s16x4 h4 = __builtin_amdgcn_ds_read_tr16_b64_v4i16((LAS s16x4*)(v1 + 4096 * ks + 256));
                const float w0 = __builtin_amdgcn_exp2f(-(float)(32 * c + 16 * ks + 8 * hi + 1) * lgc), gi = __builtin_amdgcn_exp2f(-lgc);
                float f[8], w = w0;
#pragma unroll
                for (int e = 0; e < 4; ++e) { f[e] = bf2f((unsigned short)lo[e]); f[4 + e] = bf2f((unsigned short)h4[e]); }
#pragma unroll
                for (int j = 0; j < 8; ++j) { f[j] *= w; w *= gi; }
                v4u ww; ww.x = cvtpk(f[0], f[1]); ww.y = cvtpk(f[2], f[3]); ww.z = cvtpk(f[4], f[5]); ww.w = cvtpk(f[6], f[7]); vf[ks] = __builtin_bit_cast(s16x8, ww);
            }
            f32x16 T;
#pragma unroll
            for (int r = 0; r < 16; ++r) T[r] = 0.f;
            if (wave == (c & 7)) {
                constexpr int KQ = RT_K - RT_Q;
#pragma unroll
                for (int kt = 0; kt < 8; ++kt) { const int toff = (kt >> 2) * 8192 + (kt & 3) * 512;
#pragma unroll
                    for (int s = 0; s < 2; ++s) {
                        const v2u qa = *(LAS v2u*)((s ? q2 : q0) + toff), qb = *(LAS v2u*)((s ? q3 : q1) + toff), ka2 = *(LAS v2u*)((s ? q2 : q0) + KQ + toff), kb2 = *(LAS v2u*)((s ? q3 : q1) + KQ + toff);
                        v4u aw; aw.x = ka2.x; aw.y = ka2.y; aw.z = kb2.x; aw.w = kb2.y;
                        v4u bw; bw.x = qa.x; bw.y = qa.y; bw.z = qb.x; bw.w = qb.y;
                        T = __builtin_amdgcn_mfma_f32_32x32x16_bf16(__builtin_bit_cast(s16x8, aw), __builtin_bit_cast(s16x8, bw), T, 0, 0, 0); } }
                LAS unsigned char* Pw = lds + RT_P0 + buf * RT_P0SZ + r32 * 64;
#pragma unroll
                for (int rg = 0; rg < 4; ++rg) { float v[4];
#pragma unroll
                    for (int e = 0; e < 4; ++e) { const int key = e + 8 * rg + 4 * hi; v[e] = key <= r32 ? T[4 * rg + e] : 0.f; }
                    v2u w; w.x = cvtpk(v[0], v[1]); w.y = cvtpk(v[2], v[3]);
                    *(LAS v2u*)(Pw + (8 * rg + 4 * hi) * 2) = w; }
#pragma unroll
                for (int r = 0; r < 16; ++r) T[r] = 0.f;
            }
#pragma unroll
            for (int kt = 0; kt < 8; ++kt) {
                constexpr int dummy = 0; (void)dummy;
                const int toff = (kt >> 2) * 8192 + (kt & 3) * 512;
#pragma unroll
                for (int s = 0; s < 2; ++s) {
                    const v2u qa = *(LAS v2u*)((s ? q2 : q0) + toff), qb = *(LAS v2u*)((s ? q3 : q1) + toff);
                    v4u aw; aw.x = qa.x; aw.y = qa.y; aw.z = qb.x; aw.w = qb.y;
                    v4u bw; bw.x = cvtpk(St[kt][8 * s + 0], St[kt][8 * s + 1]); bw.y = cvtpk(St[kt][8 * s + 2], St[kt][8 * s + 3]); bw.z = cvtpk(St[kt][8 * s + 4], St[kt][8 * s + 5]); bw.w = cvtpk(St[kt][8 * s + 6], St[kt][8 * s + 7]);
                    T = __builtin_amdgcn_mfma_f32_32x32x16_bf16(__builtin_bit_cast(s16x8, aw), __builtin_bit_cast(s16x8, bw), T, 0, 0, 0);
                }
#pragma unroll
                for (int ks = 0; ks < 2; ++ks) {
                    const s16x4 lo = __builtin_amdgcn_ds_read_tr16_b64_v4i16((LAS s16x4*)(k0 + toff + 4096 * ks));
                    const s16x4 h4 = __builtin_amdgcn_ds_read_tr16_b64_v4i16((LAS s16x4*)(k1 + toff + 4096 * ks + 256));
                    const s16x8 ka = (s16x8){lo[0], lo[1], lo[2], lo[3], h4[0], h4[1], h4[2], h4[3]};
                    St[kt] = __builtin_amdgcn_mfma_f32_32x32x16_bf16(ka, vf[ks], St[kt], 0, 0, 0);
                }
            }
            asm volatile("s_waitcnt lgkmcnt(0)" ::: "memory"); __builtin_amdgcn_s_barrier(); asm volatile("" ::: "memory");
#pragma unroll
            for (int ks = 0; ks < 2; ++ks) { const s16x8 a = *(LAS s16x8*)(Lp + 32 * ks); T = __builtin_amdgcn_mfma_f32_32x32x16_bf16(a, vf[ks], T, 0, 0, 0); }
            bf16* yrow = ybase + (size_t)(c * 32) * 2048;
            const float g1 = __builtin_amdgcn_exp2f(lgc); float wq = __builtin_amdgcn_exp2f((float)(32 * c + 4 * hi + 1) * lgc);
#pragma unroll
            for (int rg = 0; rg < 4; ++rg) { float wr_ = wq;
#pragma unroll
                for (int e = 0; e < 4; ++e) { const int q = e + 8 * rg + 4 * hi; yrow[(size_t)q * 2048] = (bf16)f2bf(T[4 * rg + e] * wr_); wr_ *= g1; }
                wq *= __builtin_amdgcn_exp2f(8.0f * lgc); }
            asm volatile("s_waitcnt vmcnt(16) lgkmcnt(0)" ::: "memory");
            __builtin_amdgcn_s_barrier(); asm volatile("" ::: "memory");
        }
        asm volatile("s_waitcnt vmcnt(0)" ::: "memory");
    }
}

constexpr int LDS_BYTES = 147456, LDSCTL_OFF = 131072, MISC_OFF = LDSCTL_OFF + 320, HALO_LDS = LDSCTL_OFF + 1024;
constexpr int CW_BAR = 4096;
__device__ __forceinline__ int opq(int v) { asm volatile("" : "+s"(v)); return v; }
__global__ void __launch_bounds__(512, 2) yoco_fwd(Params p) {
    extern __shared__ __attribute__((aligned(16))) unsigned char lds_raw[];
    LAS unsigned char* lds = (LAS unsigned char*)lds_raw;
    constexpr int G = 256; const int bid = blockIdx.x;
    const int wv = __builtin_amdgcn_readfirstlane((int)threadIdx.x >> 6);
    for (int u = otid(wv); u < 1024 / 4; u += 512) ((LAS unsigned*)(lds + LDSCTL_OFF))[u] = 0u;
    __syncthreads();
    XcdBarrier bar = xcd_barrier_post((unsigned*)(p.ws + WS_CTL) + CW_BAR, (volatile LAS unsigned*)(lds + MISC_OFF) + 8, wv);
#define GRID_BAR() do { XcdBarrier b_ = bar; asm volatile("" : "+s"(b_.x)); asm volatile("" : "+s"(b_.bar)); xcd_barrier(b_); } while (0)
    bf16* WB = (bf16*)(p.ws + WS_W);
    ph_wmax(p, lds, G, opq(bid), wv); GRID_BAR();
    ph_prologue(p, lds, G, opq(bid), wv); GRID_BAR();
    for (int seg = 0; seg < 3; ++seg) {
        const int row0 = seg == 2 ? MC : 0, nrows = seg == 0 ? M_ALL : MC;
        const bf16* XBs = (const bf16*)(p.ws + WS_XB) + (size_t)row0 * D; const float* RSs = (const float*)(p.ws + WS_RS) + row0;
        bf16* MBs = (bf16*)(p.ws + (seg == 0 ? WS_MBF : WS_MB)); bf16* HAs = (bf16*)(p.ws + (seg == 0 ? WS_BIG : WS_Q));
        unsigned char* A8G = (unsigned char*)p.out + 128 * MiB + (size_t)row0 * D;
        unsigned char* A8s = seg == 0 ? p.ws + WS_MB : A8G;
        const float* SAs = (const float*)(p.ws + WS_SA) + row0; const float* WSCp = (const float*)(p.ws + WS_WSC);
        if (seg > 0) { pg8::EpiAttRot8 E{(bf16*)(p.ws + WS_BIG), SAs, WSCp + WSC_KV, (const float*)(p.ws + WS_ACOS), (const float*)(p.ws + WS_ASIN), KVW, 12}; gemm_call<pg8::EpiAttRot8, 2>(lds, (const bf16*)A8G, WB + W_KV, MC, KVW, D, E, G, opq(bid), wv); }
        for (int li = 0; li < 2; ++li) {
            const int layer = (seg == 0 ? 0 : 2) + li;
            if (seg == 0) {
                { pg8::EpiRetIn E{(bf16*)(p.ws + WS_BIG), RSs, (const float*)(p.ws + WS_RCOS), (const float*)(p.ws + WS_RSIN), RQP, 0}; gemm_call(lds, XBs, WB + W_RETIN + (size_t)layer * RET_IN * D, M_ALL, RQP, D, E, G, opq(bid), wv); } GRID_BAR();
                ph_retention(p, lds, G, opq(bid), wv); GRID_BAR();
                { pg8::EpiGate8 E{(bf16*)p.out, SAs, WSCp + WSC_RET + layer * RET_IN + RQP, (LAS float*)(lds + HALO_LDS), p.ret_gn + layer * 2048}; gemm_call_pair<pg8::EpiGate8, 2>(lds, (const bf16*)A8s, WB + W_RETIN + (size_t)layer * RET_IN * D + (size_t)RQP * D, M_ALL, 2048, D, E, G, opq(bid), wv); } GRID_BAR();
                { pg8::EpiRS E{MBs, D, 0}; gemm_call(lds, (const bf16*)p.out, WB + W_RETOUT + (size_t)layer * D * 2048, M_ALL, D, 2048, E, G, opq(bid), wv); } GRID_BAR();
            } else {
                { pg8::EpiAttRot8 E{(bf16*)(p.ws + WS_Q), SAs, WSCp + WSC_Q + (layer - 2) * QW, (const float*)(p.ws + WS_ACOS), (const float*)(p.ws + WS_ASIN), QW, 12}; gemm_call<pg8::EpiAttRot8, 2>(lds, (const bf16*)A8G, (const bf16*)((const unsigned char*)(WB + W_Q) + (size_t)(layer - 2) * QW * D), MC, QW, D, E, G, opq(bid), wv); } GRID_BAR();
                ph_attn_xy(p, lds, G, opq(bid), wv); GRID_BAR();
                { pg8::EpiRS E{MBs, D, 0}; gemm_call(lds, (const bf16*)(p.ws + WS_O), WB + W_O + (size_t)(layer - 2) * D * D, MC, D, D, E, G, opq(bid), wv); } GRID_BAR();
            }
            ph_thin(p, row0, nrows, MBs, p.n_mix_post + layer * D, nullptr, A8s, true, G, opq(bid), wv); GRID_BAR();
            { pg8::EpiUpConv E{HAs, (const float*)(p.ws + WS_SA) + row0, (const float*)(p.ws + WS_WSC) + layer * 2 * FF, p.conv_w + (size_t)layer * 3 * FF, p.conv_b + (size_t)layer * FF, (float*)(p.ws + WS_HALO), (LAS float*)(lds + HALO_LDS)}; gemm_call<pg8::EpiUpConv, 2>(lds, (const bf16*)A8s, (const bf16*)((const unsigned char*)(WB + W_UP) + (size_t)layer * 2 * FF * D), nrows, 2 * FF, D, E, G, opq(bid), wv); } GRID_BAR();
            conv_fix_local(p, layer, HAs, nrows, G, opq(bid), wv);
            { pg8::EpiRS E{MBs, D, 0}; gemm_call(lds, HAs, WB + W_DOWN + (size_t)layer * D * FF, nrows, D, FF, E, G, opq(bid), wv); } GRID_BAR();
            ph_thin(p, row0, nrows, MBs, p.n_ffn_post + layer * D, layer == 3 ? p.out + (size_t)row0 * D : nullptr, layer == 0 ? A8s : (layer < 3 ? A8G : nullptr), false, G, opq(bid), wv); GRID_BAR();
        }
    }
}

extern "C" void kernel_launch(void* const* d_in, const int* in_sizes, int n_in, void* d_out, int out_size, void* d_ws, size_t ws_size, hipStream_t stream) {
    static int grid = 0;
    if (grid == 0) {
        if (n_in != 16 || in_sizes[0] != M_ALL * D || out_size != M_ALL * D || ws_size < WS_END) {
            fprintf(stderr, "kernel_launch: unexpected shapes: n_in %d in0 %d out %d ws %zu (need %zu)\n", n_in, n_in > 0 ? in_sizes[0] : -1, out_size, ws_size, (size_t)WS_END); grid = -1; return; }
        int dev = 0, cus = 0, per_cu = 0;
        if (hipGetDevice(&dev) != hipSuccess || hipDeviceGetAttribute(&cus, hipDeviceAttributeMultiprocessorCount, dev) != hipSuccess) { grid = -1; return; }
        if (hipFuncSetAttribute((const void*)yoco_fwd, hipFuncAttributeMaxDynamicSharedMemorySize, LDS_BYTES) != hipSuccess) { fprintf(stderr, "kernel_launch: hipFuncSetAttribute failed\n"); grid = -1; return; }
        if (hipOccupancyMaxActiveBlocksPerMultiprocessor(&per_cu, (const void*)yoco_fwd, 512, LDS_BYTES) != hipSuccess || per_cu < 1) { fprintf(stderr, "kernel_launch: occupancy query says %d blocks per CU\n", per_cu); (void)hipGetLastError(); grid = -1; return; }
        if (cus != 256) { fprintf(stderr, "kernel_launch: built for a 256-CU device, found %d CUs\n", cus); grid = -1; return; }
        grid = cus;
    }
    if (grid < 0) return;
    Params p{};
    p.x = (const float*)d_in[0]; p.ret_w_in = (const float*)d_in[1]; p.ret_w_out = (const float*)d_in[2]; p.ret_gn = (const float*)d_in[3]; p.kv_norm = (const float*)d_in[4];
    p.w_kv = (const float*)d_in[5]; p.w_q = (const float*)d_in[6]; p.w_o = (const float*)d_in[7]; p.n_mix_pre = (const float*)d_in[8]; p.n_mix_post = (const float*)d_in[9];
    p.n_ffn_pre = (const float*)d_in[10]; p.n_ffn_post = (const float*)d_in[11]; p.w_up = (const float*)d_in[12]; p.conv_w = (const float*)d_in[13]; p.conv_b = (const float*)d_in[14]; p.w_down = (const float*)d_in[15];
    p.out = (float*)d_out; p.ws = (unsigned char*)d_ws;
    (void)hipMemsetAsync((char*)d_ws + WS_CTL, 0, 65536, stream);
    hipLaunchKernelGGL(yoco_fwd, dim3(grid), dim3(512), LDS_BYTES, stream, p);
}
```

```cpp
#include <hip/hip_runtime.h>
#include <cstdio>
#include <cstdint>
__device__ __forceinline__ int otid(int wv) { int l; asm volatile("v_mbcnt_lo_u32_b32 %0, -1, 0\n\tv_mbcnt_hi_u32_b32 %0, -1, %0" : "=v"(l)); return (wv << 6) | l; }
namespace pg8 {
#define PG8_LAS __attribute__((address_space(3)))
typedef unsigned short bf16_t;
typedef short bf16x8 __attribute__((ext_vector_type(8)));
typedef float f32x4 __attribute__((ext_vector_type(4)));
typedef unsigned u32x4 __attribute__((ext_vector_type(4)));
constexpr int BM = 256, BK = 64, HALF = 128, HTB = HALF * BK * 2  , STAGE_BYTES = 8 * HTB, NXCD = 8, WGM = 8;

__host__ __device__ __forceinline__ int lds_byte(int r, int c) { const int st = (r >> 4) * 2 + (c >> 5), rr = r & 15, cc = c & 31, ob = rr * 64 + cc * 2; return st * 1024 + (ob ^ (((ob >> 9) & 1) << 5)); }
__host__ __device__ __forceinline__ void stage_rc(int b, int& R, int& C) { const int st = b / 1024, sb = b % 1024, swz = sb ^ (((sb >> 9) & 1) << 5); R = (st >> 1) * 16 + swz / 64; C = (st & 1) * 32 + (swz % 64) / 2; }
__host__ __device__ __forceinline__ int perm32(int rho) { const int n = rho >> 4, i = rho & 15; return 8 * (i >> 2) + 4 * n + (i & 3); }

struct Unit { int pm, pn; };
struct Gemm { const bf16_t* A; const bf16_t* Bt; int M, N, K; };

struct StaticOrder {
    int nM, nN, nwg, G, c;
    __host__ __device__ void init(int M, int N, int G_, int c_) { nM = M / BM; nN = N / BM; nwg = nM * nN; G = G_; c = c_; }
    __host__ __device__ bool next(int i, Unit& u) const {
        const long L = (long)i * G + c; if (L >= nwg) return false;
        int wgid = (int)L; { const int q = nwg / NXCD, r = nwg % NXCD, xcd = wgid % NXCD, off = wgid / NXCD; wgid = (xcd < r ? xcd * (q + 1) : r * (q + 1) + (xcd - r) * q) + off; }
        const int nig = WGM * nN, gid = wgid / nig, fm = gid * WGM, gsz = (nM - fm) < WGM ? (nM - fm) : WGM;
        u.pm = fm + ((wgid % nig) % gsz); u.pn = (wgid % nig) / gsz; return true;
    }
    __device__ __forceinline__ void a_ready(const Unit&) const {}
    __device__ __forceinline__ void done(const Unit&) const {}
};
typedef float cvt_f32x2 __attribute__((ext_vector_type(2))); typedef __bf16 cvt_bf16x2 __attribute__((ext_vector_type(2)));
__device__ __forceinline__ unsigned cvt_pk_bf16(float lo, float hi) { const cvt_f32x2 v = {lo, hi}; return __builtin_bit_cast(unsigned, __builtin_convertvector(v, cvt_bf16x2)); }
typedef int i32x4 __attribute__((ext_vector_type(4)));
typedef int i32x8 __attribute__((ext_vector_type(8)));
__device__ __forceinline__ i32x8 cat8(bf16x8 a, bf16x8 b) { const i32x4 x = __builtin_bit_cast(i32x4, a), y = __builtin_bit_cast(i32x4, b); return __builtin_shufflevector(x, y, 0, 1, 2, 3, 4, 5, 6, 7); }
template <class Epi, class Sched, bool ALIGN_EPI = false, bool SP2 = false, int QM = 0>
__device__ __forceinline__ void gemm_phase(PG8_LAS unsigned char* lds, const Gemm g, const Sched& S, const Epi& E, int wv) {
    const int tid = otid(wv), wid = __builtin_amdgcn_readfirstlane(tid >> 6), lane = tid & 63, wr = wid >> 2, wc = wid & 3, fr = lane & 15, fq = lane >> 4;
    constexpr bool F8 = (QM == 1), I8 = (QM == 2); const int K = g.K, KB = (QM != 0) ? K : 2 * K  , nt = KB / (BK * 2);
    unsigned voffA[2], voffB[2];
#pragma unroll
    for (int i = 0; i < 2; ++i) { int R, C; stage_rc(tid * 16 + i * 8192, R, C); const int Rb = Epi::PERM ? ((R & ~31) + perm32(R & 31)) : R;
        voffA[i] = (unsigned)(R * KB + C * 2); voffB[i] = (unsigned)(Rb * KB + C * 2); }
    const size_t kstep = (size_t)(BK * 2);
    const size_t hstep = (size_t)HALF * KB;
    const size_t tstep = 2 * hstep;
    const unsigned ldsw = (unsigned)wid * 1024u;
    const int aoff = lds_byte(wr * 64 + fr, fq * 8), boff = lds_byte(wc * 32 + fr, fq * 8);
#define PG8_SA(b, h) (((b) * 2 + (h)) * HTB)
#define PG8_SB(b, h) ((4 + (b) * 2 + (h)) * HTB)
#define PG8_STAGE(bufoff, gbase, voff) do { const char* _gb = (const char*)(gbase); asm volatile("" : "+s"(_gb));   \
        _Pragma("unroll") for (int _i = 0; _i < 2; ++_i) \
        __builtin_amdgcn_global_load_lds((const unsigned*)(_gb + (voff)[_i]), (PG8_LAS unsigned*)(lds + (bufoff) + ldsw + _i * 8192), 16, 0, 0); } while (0)
#define PG8_LDA(dst, b, h) do { _Pragma("unroll") for (int m = 0; m < 4; ++m) _Pragma("unroll") for (int k = 0; k < 2; ++k) dst[m][k] = *(const PG8_LAS bf16x8*)(lds + PG8_SA(b, h) + aoff + m * 2048 + k * 1024); } while (0)
#define PG8_LDB(dst, b, h) do { _Pragma("unroll") for (int n = 0; n < 2; ++n) _Pragma("unroll") for (int k = 0; k < 2; ++k) dst[n][k] = *(const PG8_LAS bf16x8*)(lds + PG8_SB(b, h) + boff + n * 2048 + k * 1024); } while (0)
#define PG8_MMA(ai, bj, At, Bt) do { __builtin_amdgcn_s_setprio(1); _Pragma("unroll") for (int m = 0; m < 4; ++m) _Pragma("unroll") for (int n = 0; n < 2; ++n) { \
        if constexpr (F8) acc[ai][bj][m][n] = __builtin_amdgcn_mfma_scale_f32_16x16x128_f8f6f4(cat8(Bt[n][0], Bt[n][1]), cat8(At[m][0], At[m][1]), acc[ai][bj][m][n], 0, 0, 0, 0, 0, 0); \
        else if constexpr (I8) { _Pragma("unroll") for (int k = 0; k < 2; ++k) acc[ai][bj][m][n] = __builtin_bit_cast(f32x4, __builtin_amdgcn_mfma_i32_16x16x64_i8(__builtin_bit_cast(i32x4, Bt[n][k]), __builtin_bit_cast(i32x4, At[m][k]), __builtin_bit_cast(i32x4, acc[ai][bj][m][n]), 0, 0, 0)); } \
        else { _Pragma("unroll") for (int k = 0; k < 2; ++k) acc[ai][bj][m][n] = __builtin_amdgcn_mfma_f32_16x16x32_bf16(Bt[n][k], At[m][k], acc[ai][bj][m][n], 0, 0, 0); } } \
        __builtin_amdgcn_s_setprio(0); } while (0)
#define PG8_WAIT_V(n) asm volatile("s_waitcnt vmcnt(" #n ")" ::: "memory")
#define PG8_WAIT_L(n) asm volatile("s_waitcnt lgkmcnt(" #n ")" ::: "memory")
#define PG8_BAR __builtin_amdgcn_s_barrier()
#define PG8_SCHED __builtin_amdgcn_sched_barrier(0)
    Unit cur, nxt; int ui = 0;
    if (!S.next(0, cur)) return;
    const char* cA = (const char*)g.A + (size_t)cur.pm * tstep; const char* cB = (const char*)g.Bt + (size_t)cur.pn * tstep;
    S.a_ready(cur);
    if constexpr (SP2) {
        PG8_STAGE(PG8_SB(0, 0), cB, voffB); PG8_STAGE(PG8_SB(0, 1), cB + hstep, voffB); PG8_STAGE(PG8_SA(0, 0), cA, voffA); PG8_STAGE(PG8_SA(0, 1), cA + hstep, voffA);
        if (wr == 1) PG8_BAR;
        PG8_WAIT_V(2); PG8_BAR;
        PG8_STAGE(PG8_SB(1, 0), cB + kstep, voffB); PG8_STAGE(PG8_SA(1, 0), cA + kstep, voffA); PG8_STAGE(PG8_SB(1, 1), cB + hstep + kstep, voffB);
        PG8_WAIT_V(6); PG8_BAR;
    } else {
        PG8_STAGE(PG8_SB(0, 0), cB, voffB); PG8_STAGE(PG8_SA(0, 0), cA, voffA); PG8_STAGE(PG8_SB(0, 1), cB + hstep, voffB); PG8_STAGE(PG8_SA(0, 1), cA + hstep, voffA);
        if (wr == 1) PG8_BAR;
        PG8_WAIT_V(4); PG8_BAR;
        PG8_STAGE(PG8_SB(1, 0), cB + kstep, voffB); PG8_STAGE(PG8_SA(1, 0), cA + kstep, voffA); PG8_STAGE(PG8_SB(1, 1), cB + hstep + kstep, voffB);
        PG8_WAIT_V(6); PG8_BAR;
    }
    if constexpr (F8) {
        const int tid2 = otid(wv);
#pragma unroll
        for (int i = 0; i < 2; ++i) { int R, C; stage_rc(tid2 * 16 + i * 8192, R, C); const int Rb = Epi::PERM ? ((R & ~31) + perm32(R & 31)) : R;
            voffA[i] = (unsigned)(R * KB + C * 2); voffB[i] = (unsigned)(Rb * KB + C * 2); }
    }
    f32x4 acc[2][2][4][2];
#pragma unroll
    for (int a = 0; a < 2; ++a)
#pragma unroll
        for (int b = 0; b < 2; ++b)
#pragma unroll
            for (int m = 0; m < 4; ++m)
#pragma unroll
                for (int n = 0; n < 2; ++n) acc[a][b][m][n] = (f32x4){0.f, 0.f, 0.f, 0.f};
    bf16x8 At[4][2], B0[2][2], B1[2][2];
    for (;;) {
        const bool has_next = S.next(ui + 1, nxt);
        const char* nA = has_next ? (const char*)g.A + (size_t)nxt.pm * tstep : cA; const char* nB = has_next ? (const char*)g.Bt + (size_t)nxt.pn * tstep : cB;
        for (int t = 0; t < nt; t += 2) {
            const bool last = (t == nt - 2);
            const char* a1 = cA + (size_t)(t + 1) * kstep;
            const char* a2 = last ? nA : cA + (size_t)(t + 2) * kstep; const char* b2 = last ? nB : cB + (size_t)(t + 2) * kstep;
            const char* a3 = a2 + kstep; const char* b3 = b2 + kstep;
            if (last && has_next) S.a_ready(nxt);
            if constexpr (SP2) {
            PG8_LDB(B0, 0, 0); PG8_LDB(B1, 0, 1); PG8_SCHED; PG8_LDA(At, 0, 0); PG8_STAGE(PG8_SA(1, 1), a1 + hstep, voffA);
            PG8_WAIT_V(8); PG8_WAIT_L(0); PG8_BAR; PG8_MMA(0, 0, At, B0); PG8_MMA(0, 1, At, B1); PG8_BAR; PG8_SCHED;
            PG8_LDA(At, 0, 1); PG8_STAGE(PG8_SB(0, 0), b2, voffB); PG8_STAGE(PG8_SB(0, 1), b2 + hstep, voffB); PG8_STAGE(PG8_SA(0, 0), a2, voffA);
            PG8_WAIT_V(8); PG8_WAIT_L(0); PG8_BAR; PG8_MMA(1, 0, At, B0); PG8_MMA(1, 1, At, B1); PG8_BAR; PG8_SCHED;
            PG8_LDB(B0, 1, 0); PG8_LDB(B1, 1, 1); PG8_SCHED; PG8_LDA(At, 1, 0); PG8_STAGE(PG8_SA(0, 1), a2 + hstep, voffA);
            PG8_WAIT_V(8); PG8_WAIT_L(0); PG8_BAR; PG8_MMA(0, 0, At, B0); PG8_MMA(0, 1, At, B1); PG8_BAR; PG8_SCHED;
            PG8_LDA(At, 1, 1); PG8_STAGE(PG8_SB(1, 0), b3, voffB); PG8_STAGE(PG8_SB(1, 1), b3 + hstep, voffB); PG8_STAGE(PG8_SA(1, 0), a3, voffA);
            PG8_WAIT_V(8); PG8_WAIT_L(0); PG8_BAR; PG8_MMA(1, 0, At, B0); PG8_MMA(1, 1, At, B1); PG8_BAR; PG8_SCHED;
            } else {
            PG8_LDB(B0, 0, 0); PG8_SCHED; PG8_LDA(At, 0, 0); PG8_STAGE(PG8_SA(1, 1), a1 + hstep, voffA);
            PG8_WAIT_L(8); PG8_BAR; PG8_WAIT_L(0); PG8_MMA(0, 0, At, B0); PG8_BAR; PG8_SCHED;
            PG8_LDB(B1, 0, 1); PG8_STAGE(PG8_SB(0, 0), b2, voffB);
            PG8_BAR; PG8_WAIT_L(0); PG8_MMA(0, 1, At, B1); PG8_BAR;
            PG8_LDA(At, 0, 1); PG8_STAGE(PG8_SA(0, 0), a2, voffA);
            PG8_BAR; PG8_WAIT_L(0); PG8_MMA(1, 0, At, B0); PG8_BAR; PG8_SCHED;
            PG8_STAGE(PG8_SB(0, 1), b2 + hstep, voffB);
            PG8_WAIT_V(6); PG8_BAR; PG8_MMA(1, 1, At, B1); PG8_BAR;
            PG8_LDB(B0, 1, 0); PG8_SCHED; PG8_LDA(At, 1, 0); PG8_STAGE(PG8_SA(0, 1), a2 + hstep, voffA);
            PG8_WAIT_L(8); PG8_BAR; PG8_WAIT_L(0); PG8_MMA(0, 0, At, B0); PG8_BAR; PG8_SCHED;
            PG8_LDB(B1, 1, 1); PG8_STAGE(PG8_SB(1, 0), b3, voffB);
            PG8_BAR; PG8_WAIT_L(0); PG8_MMA(0, 1, At, B1); PG8_BAR;
            PG8_LDA(At, 1, 1); PG8_STAGE(PG8_SA(1, 0), a3, voffA);
            PG8_BAR; PG8_WAIT_L(0); PG8_MMA(1, 0, At, B0); PG8_BAR; PG8_SCHED;
            PG8_STAGE(PG8_SB(1, 1), b3 + hstep, voffB);
            PG8_WAIT_V(6); PG8_BAR; PG8_MMA(1, 1, At, B1); PG8_BAR;
            }
        }
        if constexpr (ALIGN_EPI) { if (wr == 0) PG8_BAR; }
        if constexpr (!Epi::AFTER_DRAIN) { E(acc, cur, wr, wc, fr, fq); S.done(cur); }
        if (!has_next) break;
#pragma unroll
        for (int a = 0; a < 2; ++a)
#pragma unroll
            for (int b = 0; b < 2; ++b)
#pragma unroll
                for (int m = 0; m < 4; ++m)
#pragma unroll
                    for (int n = 0; n < 2; ++n) acc[a][b][m][n] = (f32x4){0.f, 0.f, 0.f, 0.f};
        cur = nxt; cA = nA; cB = nB; ++ui;
        if constexpr (ALIGN_EPI) { if (wr == 1) PG8_BAR; }
    }
    PG8_WAIT_V(0);
    if constexpr (!ALIGN_EPI) { if (wr == 0) PG8_BAR; }
    PG8_BAR;
    if constexpr (Epi::AFTER_DRAIN) { E.fused(acc, cur, wr, wc, fr, fq, lds, wid, lane); S.done(cur); }
#undef PG8_SA
#undef PG8_SB
#undef PG8_STAGE
#undef PG8_LDA
#undef PG8_LDB
#undef PG8_MMA
#undef PG8_WAIT_V
#undef PG8_WAIT_L
#undef PG8_BAR
#undef PG8_SCHED
}
}
#define LAS __attribute__((address_space(3)))
#define XB_TMO      128
#define XB_XCNT(j)  (256  + 64 * (j))
#define XB_XSUB(j)  (1280 + 64 * (j))
#define XB_XGEN(j)  (2304 + 64 * (j))
#define XB_TOP      3328
#define XB_TOPGEN   3392
#define XCD_BAR_WORDS 3456
#define XB_SPIN_CAP (1u << 18)

__device__ __forceinline__ unsigned xb_ld(unsigned* p)              { return __hip_atomic_load(p, __ATOMIC_RELAXED, __HIP_MEMORY_SCOPE_AGENT); }
__device__ __forceinline__ unsigned xb_add(unsigned* p, unsigned v) { return __hip_atomic_fetch_add(p, v, __ATOMIC_RELAXED, __HIP_MEMORY_SCOPE_AGENT); }
__device__ __forceinline__ unsigned xb_xcc_id() { return (unsigned)__builtin_amdgcn_s_getreg((3 << 11) | 20) & 0xFu; }
#define XB_SPIN(cond, bar) do { unsigned _sp = 0; while (cond) { __builtin_amdgcn_s_sleep(1); \
    if ((++_sp & 255u) == 0u) { if (xb_ld(&(bar)[XB_TMO])) break; if (_sp > XB_SPIN_CAP) { atomicAdd(&(bar)[XB_TMO], 1u); break; } } } } while (0)

struct XcdBarrier {
    int wv;
    unsigned* bar; unsigned x;
    volatile LAS unsigned* st;
};

__device__ __forceinline__ XcdBarrier xcd_barrier_post(unsigned* bar, volatile LAS unsigned* st, int wv) {
    XcdBarrier b; b.wv = wv; b.bar = bar; b.x = xb_xcc_id(); b.st = st;
    if (otid(wv) == 0) (void)xb_add(&bar[XB_XCNT(b.x)], 1u);
    return b;
}
__device__ __forceinline__ void xcd_barrier_complete(unsigned* bar, unsigned x, unsigned& nloc, unsigned& nx) {
    const unsigned G = gridDim.x * gridDim.y * gridDim.z;
    unsigned sum, cnt, mine, sp = 0u;
    for (;;) {
        sum = 0u; cnt = 0u; mine = 0u;
#pragma unroll
        for (unsigned j = 0; j < 16; ++j) { const unsigned c = xb_ld(&bar[XB_XCNT(j)]); sum += c; cnt += (c > 0u) ? 1u : 0u; mine = (j == x) ? c : mine; }
        if (sum == G) break;
        __builtin_amdgcn_s_sleep(1);
        if ((++sp & 255u) == 0u) { if (xb_ld(&bar[XB_TMO])) break; if (sp > XB_SPIN_CAP) { atomicAdd(&bar[XB_TMO], 1u); break; } }
    }
    nloc = mine > 0u ? mine : 1u; nx = cnt > 0u ? cnt : 1u;
}

__device__ __forceinline__ void xcd_barrier(const XcdBarrier& b) {
    asm volatile("s_waitcnt vmcnt(0)" ::: "memory");
    __syncthreads();
    if (otid(b.wv) == 0) {
        unsigned* bar = b.bar;
        __builtin_amdgcn_s_waitcnt(0);
        unsigned nloc = b.st[0], nx = b.st[1];
        if (nloc == 0u) { xcd_barrier_complete(bar, b.x, nloc, nx); b.st[0] = nloc; b.st[1] = nx; }
        const unsigned old = xb_add(&bar[XB_XSUB(b.x)], 1u);
        const unsigned gen = old / nloc;
        if (old + 1u == (gen + 1u) * nloc) {
            __builtin_amdgcn_fence(__ATOMIC_RELEASE, "agent");
            asm volatile("s_waitcnt vmcnt(0)" ::: "memory");
            const unsigned og = xb_add(&bar[XB_TOP], 1u);
            const unsigned tg = og / nx;
            if (og + 1u == (tg + 1u) * nx) xb_add(&bar[XB_TOPGEN], 1u);
            else XB_SPIN(xb_ld(&bar[XB_TOPGEN]) == tg, bar);
            __builtin_amdgcn_fence(__ATOMIC_ACQUIRE, "agent");
            xb_add(&bar[XB_XGEN(b.x)], 1u);
            asm volatile("s_waitcnt vmcnt(0)" ::: "memory");
        } else {
            XB_SPIN(xb_ld(&bar[XB_XGEN(b.x)]) == gen, bar);
            __builtin_amdgcn_fence(__ATOMIC_ACQUIRE, "agent");
            asm volatile("s_waitcnt vmcnt(0)" ::: "memory");
        }
    }
    __syncthreads();
}


typedef unsigned short bf16;
typedef unsigned v4u __attribute__((ext_vector_type(4)));
typedef unsigned v2u __attribute__((ext_vector_type(2)));
typedef float f32x4 __attribute__((ext_vector_type(4)));

constexpr int D = 1024, SEQ = 2048, NBATCH = 32, M_ALL = NBATCH * SEQ;
constexpr int MC = M_ALL / 2;
constexpr int FF = 2816, RET_IN = 6144, QW = 3072, KVW = 6144;
constexpr float RMS_EPS = 1e-6f, GN_EPS = 1e-6f;
constexpr size_t MiB = 1u << 20;
constexpr size_t WS_CTL = 0;
constexpr size_t WS_RCOS = 1 * MiB, WS_RSIN = 2 * MiB;
constexpr size_t WS_ACOS = 3 * MiB, WS_ASIN = 3 * MiB + 65536;
constexpr size_t WS_RS = 3 * MiB + 512 * 1024;
constexpr size_t WS_SA = 3 * MiB + 768 * 1024;
constexpr size_t WS_WSC = 65536;
constexpr int WSC_KV = 4 * 2 * 2816, WSC_Q = WSC_KV + 6144, WSC_RET = WSC_Q + 2 * 3072;
constexpr size_t WS_W = 4 * MiB;
constexpr size_t W_RETIN = 0, W_RETOUT = W_RETIN + 2ull * RET_IN * D, W_KV = W_RETOUT + 2ull * D * 2048, W_Q = W_KV + (size_t)KVW * D,
                 W_O = W_Q + 2ull * QW * D, W_UP = W_O + 2ull * D * D, W_DOWN = W_UP + 4ull * 2 * FF * D, W_END = W_DOWN + 4ull * D * FF;
static_assert(W_END * 2 <= 127 * MiB, "weights");
constexpr size_t WS_XB = 132 * MiB;
constexpr size_t WS_GS = 260 * MiB;
constexpr size_t WS_BIG = 264 * MiB;
constexpr size_t WS_Q = 648 * MiB;
constexpr size_t WS_MBF = 776 * MiB;
constexpr size_t WS_O = 840 * MiB;
constexpr size_t WS_MB = 904 * MiB;
constexpr size_t WS_HALO = 968 * MiB;
constexpr size_t WS_P0 = 986 * MiB;
constexpr size_t WS_END = 1002 * MiB;
constexpr int RQP = 4096;

struct Params {
    const float* x; const float* ret_w_in; const float* ret_w_out; const float* ret_gn; const float* kv_norm; const float* w_kv; const float* w_q; const float* w_o;
    const float* n_mix_pre; const float* n_mix_post; const float* n_ffn_pre; const float* n_ffn_post; const float* w_up; const float* conv_w; const float* conv_b; const float* w_down;
    float* out; unsigned char* ws;
};

__device__ __forceinline__ float bf2f(unsigned short b) { return __uint_as_float(((unsigned)b) << 16); }
__device__ __forceinline__ unsigned f2bf(float f) { unsigned u = __float_as_uint(f); return (u + 0x7fffu + ((u >> 16) & 1u)) >> 16; }
__device__ __forceinline__ unsigned pk2(float lo, float hi) { return f2bf(lo) | (f2bf(hi) << 16); }
__device__ __forceinline__ float dpp_add(float v, int ctrl_sel) {
    int r;
    if (ctrl_sel == 0) r = __builtin_amdgcn_update_dpp(0, __builtin_bit_cast(int, v), 0xB1, 0xF, 0xF, false);
    else if (ctrl_sel == 1) r = __builtin_amdgcn_update_dpp(0, __builtin_bit_cast(int, v), 0x4E, 0xF, 0xF, false);
    else if (ctrl_sel == 2) r = __builtin_amdgcn_update_dpp(0, __builtin_bit_cast(int, v), 0x141, 0xF, 0xF, false);
    else r = __builtin_amdgcn_update_dpp(0, __builtin_bit_cast(int, v), 0x140, 0xF, 0xF, false);
    return v + __builtin_bit_cast(float, r);
}
__device__ __forceinline__ float wave_max(float v) {
    v = fmaxf(v, __builtin_bit_cast(float, __builtin_amdgcn_update_dpp(0, __builtin_bit_cast(int, v), 0xB1, 0xF, 0xF, false)));
    v = fmaxf(v, __builtin_bit_cast(float, __builtin_amdgcn_update_dpp(0, __builtin_bit_cast(int, v), 0x4E, 0xF, 0xF, false)));
    v = fmaxf(v, __builtin_bit_cast(float, __builtin_amdgcn_update_dpp(0, __builtin_bit_cast(int, v), 0x141, 0xF, 0xF, false)));
    v = fmaxf(v, __builtin_bit_cast(float, __builtin_amdgcn_update_dpp(0, __builtin_bit_cast(int, v), 0x140, 0xF, 0xF, false)));
    { const unsigned u = __builtin_bit_cast(unsigned, v); auto r = __builtin_amdgcn_permlane16_swap(u, u, false, false); v = fmaxf(__builtin_bit_cast(float, (unsigned)r[0]), __builtin_bit_cast(float, (unsigned)r[1])); }
    { const unsigned u = __builtin_bit_cast(unsigned, v); auto r = __builtin_amdgcn_permlane32_swap(u, u, false, false); v = fmaxf(__builtin_bit_cast(float, (unsigned)r[0]), __builtin_bit_cast(float, (unsigned)r[1])); }
    return v;
}
__device__ __forceinline__ unsigned pk4_i8(float a, float b, float c, float d) {
    const unsigned ua = __float_as_uint(a + 12582912.0f), ub = __float_as_uint(b + 12582912.0f), uc = __float_as_uint(c + 12582912.0f), ud = __float_as_uint(d + 12582912.0f);
    const unsigned lo = __builtin_amdgcn_perm(ub, ua, 0x0c0c0400u), hi = __builtin_amdgcn_perm(ud, uc, 0x0c0c0400u);
    return __builtin_amdgcn_perm(hi, lo, 0x05040100u);
}
__device__ __forceinline__ float xmax32(float v) { const unsigned u = __builtin_bit_cast(unsigned, v); auto r = __builtin_amdgcn_permlane32_swap(u, u, false, false); return fmaxf(__builtin_bit_cast(float, (unsigned)r[0]), __builtin_bit_cast(float, (unsigned)r[1])); }
__device__ __forceinline__ float xsum32(float v) { const unsigned u = __builtin_bit_cast(unsigned, v); auto r = __builtin_amdgcn_permlane32_swap(u, u, false, false); return __builtin_bit_cast(float, (unsigned)r[0]) + __builtin_bit_cast(float, (unsigned)r[1]); }
__device__ __forceinline__ float xor32(float v) { int l; asm volatile("v_mbcnt_lo_u32_b32 %0, -1, 0\n\tv_mbcnt_hi_u32_b32 %0, -1, %0" : "=v"(l)); return __builtin_bit_cast(float, __builtin_amdgcn_ds_bpermute((l ^ 32) << 2, __builtin_bit_cast(int, v))); }
__device__ __forceinline__ float wave_sum(float v) {
    v = dpp_add(v, 0); v = dpp_add(v, 1); v = dpp_add(v, 2); v = dpp_add(v, 3);
    { const unsigned u = __builtin_bit_cast(unsigned, v); auto r = __builtin_amdgcn_permlane16_swap(u, u, false, false); v = __builtin_bit_cast(float, (unsigned)r[0]) + __builtin_bit_cast(float, (unsigned)r[1]); }
    { const unsigned u = __builtin_bit_cast(unsigned, v); auto r = __builtin_amdgcn_permlane32_swap(u, u, false, false); v = __builtin_bit_cast(float, (unsigned)r[0]) + __builtin_bit_cast(float, (unsigned)r[1]); }
    return v;
}
#define LDS_WAIT() asm volatile("s_waitcnt lgkmcnt(0)" ::: "memory")

namespace pg8 {
struct EpiRS {
    static constexpr bool PERM = true, AFTER_DRAIN = false;
    bf16_t* O; int ldc; int pad;
    __device__ __forceinline__ void operator()(const f32x4 (&acc)[2][2][4][2], const Unit& u, int wr, int wc, int fr, int fq) const {
        const int row0 = u.pm * BM + wr * 64 + fr, col0 = u.pn * BM + wc * 32 + 8 * fq;
#pragma unroll
        for (int ai = 0; ai < 2; ++ai)
#pragma unroll
            for (int m = 0; m < 4; ++m) {
                bf16_t* rowp = O + (size_t)(row0 + ai * HALF + m * 16) * ldc + col0;
#pragma unroll
                for (int bj = 0; bj < 2; ++bj) { const f32x4 v0 = acc[ai][bj][m][0], v1 = acc[ai][bj][m][1];
                    u32x4 w; w.x = cvt_pk_bf16(v0[0], v0[1]); w.y = cvt_pk_bf16(v0[2], v0[3]); w.z = cvt_pk_bf16(v1[0], v1[1]); w.w = cvt_pk_bf16(v1[2], v1[3]);
                    *(u32x4*)(rowp + bj * HALF) = w; }
            }
    }
};

struct EpiRetIn {
    static constexpr bool PERM = true, AFTER_DRAIN = false;
    bf16_t* O; const float* rs; const float* rc; const float* rsn; int ldc; int pad;
    __device__ __forceinline__ void operator()(const f32x4 (&acc)[2][2][4][2], const Unit& u, int wr, int wc, int fr_, int fq_) const {
        const int ln_ = otid(0); const int fr = ln_ & 15, fq = ln_ >> 4; (void)fr_; (void)fq_;
        const int row0 = u.pm * BM + wr * 64 + fr, j0 = wc * 32 + 8 * fq, col0 = u.pn * BM + j0;
        const bool rot = u.pn < 8; const float ksc = (u.pn >= 4 && u.pn < 8) ? 0.0625f : 1.0f;
#pragma unroll
        for (int ab = 0; ab < 4; ++ab) { const int ai = ab >> 1, mb = 2 * (ab & 1);
            float sv[4]; f32x4 c0[4], c1[4], s0[4], s1[4];
#pragma unroll
            for (int m = mb; m < mb + 2; ++m) { const int row = row0 + ai * HALF + m * 16; sv[m] = rs[row] * ksc;
                if (rot) { const int pos = row & 2047; const float* cp = rc + pos * 128 + j0; const float* sp = rsn + pos * 128 + j0;
                    c0[m] = *(const f32x4*)cp; c1[m] = *(const f32x4*)(cp + 4); s0[m] = *(const f32x4*)sp; s1[m] = *(const f32x4*)(sp + 4); } }
#pragma unroll
            for (int m = mb; m < mb + 2; ++m) {
                const int row = row0 + ai * HALF + m * 16; const float s = sv[m];
                f32x4 a0 = acc[ai][0][m][0], a1 = acc[ai][0][m][1], b0 = acc[ai][1][m][0], b1 = acc[ai][1][m][1];
                if (rot) { const f32x4 n0 = a0 * c0[m] - b0 * s0[m], n1 = a1 * c1[m] - b1 * s1[m], q0 = b0 * c0[m] + a0 * s0[m], q1 = b1 * c1[m] + a1 * s1[m];
                    a0 = n0; a1 = n1; b0 = q0; b1 = q1; }
                a0 = a0 * s; a1 = a1 * s; b0 = b0 * s; b1 = b1 * s;
                bf16_t* rowp = O + ((size_t)((row >> 11) * 16 + u.pn) * 2048 + (row & 2047)) * 256 + j0;
                u32x4 w; w.x = cvt_pk_bf16(a0[0], a0[1]); w.y = cvt_pk_bf16(a0[2], a0[3]); w.z = cvt_pk_bf16(a1[0], a1[1]); w.w = cvt_pk_bf16(a1[2], a1[3]); __builtin_nontemporal_store(w, (u32x4*)rowp);
                u32x4 x; x.x = cvt_pk_bf16(b0[0], b0[1]); x.y = cvt_pk_bf16(b0[2], b0[3]); x.z = cvt_pk_bf16(b1[0], b1[1]); x.w = cvt_pk_bf16(b1[2], b1[3]); __builtin_nontemporal_store(x, (u32x4*)(rowp + HALF));
            }
        }
    }
};
struct EpiGate8 {
    static constexpr bool PERM = true, AFTER_DRAIN = false;
    bf16_t* Y; const float* sa; const float* sw; PG8_LAS float* st; const float* gain;
    __device__ __forceinline__ void operator()(const f32x4 (&acc)[2][2][4][2], const Unit& u, int wr, int wc, int fr_, int fq_) const {
        const int ln_ = otid(0); const int fr = ln_ & 15, fq = ln_ >> 4; (void)fr_; (void)fq_;
        const int row0 = u.pm * BM + wr * 64 + fr, col0 = u.pn * BM + wc * 32 + 8 * fq, head = u.pn >> 1;
        if ((u.pn & 1) == 0) {
            const int wid = wr * 4 + wc;
#pragma unroll
            for (int jb = 0; jb < 2; ++jb) {
                u32x4 yr[16];
#pragma unroll
                for (int k = 0; k < 16; ++k) yr[k] = *((const u32x4*)(Y + (size_t)(u.pm * BM + wid * 32 + jb * 16 + k) * 2048 + head * 512) + ln_);
#pragma unroll
                for (int k = 0; k < 16; ++k) {
                    float y[8];
#pragma unroll
                    for (int e = 0; e < 4; ++e) { y[2 * e] = __uint_as_float(yr[k][e] << 16); y[2 * e + 1] = __uint_as_float(yr[k][e] & 0xffff0000u); }
                    float sm = 0.f;
#pragma unroll
                    for (int e = 0; e < 8; ++e) sm += y[e];
                    const float mu = ::wave_sum(sm) * (1.0f / 512.0f); float q = 0.f;
#pragma unroll
                    for (int e = 0; e < 8; ++e) { const float d = y[e] - mu; q += d * d; }
                    const float rstd = 1.0f / sqrtf(::wave_sum(q) * (1.0f / 512.0f) + 1e-6f);
                    if (ln_ == 0) { PG8_LAS float* d = st + (wid * 32 + jb * 16 + k) * 2; d[0] = mu; d[1] = rstd; }
                }
            }
            asm volatile("s_waitcnt lgkmcnt(0)" ::: "memory"); __builtin_amdgcn_s_barrier(); asm volatile("" ::: "memory");
        }
        float gn[2][8], cs[2][8];
#pragma unroll
        for (int bj = 0; bj < 2; ++bj) { const f32x4 a = *(const f32x4*)(gain + col0 + bj * HALF), b = *(const f32x4*)(gain + col0 + bj * HALF + 4), c = *(const f32x4*)(sw + col0 + bj * HALF), d = *(const f32x4*)(sw + col0 + bj * HALF + 4);
#pragma unroll
            for (int e = 0; e < 4; ++e) { gn[bj][e] = a[e]; gn[bj][4 + e] = b[e]; cs[bj][e] = c[e]; cs[bj][4 + e] = d[e]; } }
#pragma unroll
        for (int ai = 0; ai < 2; ++ai) {
            float sv[4], muv[4], rsv[4]; u32x4 yv[4][2];
#pragma unroll
            for (int m = 0; m < 4; ++m) { const int row = row0 + ai * HALF + m * 16; sv[m] = sa[row];
                const PG8_LAS float* sp = st + (wr * 64 + fr + ai * HALF + m * 16) * 2; muv[m] = sp[0]; rsv[m] = sp[1];
                const bf16_t* rowp = Y + (size_t)row * 2048 + col0; yv[m][0] = *(const u32x4*)rowp; yv[m][1] = *(const u32x4*)(rowp + HALF); }
#pragma unroll
            for (int m = 0; m < 4; ++m) {
                const int row = row0 + ai * HALF + m * 16; const float s = sv[m], mu = muv[m], rstd = rsv[m];
                bf16_t* rowp = Y + (size_t)row * 2048 + col0;
#pragma unroll
                for (int bj = 0; bj < 2; ++bj) { float o[8];
#pragma unroll
                    for (int e = 0; e < 8; ++e) { const float g = (float)__float_as_int(acc[ai][bj][m][e >> 2][e & 3]) * s * cs[bj][e]; const unsigned w = yv[m][bj][e >> 1]; const float y = __uint_as_float((e & 1) ? (w & 0xffff0000u) : (w << 16));
                        const float sil = g * __builtin_amdgcn_rcpf(1.0f + __builtin_amdgcn_exp2f(-1.4426950408889634f * g)); o[e] = sil * ((y - mu) * rstd * gn[bj][e]); }
                    u32x4 w; w.x = cvt_pk_bf16(o[0], o[1]); w.y = cvt_pk_bf16(o[2], o[3]); w.z = cvt_pk_bf16(o[4], o[5]); w.w = cvt_pk_bf16(o[6], o[7]);
                    *(u32x4*)(rowp + bj * HALF) = w; }
            }
        }
    }
};
struct PairOrder {
    StaticOrder so;
    __host__ __device__ void init(int M, int N, int G_, int c_) { so.init(M, N / 2, G_, c_); }
    __host__ __device__ bool next(int i, Unit& u) const { Unit h; if (!so.next(i >> 1, h)) return false; u.pm = h.pm; u.pn = 2 * h.pn + (i & 1); return true; }
    __device__ __forceinline__ void a_ready(const Unit&) const {}
    __device__ __forceinline__ void done(const Unit&) const {}
};
struct EpiAttRot {
    static constexpr bool PERM = true, AFTER_DRAIN = false;
    bf16_t* O; const float* rs; const float* ac; const float* as; int ldc; int rot_tiles;
    __device__ __forceinline__ void operator()(const f32x4 (&acc)[2][2][4][2], const Unit& u, int wr, int wc, int fr, int fq) const {
        const int row0 = u.pm * BM + wr * 64 + fr, col0 = u.pn * BM + wc * 32 + 8 * fq;
        const bool wrot = (u.pn < rot_tiles) && ((wc & 1) == 0); const bool lrot = fq < 2;
#pragma unroll
        for (int ai = 0; ai < 2; ++ai)
#pragma unroll
            for (int m = 0; m < 4; ++m) {
                const int row = row0 + ai * HALF + m * 16; const float s = rs[row];
                f32x4 cc = (f32x4){1.f, 1.f, 1.f, 1.f}, ss = (f32x4){0.f, 0.f, 0.f, 0.f};
                if (wrot) { const int pos = row & 2047; const f32x4 c = *(const f32x4*)(ac + pos * 8 + 4 * (fq & 1)), sn = *(const f32x4*)(as + pos * 8 + 4 * (fq & 1));
                    if (lrot) { cc = c; ss = sn; } }
                bf16_t* rowp = O + (size_t)row * ldc + col0;
#pragma unroll
                for (int bj = 0; bj < 2; ++bj) { const f32x4 v0 = acc[ai][bj][m][0], v1 = acc[ai][bj][m][1];
                    const float n0 = (v0[0] * cc[0] - v0[1] * ss[0]) * s, n1 = (v0[1] * cc[0] + v0[0] * ss[0]) * s, n2 = (v0[2] * cc[1] - v0[3] * ss[1]) * s, n3 = (v0[3] * cc[1] + v0[2] * ss[1]) * s;
                    const float n4 = (v1[0] * cc[2] - v1[1] * ss[2]) * s, n5 = (v1[1] * cc[2] + v1[0] * ss[2]) * s, n6 = (v1[2] * cc[3] - v1[3] * ss[3]) * s, n7 = (v1[3] * cc[3] + v1[2] * ss[3]) * s;
                    u32x4 w; w.x = cvt_pk_bf16(n0, n1); w.y = cvt_pk_bf16(n2, n3); w.z = cvt_pk_bf16(n4, n5); w.w = cvt_pk_bf16(n6, n7);
                    *(u32x4*)(rowp + bj * HALF) = w; }
            }
    }
};

struct EpiAttRot8 {
    static constexpr bool PERM = true, AFTER_DRAIN = false;
    bf16_t* O; const float* sa; const float* sw; const float* ac; const float* as; int ldc; int rot_tiles;
    __device__ __forceinline__ void operator()(const f32x4 (&acc)[2][2][4][2], const Unit& u, int wr, int wc, int fr_, int fq_) const {
        const int ln_ = otid(0); const int fr = ln_ & 15, fq = ln_ >> 4; (void)fr_; (void)fq_;
        const int row0 = u.pm * BM + wr * 64 + fr, col0 = u.pn * BM + wc * 32 + 8 * fq;
        const bool iskv = ldc == 6144;
        size_t cbase[2]; int grp[2];
#pragma unroll
        for (int bj = 0; bj < 2; ++bj) { const int n = col0 + bj * HALF; const int part = (iskv && n >= 3072) ? 1 : 0, nn = n - 3072 * part, gh = nn >> 6, d = nn & 63;
            grp[bj] = (gh >> 4) + ((!iskv && gh < 16) ? 1 : 0)  ; cbase[bj] = (iskv ? (size_t)(gh * 2 + part) : (size_t)gh) * 131072 + d; }
        const bool wrot = (u.pn < rot_tiles) && ((wc & 1) == 0); const bool lrot = fq < 2;
        float cs[2][8];
#pragma unroll
        for (int bj = 0; bj < 2; ++bj) { const f32x4 a = *(const f32x4*)(sw + col0 + bj * HALF), b = *(const f32x4*)(sw + col0 + bj * HALF + 4);
#pragma unroll
            for (int e = 0; e < 4; ++e) { cs[bj][e] = a[e]; cs[bj][4 + e] = b[e]; } }
#pragma unroll
        for (int ai = 0; ai < 2; ++ai) {
            float sv[4]; f32x4 ccv[4], ssv[4];
#pragma unroll
            for (int m = 0; m < 4; ++m) { const int row = row0 + ai * HALF + m * 16; sv[m] = sa[row];
                ccv[m] = (f32x4){1.f, 1.f, 1.f, 1.f}; ssv[m] = (f32x4){0.f, 0.f, 0.f, 0.f};
                if (wrot) { const int pos = row & 2047; const f32x4 c = *(const f32x4*)(ac + pos * 8 + 4 * (fq & 1)), sn = *(const f32x4*)(as + pos * 8 + 4 * (fq & 1));
                    if (lrot) { ccv[m] = c; ssv[m] = sn; } } }
#pragma unroll
            for (int m = 0; m < 4; ++m) {
                const int row = row0 + ai * HALF + m * 16; const float s = sv[m];
                const f32x4 cc = ccv[m], ss = ssv[m];
                const int tk = row & 2047; bf16_t* rowb = O + (size_t)(row >> 11) * (iskv ? 48 * 2 * 131072 : 48 * 131072);
#pragma unroll
                for (int bj = 0; bj < 2; ++bj) { float t[8];
                    const int slot = grp[bj] == 0 ? tk : (grp[bj] == 1 ? (((tk & 3) << 9) | (tk >> 2)) : (((tk & 15) << 7) | (tk >> 4)));
#pragma unroll
                    for (int e = 0; e < 8; ++e) t[e] = (float)__float_as_int(acc[ai][bj][m][e >> 2][e & 3]) * cs[bj][e];
                    u32x4 w;
                    if (!wrot) {
                        w.x = cvt_pk_bf16(t[0] * s, t[1] * s); w.y = cvt_pk_bf16(t[2] * s, t[3] * s); w.z = cvt_pk_bf16(t[4] * s, t[5] * s); w.w = cvt_pk_bf16(t[6] * s, t[7] * s);
                    } else {
                    const float n0 = (t[0] * cc[0] - t[1] * ss[0]) * s, n1 = (t[1] * cc[0] + t[0] * ss[0]) * s, n2 = (t[2] * cc[1] - t[3] * ss[1]) * s, n3 = (t[3] * cc[1] + t[2] * ss[1]) * s;
                    const float n4 = (t[4] * cc[2] - t[5] * ss[2]) * s, n5 = (t[5] * cc[2] + t[4] * ss[2]) * s, n6 = (t[6] * cc[3] - t[7] * ss[3]) * s, n7 = (t[7] * cc[3] + t[6] * ss[3]) * s;
                    w.x = cvt_pk_bf16(n0, n1); w.y = cvt_pk_bf16(n2, n3); w.z = cvt_pk_bf16(n4, n5); w.w = cvt_pk_bf16(n6, n7);
                    }
                    *(u32x4*)(rowb + cbase[bj] + (size_t)slot * 64) = w; }
            }
        }
    }
};

__device__ __forceinline__ float dpp_ror1(float x) { return __builtin_bit_cast(float, __builtin_amdgcn_update_dpp(0, __builtin_bit_cast(int, x), 0x121, 0xF, 0xF, false)); }
__device__ __forceinline__ float dpp_ror2(float x) { return __builtin_bit_cast(float, __builtin_amdgcn_update_dpp(0, __builtin_bit_cast(int, x), 0x122, 0xF, 0xF, false)); }
typedef float gf2 __attribute__((ext_vector_type(2)));
__device__ __forceinline__ gf2 gelu_tanh_mul2(gf2 x, gf2 v) {
    const gf2 p = x * x * (gf2){0.10294324f, 0.10294324f} + (gf2){2.30220819f, 2.30220819f};
    const gf2 a = -x * p;
    gf2 t; t.x = __builtin_amdgcn_exp2f(a.x); t.y = __builtin_amdgcn_exp2f(a.y);
    const gf2 d = t + (gf2){1.0f, 1.0f};
    gf2 r; r.x = __builtin_amdgcn_rcpf(d.x); r.y = __builtin_amdgcn_rcpf(d.y);
    return x * v * r;
}
__device__ __forceinline__ float gelu_tanh_mul(float x, float v) { const float t = __builtin_amdgcn_exp2f(-x * (2.30220819f + 0.10294324f * x * x)); return x * v * __builtin_amdgcn_rcpf(1.0f + t); }
struct EpiUpConv {
    static constexpr bool PERM = true, AFTER_DRAIN = false; static constexpr int NST = 8;
    bf16_t* H; const float* sa; const float* sw; const float* cw; const float* cb; float* halo_g; PG8_LAS float* hl;
    static __device__ __forceinline__ f32x4 cvt4(const f32x4 a, float s) { f32x4 r;
#pragma unroll
        for (int e = 0; e < 4; ++e) r[e] = (float)__float_as_int(a[e]) * s;
        return r; }
    __device__ __forceinline__ void operator()(const f32x4 (&acc)[2][2][4][2], const Unit& u, int wr, int wc, int fr_, int fq_) const {
        const int ln_ = otid(0); const int fr = ln_ & 15, fq = ln_ >> 4; (void)fr_; (void)fq_;
        const int c0 = wc * 32 + 8 * fq, f0 = u.pn * HALF + c0, row0 = u.pm * BM + wr * 64 + 4 * fr;
        float* hb = halo_g + ((size_t)u.pm * 22 + u.pn) * 768 + c0;
        float sv[2][4];
#pragma unroll
        for (int ai = 0; ai < 2; ++ai) { const f32x4 t = *(const f32x4*)(sa + row0 + ai * HALF);
#pragma unroll
            for (int m = 0; m < 4; ++m) sv[ai][m] = t[m]; }
        float w0[8], w1[8], w2[8], bb[8], sv8[8];
#pragma unroll
        for (int e = 0; e < 8; ++e) { const float sg = sw[f0 + e]; w0[e] = cw[f0 + e] * sg; w1[e] = cw[FF + f0 + e] * sg; w2[e] = cw[2 * FF + f0 + e] * sg; bb[e] = cb[f0 + e]; sv8[e] = sw[FF + f0 + e]; }
#pragma unroll
        for (int ai = 0; ai < 2; ++ai)
            if (fr == 15) {
#pragma unroll
                for (int k = 0; k < 2; ++k) { PG8_LAS float* d = hl + ((2 * ai + wr) * 2 + k) * 128 + c0; const float s = sv[ai][2 + k];
                    *(PG8_LAS f32x4*)d = cvt4(acc[ai][0][2 + k][0], s); *(PG8_LAS f32x4*)(d + 4) = cvt4(acc[ai][0][2 + k][1], s); } }
        asm volatile("s_waitcnt lgkmcnt(0)" ::: "memory"); __builtin_amdgcn_s_barrier(); asm volatile("" ::: "memory");
#pragma unroll
        for (int ai = 0; ai < 2; ++ai) {
            const int gid = 2 * ai + wr;
            float hm1[8], hm2[8];
#pragma unroll
            for (int e = 0; e < 8; ++e) { hm1[e] = 0.f; hm2[e] = 0.f; }
            if (gid > 0) { const PG8_LAS float* s2 = hl + ((gid - 1) * 2 + 0) * 128 + c0; const PG8_LAS float* s1 = hl + ((gid - 1) * 2 + 1) * 128 + c0;
                const f32x4 a = *(const PG8_LAS f32x4*)s2, b = *(const PG8_LAS f32x4*)(s2 + 4), c = *(const PG8_LAS f32x4*)s1, d = *(const PG8_LAS f32x4*)(s1 + 4);
#pragma unroll
                for (int e = 0; e < 4; ++e) { hm2[e] = a[e]; hm2[4 + e] = b[e]; hm1[e] = c[e]; hm1[4 + e] = d[e]; } }
            float o[4][8];
#pragma unroll
            for (int e = 0; e < 8; e += 2) {
                gf2 g[4], v[4];
#pragma unroll
                for (int m = 0; m < 4; ++m) {
                    g[m] = (gf2){(float)__float_as_int(acc[ai][0][m][e >> 2][e & 3]), (float)__float_as_int(acc[ai][0][m][e >> 2][(e & 3) + 1])} * sv[ai][m];
                    v[m] = (gf2){(float)__float_as_int(acc[ai][1][m][e >> 2][e & 3]), (float)__float_as_int(acc[ai][1][m][e >> 2][(e & 3) + 1])} * sv[ai][m] * (gf2){sv8[e], sv8[e + 1]}; }
                gf2 q3, q2; q3.x = dpp_ror1(g[3].x); q3.y = dpp_ror1(g[3].y); q2.x = dpp_ror1(g[2].x); q2.y = dpp_ror1(g[2].y);
                const gf2 tm1 = fr >= 1 ? q3 : (gf2){hm1[e], hm1[e + 1]}, tm2 = fr >= 1 ? q2 : (gf2){hm2[e], hm2[e + 1]};
                const gf2 W0 = {w0[e], w0[e + 1]}, W1 = {w1[e], w1[e + 1]}, W2 = {w2[e], w2[e + 1]}, BB = {bb[e], bb[e + 1]};
                const gf2 r0 = gelu_tanh_mul2(BB + W0 * tm2 + W1 * tm1 + W2 * g[0], v[0]);
                const gf2 r1 = gelu_tanh_mul2(BB + W0 * tm1 + W1 * g[0] + W2 * g[1], v[1]);
                const gf2 r2 = gelu_tanh_mul2(BB + W0 * g[0] + W1 * g[1] + W2 * g[2], v[2]);
                const gf2 r3 = gelu_tanh_mul2(BB + W0 * g[1] + W1 * g[2] + W2 * g[3], v[3]);
                o[0][e] = r0.x; o[0][e + 1] = r0.y; o[1][e] = r1.x; o[1][e + 1] = r1.y; o[2][e] = r2.x; o[2][e + 1] = r2.y; o[3][e] = r3.x; o[3][e + 1] = r3.y;
            }
#pragma unroll
            for (int m = 0; m < 4; ++m) {
                u32x4 w; w.x = cvt_pk_bf16(o[m][0], o[m][1]); w.y = cvt_pk_bf16(o[m][2], o[m][3]); w.z = cvt_pk_bf16(o[m][4], o[m][5]); w.w = cvt_pk_bf16(o[m][6], o[m][7]);
                __builtin_nontemporal_store(w, (u32x4*)(H + (size_t)(row0 + ai * HALF + m) * FF + f0));
            }
        }
        if (wr == 1 && fr == 15) {
#pragma unroll
            for (int k = 0; k < 2; ++k) { const float s = sv[1][2 + k]; float* gd = hb + k * 128; *(f32x4*)gd = cvt4(acc[1][0][2 + k][0], s); *(f32x4*)(gd + 4) = cvt4(acc[1][0][2 + k][1], s); } }
        if (wr == 0 && fr == 0) {
#pragma unroll
            for (int k = 0; k < 2; ++k) { const float s = sv[0][k]; float* gd = hb + (2 + k) * 128; *(f32x4*)gd = cvt4(acc[0][0][k][0], s); *(f32x4*)(gd + 4) = cvt4(acc[0][0][k][1], s);
                float* vd = hb + (4 + k) * 128; *(f32x4*)vd = cvt4(acc[0][1][k][0], s); *(f32x4*)(vd + 4) = cvt4(acc[0][1][k][1], s); } }
    }
};

struct EpiGate {
    static constexpr bool PERM = true, AFTER_DRAIN = false;
    bf16_t* Y; const float* rs; const float* gs; const float* gain;
    __device__ __forceinline__ void operator()(const f32x4 (&acc)[2][2][4][2], const Unit& u, int wr, int wc, int fr, int fq) const {
        const int row0 = u.pm * BM + wr * 64 + fr, col0 = u.pn * BM + wc * 32 + 8 * fq, head = u.pn >> 1;
        float gn[2][8];
#pragma unroll
        for (int bj = 0; bj < 2; ++bj) { const f32x4 a = *(const f32x4*)(gain + col0 + bj * HALF), b = *(const f32x4*)(gain + col0 + bj * HALF + 4);
#pragma unroll
            for (int e = 0; e < 4; ++e) { gn[bj][e] = a[e]; gn[bj][4 + e] = b[e]; } }
#pragma unroll
        for (int ai = 0; ai < 2; ++ai)
#pragma unroll
            for (int m = 0; m < 4; ++m) {
                const int row = row0 + ai * HALF + m * 16; const float s = rs[row]; const float mu = gs[(row * 4 + head) * 2], rstd = gs[(row * 4 + head) * 2 + 1];
                bf16_t* rowp = Y + (size_t)row * 2048 + col0;
#pragma unroll
                for (int bj = 0; bj < 2; ++bj) { const u32x4 yv = *(const u32x4*)(rowp + bj * HALF); float o[8];
#pragma unroll
                    for (int e = 0; e < 8; ++e) { const float g = acc[ai][bj][m][e >> 2][e & 3] * s; const unsigned w = yv[e >> 1]; const float y = __uint_as_float((e & 1) ? (w & 0xffff0000u) : (w << 16));
                        const float sil = g * __builtin_amdgcn_rcpf(1.0f + __builtin_amdgcn_exp2f(-1.4426950408889634f * g)); o[e] = sil * ((y - mu) * rstd * gn[bj][e]); }
                    u32x4 w; w.x = cvt_pk_bf16(o[0], o[1]); w.y = cvt_pk_bf16(o[2], o[3]); w.z = cvt_pk_bf16(o[4], o[5]); w.w = cvt_pk_bf16(o[6], o[7]);
                    *(u32x4*)(rowp + bj * HALF) = w; }
            }
    }
};
}

template <class Epi, int QM = 0>
__device__ __forceinline__ void gemm_call(LAS unsigned char* lds, const bf16* A, const bf16* Bt, int M, int N, int K, const Epi& E, int G, int bid, int wv) {
    pg8::Gemm g{A, Bt, M, N, K}; pg8::StaticOrder S; S.init(M, N, G, bid);
    pg8::gemm_phase<Epi, pg8::StaticOrder, true, true, QM>(lds, g, S, E, wv);
}
template <class Epi, int QM>
__device__ __forceinline__ void gemm_call_pair(LAS unsigned char* lds, const bf16* A, const bf16* Bt, int M, int N, int K, const Epi& E, int G, int bid, int wv) {
    pg8::Gemm g{A, Bt, M, N, K}; pg8::PairOrder S; S.init(M, N, G, bid);
    pg8::gemm_phase<Epi, pg8::PairOrder, true, true, QM>(lds, g, S, E, wv);
}
__device__ __forceinline__ unsigned pk4_fp8(float a, float b, float c, float d) { int w = 0; w = __builtin_amdgcn_cvt_pk_fp8_f32(a, b, w, false); w = __builtin_amdgcn_cvt_pk_fp8_f32(c, d, w, true); return (unsigned)w; }
constexpr float W8_SCALE = 32.0f;

struct TItem { const float* W; int K, N; bf16* WT; const float* gain; int mode, rot_limit, item; const float* wsc  ; };
__device__ __forceinline__ void transpose_load(const TItem& t, int lane, float (&v)[32]) {
    const int nblk = t.N / 32, kb = t.item / nblk, nb = t.item % nblk, k0 = 64 * kb, n0 = 32 * nb;
    int src0 = n0;
    if (t.mode == 1) { const int pn = n0 >> 8, bj = (n0 >> 7) & 1, i0 = n0 & 127; src0 = bj * FF + 128 * pn + i0; }
#pragma unroll
    for (int i = 0; i < 32; ++i) { const int kk = 2 * i + (lane >> 5); const float g = t.gain ? t.gain[k0 + kk] : 1.f; v[i] = t.W[(size_t)(k0 + kk) * t.N + src0 + (lane & 31)] * g; }
}
__device__ __forceinline__ void transpose_finish(const TItem& t, LAS float* scr, int lane, const float (&v)[32]) {
    const int K = t.K; bf16* WT = t.WT; const float* wsc = t.wsc;
    const int nblk = t.N / 32, kb = t.item / nblk, nb = t.item % nblk, k0 = 64 * kb, n0 = 32 * nb;
    int src0 = n0;
    if (t.mode == 1) { const int pn = n0 >> 8, bj = (n0 >> 7) & 1, i0 = n0 & 127; src0 = bj * FF + 128 * pn + i0; }
#pragma unroll
    for (int i = 0; i < 32; ++i) { const int kk = 2 * i + (lane >> 5); scr[kk * 33 + (lane & 31)] = v[i]; }
    LDS_WAIT(); asm volatile("" ::: "memory");
    const int c = lane & 7;
    const bool rot = (n0 < t.rot_limit) && ((n0 & 63) == 0);
#pragma unroll
    for (int j = 0; j < 4; ++j) { const int n = (lane >> 3) + 8 * j; const int sn = (rot && n < 16) ? ((n & 1) * 8 + (n >> 1)) : n; const LAS float* s = scr + (8 * c) * 33 + sn;
        if (wsc) { const float sc = wsc[src0 + n], iv = sc > 0.f ? 1.0f / sc : 0.f;
            v2u o; o.x = pk4_i8(s[0 * 33] * iv, s[1 * 33] * iv, s[2 * 33] * iv, s[3 * 33] * iv); o.y = pk4_i8(s[4 * 33] * iv, s[5 * 33] * iv, s[6 * 33] * iv, s[7 * 33] * iv);
            *(v2u*)((unsigned char*)WT + (size_t)(n0 + n) * K + k0 + 8 * c) = o; continue; }
        v4u o; o.x = pk2(s[0 * 33], s[1 * 33]); o.y = pk2(s[2 * 33], s[3 * 33]); o.z = pk2(s[4 * 33], s[5 * 33]); o.w = pk2(s[6 * 33], s[7 * 33]);
        *(v4u*)(WT + (size_t)(n0 + n) * K + k0 + 8 * c) = o; }
    LDS_WAIT(); asm volatile("" ::: "memory");
}

__device__ __forceinline__ void ph_wmax(const Params& p, LAS unsigned char* lds, int G, int bid, int wv) {
    const int tid = otid(wv), lane = tid & 63, wave = tid >> 6;
    LAS float* part = (LAS float*)lds;
    float* WSC = (float*)(p.ws + WS_WSC);
    for (int it = bid; it < 4 * 44 + 48 + 2 * 24 + 2 * 16; it += G) {
        const float* Wb; const float* gk; int pitch, c, obase, rot_limit;
        if (it < 176) { const int l = it / 44; c = it % 44; Wb = p.w_up + (size_t)l * D * 2 * FF; gk = p.n_ffn_pre + l * D; pitch = 2 * FF; obase = l * 2 * FF; rot_limit = 0; }
        else if (it < 224) { c = it - 176; Wb = p.w_kv; gk = p.kv_norm; pitch = KVW; obase = WSC_KV; rot_limit = 3072; }
        else if (it >= 272) { const int l = (it - 272) / 16; c = 32 + (it - 272) % 16  ; Wb = p.ret_w_in + (size_t)l * D * RET_IN; gk = p.n_mix_pre + l * D; pitch = RET_IN; obase = WSC_RET + l * RET_IN; rot_limit = 0; }
        else { const int l = (it - 224) / 24; c = (it - 224) % 24; Wb = p.w_q + (size_t)l * D * QW; gk = p.n_mix_pre + (2 + l) * D; pitch = QW; obase = WSC_Q + l * QW; rot_limit = QW; }
        const float* W = Wb + 128 * c + 2 * lane;
        float m0 = 0.f, m1 = 0.f;
#pragma unroll 32
        for (int k = wave * 128; k < wave * 128 + 128; ++k) { const float gg = gk[k]; const float2 w = *(const float2*)(W + (size_t)k * pitch); m0 = fmaxf(m0, fabsf(w.x * gg)); m1 = fmaxf(m1, fabsf(w.y * gg)); }
        part[wave * 128 + 2 * lane] = m0; part[wave * 128 + 2 * lane + 1] = m1;
        __syncthreads();
        if (tid < 128) { float m = part[tid];
#pragma unroll
            for (int w = 1; w < 8; ++w) m = fmaxf(m, part[w * 128 + tid]);
            const int sc_ = 128 * c + tid, hj = sc_ & 63; int oc = sc_;
            if (sc_ < rot_limit && hj < 16) oc = (sc_ & ~63) + (hj < 8 ? 2 * hj : 2 * (hj - 8) + 1);
            WSC[obase + oc] = m * (1.0f / 127.0f); }
        __syncthreads();
    }
}
__device__ __forceinline__ void ph_prologue(const Params& p, LAS unsigned char* lds, int G, int bid, int wv) {
    const int tid = otid(wv), lane = tid & 63, wave = tid >> 6;
    LAS float* scr = (LAS float*)(lds + wave * 16384);
    const int gw = bid * 8 + wave, NGW = G * 8;
    bf16* WB = (bf16*)(p.ws + WS_W);
    constexpr int I_RETIN = 16 * 192, I_RETOUT = 32 * 32, I_KV = 16 * 192, I_Q = 16 * 96, I_O = 16 * 32, I_UP = 16 * 176, I_DOWN = 44 * 32;
    constexpr int NITEMS = 2 * I_RETIN + 2 * I_RETOUT + I_KV + 2 * I_Q + 2 * I_O + 4 * I_UP + 4 * I_DOWN;
    const float* WSCb = (const float*)(p.ws + WS_WSC);
    auto decode = [&](int it) -> TItem {
        int r = it;
        if (r < 2 * I_RETIN) { const int l = r / I_RETIN; const int itx = r % I_RETIN; const bool gate = (itx % 192) >= 128;
            bf16* base = WB + W_RETIN + (size_t)l * RET_IN * D;
            return TItem{p.ret_w_in + (size_t)l * D * RET_IN, D, RET_IN, gate ? (bf16*)((unsigned char*)base + (size_t)RQP * D) : base, p.n_mix_pre + l * D, 0, 0, itx, gate ? WSCb + WSC_RET + l * RET_IN : nullptr}; } r -= 2 * I_RETIN;
        if (r < 2 * I_RETOUT) { const int l = r / I_RETOUT; return TItem{p.ret_w_out + (size_t)l * 2048 * D, 2048, D, WB + W_RETOUT + (size_t)l * D * 2048, nullptr, 0, 0, r % I_RETOUT, nullptr}; } r -= 2 * I_RETOUT;
        if (r < I_KV) return TItem{p.w_kv, D, KVW, WB + W_KV, p.kv_norm, 0, 3072, r, WSCb + WSC_KV}; r -= I_KV;
        if (r < 2 * I_Q) { const int l = r / I_Q; return TItem{p.w_q + (size_t)l * D * QW, D, QW, (bf16*)((unsigned char*)(WB + W_Q) + (size_t)l * QW * D), p.n_mix_pre + (2 + l) * D, 0, QW, r % I_Q, WSCb + WSC_Q + l * QW}; } r -= 2 * I_Q;
        if (r < 2 * I_O) { const int l = r / I_O; return TItem{p.w_o + (size_t)l * D * D, D, D, WB + W_O + (size_t)l * D * D, nullptr, 0, 0, r % I_O, nullptr}; } r -= 2 * I_O;
        if (r < 4 * I_UP) { const int l = r / I_UP; return TItem{p.w_up + (size_t)l * D * 2 * FF, D, 2 * FF, (bf16*)((unsigned char*)(WB + W_UP) + (size_t)l * 2 * FF * D), p.n_ffn_pre + l * D, 1, 0, r % I_UP, WSCb + l * 2 * FF}; } r -= 4 * I_UP;
        { const int l = r / I_DOWN; return TItem{p.w_down + (size_t)l * FF * D, FF, D, WB + W_DOWN + (size_t)l * D * FF, nullptr, 0, 0, r % I_DOWN, nullptr}; }
    };
    if (gw < NITEMS) {
        TItem cur = decode(gw); float v[32]; transpose_load(cur, lane, v);
        for (int it = gw; it < NITEMS; it += NGW) {
            const int nit = it + NGW < NITEMS ? it + NGW : it;
            const TItem nx = decode(nit); float vn[32]; transpose_load(nx, lane, vn);
            transpose_finish(cur, scr, lane, v);
            cur = nx;
#pragma unroll
            for (int i = 0; i < 32; ++i) v[i] = vn[i];
        }
    }
    float* rcos = (float*)(p.ws + WS_RCOS); float* rsin = (float*)(p.ws + WS_RSIN); float* acos_ = (float*)(p.ws + WS_ACOS); float* asin_ = (float*)(p.ws + WS_ASIN);
    const int gt = bid * 512 + tid, NGT = G * 512;
    for (int i = gt; i < 2048 * 128; i += NGT) { const int pos = i >> 7, j = i & 127;
        const float inv = (float)(1.0 / pow(10000.0, (double)j / 127.0)); const float ang = (float)pos * inv;
        rcos[i] = (float)cos((double)ang); rsin[i] = (float)sin((double)ang); }
    for (int i = gt; i < 2048 * 8; i += NGT) { const int pos = i >> 3, j = i & 7;
        const float inv = (float)pow(500000.0, -(double)(2 * j) / 16.0); const float ang = (float)pos * inv;
        acos_[i] = (float)cos((double)ang); asin_[i] = (float)sin((double)ang); }
    bf16* XB = (bf16*)(p.ws + WS_XB); float* RS = (float*)(p.ws + WS_RS); float* SA = (float*)(p.ws + WS_SA); unsigned char* A8 = p.ws + WS_MB;
    f32x4 v[4];
#pragma unroll
    for (int j = 0; j < 4; ++j) v[j] = ((const f32x4*)(p.x + (size_t)gw * D) + lane)[64 * j];
    for (int m = gw; m < M_ALL; m += NGW) {
        const int mn = m + NGW < M_ALL ? m + NGW : m;
        f32x4 vn[4];
#pragma unroll
        for (int j = 0; j < 4; ++j) vn[j] = ((const f32x4*)(p.x + (size_t)mn * D) + lane)[64 * j];
        float s = 0.f;
#pragma unroll
        for (int j = 0; j < 4; ++j) s += (v[j][0] * v[j][0] + v[j][1] * v[j][1]) + (v[j][2] * v[j][2] + v[j][3] * v[j][3]);
        s = wave_sum(s);
        v2u* o = (v2u*)(XB + (size_t)m * D) + lane;
#pragma unroll
        for (int j = 0; j < 4; ++j) { v2u w; w.x = pk2(v[j][0], v[j][1]); w.y = pk2(v[j][2], v[j][3]); o[64 * j] = w; }
        const float rn = 1.0f / sqrtf(s * (1.0f / D) + RMS_EPS);
        if (lane == 0) RS[m] = rn;
        float am = 0.f;
#pragma unroll
        for (int j = 0; j < 4; ++j) am = fmaxf(fmaxf(am, fmaxf(fabsf(v[j][0]), fabsf(v[j][1]))), fmaxf(fabsf(v[j][2]), fabsf(v[j][3])));
        am = wave_max(am);
        const float iv = am > 0.f ? 127.0f / am : 0.f;
        if (lane == 0) SA[m] = rn * am * (1.0f / 127.0f);
        unsigned* a8 = (unsigned*)(A8 + (size_t)m * D) + lane;
#pragma unroll
        for (int j = 0; j < 4; ++j) a8[64 * j] = pk4_i8(v[j][0] * iv, v[j][1] * iv, v[j][2] * iv, v[j][3] * iv);
#pragma unroll
        for (int j = 0; j < 4; ++j) v[j] = vn[j];
    }
}

__device__ __forceinline__ void thin_row(bf16* xrow, const bf16* mrow, float* rsp, float* orow, unsigned char* a8row, float* sap, const f32x4 (&g)[4], const v4u (&xv)[2], const v4u (&mv)[2], int lane) {
    float mf[16], xf[16]; float sm = 0.f;
#pragma unroll
    for (int j = 0; j < 2; ++j)
#pragma unroll
        for (int e = 0; e < 4; ++e) { mf[8 * j + 2 * e] = __uint_as_float(mv[j][e] << 16); mf[8 * j + 2 * e + 1] = __uint_as_float(mv[j][e] & 0xffff0000u);
            xf[8 * j + 2 * e] = __uint_as_float(xv[j][e] << 16); xf[8 * j + 2 * e + 1] = __uint_as_float(xv[j][e] & 0xffff0000u); }
#pragma unroll
    for (int e = 0; e < 16; ++e) sm += mf[e] * mf[e];
    const float r = 1.0f / sqrtf(wave_sum(sm) * (1.0f / D) + RMS_EPS);
    float s = 0.f; v4u wk[2];
#pragma unroll
    for (int j = 0; j < 2; ++j) { float y[8];
#pragma unroll
        for (int e = 0; e < 8; ++e) y[e] = xf[8 * j + e] + g[2 * j + (e >> 2)][e & 3] * r * mf[8 * j + e];
        v4u w; w.x = pk2(y[0], y[1]); w.y = pk2(y[2], y[3]); w.z = pk2(y[4], y[5]); w.w = pk2(y[6], y[7]);
        *((v4u*)(xrow + 512 * j) + lane) = w; wk[j] = w;
        if (orow) { __builtin_nontemporal_store((f32x4){y[0], y[1], y[2], y[3]}, (f32x4*)(orow + 512 * j) + 2 * lane); __builtin_nontemporal_store((f32x4){y[4], y[5], y[6], y[7]}, (f32x4*)(orow + 512 * j) + 2 * lane + 1); }
#pragma unroll
        for (int e = 0; e < 4; ++e) { const float a = __uint_as_float(w[e] << 16), b = __uint_as_float(w[e] & 0xffff0000u); s += a * a + b * b; } }
    s = wave_sum(s);
    const float rn = 1.0f / sqrtf(s * (1.0f / D) + RMS_EPS);
    if (lane == 0) *rsp = rn;
    if (a8row) {
        float f[16]; float am = 0.f;
#pragma unroll
        for (int j = 0; j < 2; ++j)
#pragma unroll
            for (int e = 0; e < 4; ++e) { f[8 * j + 2 * e] = __uint_as_float(wk[j][e] << 16); f[8 * j + 2 * e + 1] = __uint_as_float(wk[j][e] & 0xffff0000u); }
#pragma unroll
        for (int e = 0; e < 16; ++e) am = fmaxf(am, fabsf(f[e]));
        am = wave_max(am);
        const float iv = am > 0.f ? 127.0f / am : 0.f;
        if (lane == 0) *sap = rn * am * (1.0f / 127.0f);
#pragma unroll
        for (int j = 0; j < 2; ++j) { v2u o; o.x = pk4_i8(f[8 * j] * iv, f[8 * j + 1] * iv, f[8 * j + 2] * iv, f[8 * j + 3] * iv); o.y = pk4_i8(f[8 * j + 4] * iv, f[8 * j + 5] * iv, f[8 * j + 6] * iv, f[8 * j + 7] * iv);
            *((v2u*)(a8row + 512 * j) + lane) = o; }
    }
}
__device__ __forceinline__ void ph_thin(const Params& p, int row0, int nrows, const bf16* MB, const float* gpost, float* outf, unsigned char* a8, bool a8perm  , int G, int bid, int wv) {
    const int tid = otid(wv), lane = tid & 63, wave = tid >> 6, gw = bid * 8 + wave, NGW = G * 8;
    bf16* XB = (bf16*)(p.ws + WS_XB) + (size_t)row0 * D;
    float* RS = (float*)(p.ws + WS_RS) + row0; float* SA = (float*)(p.ws + WS_SA) + row0;
    f32x4 g[4];
#pragma unroll
    for (int j = 0; j < 2; ++j) { g[2 * j] = ((const f32x4*)(gpost + 512 * j))[2 * lane]; g[2 * j + 1] = ((const f32x4*)(gpost + 512 * j))[2 * lane + 1]; }
    for (int m = gw; m < nrows; m += 2 * NGW) {
        const int m2 = m + NGW; const bool has2 = m2 < nrows; const int mb = has2 ? m2 : m;
        v4u xa[2], ma[2], xb[2], mbv[2];
#pragma unroll
        for (int j = 0; j < 2; ++j) { xa[j] = *((const v4u*)(XB + (size_t)m * D + 512 * j) + lane); ma[j] = *((const v4u*)(MB + (size_t)m * D + 512 * j) + lane);
            xb[j] = *((const v4u*)(XB + (size_t)mb * D + 512 * j) + lane); mbv[j] = *((const v4u*)(MB + (size_t)mb * D + 512 * j) + lane); }
        thin_row(XB + (size_t)m * D, MB + (size_t)m * D, RS + m, outf ? outf + (size_t)m * D : nullptr, a8 ? a8 + (size_t)(a8perm ? ((m & ~63) | ((m & 3) << 4) | ((m >> 2) & 15)) : m) * D : nullptr, SA + m, g, xa, ma, lane);
        if (has2) thin_row(XB + (size_t)m2 * D, MB + (size_t)m2 * D, RS + m2, outf ? outf + (size_t)m2 * D : nullptr, a8 ? a8 + (size_t)(a8perm ? ((m2 & ~63) | ((m2 & 3) << 4) | ((m2 >> 2) & 15)) : m2) * D : nullptr, SA + m2, g, xb, mbv, lane);
    }
}
__device__ __forceinline__ void conv_fix_local(const Params& p, int layer, bf16* H, int nrows, int G, int bid, int wv) {
    const int tid = otid(wv);
    const float* halo = (const float*)(p.ws + WS_HALO);
    const float* cw = p.conv_w + (size_t)layer * 3 * FF; const float* cb = p.conv_b + (size_t)layer * FF; const float* sw = (const float*)(p.ws + WS_WSC) + layer * 2 * FF;
    pg8::StaticOrder S; S.init(nrows, D, G, bid); pg8::Unit u;
    for (int i = 0; S.next(i, u); ++i) {
        const int pm = u.pm; if ((pm & 7) == 0) continue;
        float ov[11];
#pragma unroll
        for (int q = 0; q < 11; ++q) { const int e = tid + 512 * q; const int j = e >= FF ? 1 : 0, f = e - j * FF, pn = f >> 7, c = f & 127;
            const float* cur = halo + ((size_t)pm * 22 + pn) * 768; const float* prv = halo + ((size_t)(pm - 1) * 22 + pn) * 768;
            const float g0 = cur[(2 + j) * 128 + c], gm1 = j ? cur[2 * 128 + c] : prv[128 + c], gm2 = j ? prv[128 + c] : prv[c], v = cur[(4 + j) * 128 + c];
            const float cv = cb[f] + sw[f] * (cw[f] * gm2 + cw[FF + f] * gm1 + cw[2 * FF + f] * g0);
            ov[q] = pg8::gelu_tanh_mul(cv, v * sw[FF + f]); }
#pragma unroll
        for (int q = 0; q < 11; ++q) { const int e = tid + 512 * q; const int j = e >= FF ? 1 : 0, f = e - j * FF; H[(size_t)(pm * 256 + j) * FF + f] = (bf16)f2bf(ov[q]); }
    }
    asm volatile("s_waitcnt vmcnt(0)" ::: "memory"); __syncthreads();
}

__device__ __forceinline__ void ph_gn_stats(const Params& p, int G, int bid, int wv) {
    const int tid = otid(wv), lane = tid & 63, wave = tid >> 6, gw = bid * 8 + wave, NGW = G * 8;
    const bf16* Y = (const bf16*)p.out; float* GS = (float*)(p.ws + WS_GS);
    for (int row = gw; row < M_ALL; row += NGW) {
        v4u yv[4];
#pragma unroll
        for (int hd = 0; hd < 4; ++hd) yv[hd] = *((const v4u*)(Y + (size_t)row * 2048 + hd * 512) + lane);
        float mu4[4], rs4[4];
#pragma unroll
        for (int hd = 0; hd < 4; ++hd) {
            float y[8];
#pragma unroll
            for (int e = 0; e < 4; ++e) { y[2 * e] = __uint_as_float(yv[hd][e] << 16); y[2 * e + 1] = __uint_as_float(yv[hd][e] & 0xffff0000u); }
            float s = 0.f;
#pragma unroll
            for (int e = 0; e < 8; ++e) s += y[e];
            const float mu = wave_sum(s) * (1.0f / 512.0f); float q = 0.f;
#pragma unroll
            for (int e = 0; e < 8; ++e) { const float d = y[e] - mu; q += d * d; }
            mu4[hd] = mu; rs4[hd] = 1.0f / sqrtf(wave_sum(q) * (1.0f / 512.0f) + GN_EPS);
        }
        if (lane == 0) { *(f32x4*)(GS + (size_t)row * 8) = (f32x4){mu4[0], rs4[0], mu4[1], rs4[1]}; *(f32x4*)(GS + (size_t)row * 8 + 4) = (f32x4){mu4[2], rs4[2], mu4[3], rs4[3]}; }
    }
}

typedef float f32x16 __attribute__((ext_vector_type(16)));
typedef short s16x8 __attribute__((ext_vector_type(8)));
typedef float af2 __attribute__((ext_vector_type(2)));
constexpr float RESCALE_THR = 8.0f;
typedef short s16x4 __attribute__((ext_vector_type(4)));
__device__ __forceinline__ int vt_off(int row, int ch) { return 1024 * (row >> 3) + 512 * (ch >> 2) + 64 * (row & 7) + 16 * ((ch & 3) ^ ((row >> 2) & 3)); }
__device__ __forceinline__ unsigned cvtpk(float lo, float hi) { return pg8::cvt_pk_bf16(lo, hi); }


template <int DIL>
__device__ __forceinline__ void attn_group(const s16x8 (&qf)[4], const bf16* kbase  , int qpos, int ntiles, int base, int n_inner, int step_inner, int step_outer, int n_win, int first_causal,
                                           f32x16& o0, f32x16& o1, float& m, float& lsum, LAS unsigned char* vbuf, int lane,
                                           v4u (&kc)[4], v4u (&vc)[4]  , const bf16* nsrc  ) {
    const int r32 = lane & 31, hi = lane >> 5;
    constexpr float C2 = 0.125f * 1.4426950408889634f;
    const int vrow = lane >> 3, vch = lane & 7;
    int woff[4];
#pragma unroll
    for (int i = 0; i < 4; ++i) woff[i] = vt_off(vrow + 8 * i, vch);
    const int g1 = (lane >> 4) & 1, q4 = (lane >> 2) & 3, pp = lane & 3;
    int ca = 0, cj = 0, kp_cur = base;
    for (int u = 0; u < ntiles; ++u) {
        const int kp0 = kp_cur, cj_cur = cj;
        int nj = cj + 1, na = ca; if (nj == n_inner) { nj = 0; na = ca + 1; }
        const bool more = u + 1 < ntiles; const int kpn = more ? base + na * step_outer + nj * step_inner : kp0;
        ca = na; cj = nj; kp_cur = kpn;
        LAS unsigned char* kb = vbuf; LAS unsigned char* vb = kb + 4096;
#pragma unroll
        for (int i = 0; i < 4; ++i) { *(LAS v4u*)(kb + woff[i]) = kc[i]; *(LAS v4u*)(vb + woff[i]) = vc[i]; }
        asm volatile("s_waitcnt lgkmcnt(0)" ::: "memory"); __builtin_amdgcn_wave_barrier();
        const int sln = DIL == 1 ? kpn : (DIL == 4 ? (((kpn & 3) << 9) | (kpn >> 2)) : (((kpn & 15) << 7) | (kpn >> 4)));
        const bf16* nb = more ? kbase + (size_t)sln * 64 : nsrc;
#pragma unroll
        for (int i = 0; i < 4; ++i) { const bf16* src = nb + (vrow + 8 * i) * 64 + 8 * vch; kc[i] = *(const v4u*)src; vc[i] = *(const v4u*)(src + 131072); }
        f32x16 S;
#pragma unroll
        for (int r = 0; r < 16; ++r) S[r] = 0.f;
#pragma unroll
        for (int s = 0; s < 4; ++s) { const s16x8 kf = *(LAS s16x8*)(kb + vt_off(r32, 2 * s + hi)); S = __builtin_amdgcn_mfma_f32_32x32x16_bf16(kf, qf[s], S, 0, 0, 0); }
        const bool t_causal = (DIL == 16) ? (cj_cur == n_inner - 1) : (u >= first_causal);
        const int dbase = qpos - kp0 - 4 * hi * DIL;
        constexpr bool lv = true;
        if (t_causal) { const int a = (DIL == 16) ? (lv ? dbase : -1) : dbase;
#pragma unroll
            for (int r = 0; r < 16; ++r) { const int kr = ((r & 3) + 8 * (r >> 2)) * DIL; S[r] = (kr <= a) ? S[r] : -INFINITY; }
        } else if (u < n_win) { const int bw = dbase - 128 * DIL;
#pragma unroll
            for (int r = 0; r < 16; ++r) { const int kr = ((r & 3) + 8 * (r >> 2)) * DIL; S[r] = (kr >= bw) ? S[r] : -INFINITY; }
        }
        float tmax = S[0];
#pragma unroll
        for (int r = 1; r < 16; ++r) tmax = fmaxf(tmax, S[r]);
        const bool pmask = (DIL == 16) && !t_causal;
        if (pmask) tmax = lv ? tmax : -INFINITY;
        tmax = xmax32(tmax);
        const float mnew = fmaxf(m, tmax * C2);
        if (__builtin_amdgcn_ballot_w64(mnew > m + RESCALE_THR) != 0) {
            const float alpha = __builtin_amdgcn_exp2f(m - mnew); m = mnew; lsum *= alpha;
#pragma unroll
            for (int r = 0; r < 16; ++r) { o0[r] *= alpha; o1[r] *= alpha; }
        }
        float ps;
        { af2 ps2 = {0.f, 0.f}; const af2 c2 = {C2, C2}, nm = {-m, -m};
#pragma unroll
          for (int r = 0; r < 16; r += 2) { const af2 a = (af2){S[r], S[r + 1]} * c2 + nm; af2 ev; ev.x = __builtin_amdgcn_exp2f(a.x); ev.y = __builtin_amdgcn_exp2f(a.y); S[r] = ev.x; S[r + 1] = ev.y; ps2 += ev; }
          ps = ps2.x + ps2.y; }
        if (pmask) ps = lv ? ps : 0.f;
        lsum += ps;
        s16x8 pb[2];
#pragma unroll
        for (int s = 0; s < 2; ++s) { v4u w; w.x = cvtpk(S[8 * s + 0], S[8 * s + 1]); w.y = cvtpk(S[8 * s + 2], S[8 * s + 3]); w.z = cvtpk(S[8 * s + 4], S[8 * s + 5]); w.w = cvtpk(S[8 * s + 6], S[8 * s + 7]);
            if (pmask) { const unsigned lm = lv ? 0xffffffffu : 0u; w.x &= lm; w.y &= lm; w.z &= lm; w.w &= lm; }
            pb[s] = __builtin_bit_cast(s16x8, w); }
#pragma unroll
        for (int dt = 0; dt < 2; ++dt)
#pragma unroll
            for (int s = 0; s < 2; ++s) {
                s16x4 lo = __builtin_amdgcn_ds_read_tr16_b64_v4i16((LAS s16x4*)(vb + vt_off(16 * s + 4 * hi + q4, 4 * dt + 2 * g1 + (pp >> 1)) + 8 * (pp & 1)));
                s16x4 hi4 = __builtin_amdgcn_ds_read_tr16_b64_v4i16((LAS s16x4*)(vb + vt_off(16 * s + 8 + 4 * hi + q4, 4 * dt + 2 * g1 + (pp >> 1)) + 8 * (pp & 1)));
                const s16x8 va = (s16x8){lo[0], lo[1], lo[2], lo[3], hi4[0], hi4[1], hi4[2], hi4[3]};
                if (dt == 0) o0 = __builtin_amdgcn_mfma_f32_32x32x16_bf16(va, pb[s], o0, 0, 0, 0);
                else o1 = __builtin_amdgcn_mfma_f32_32x32x16_bf16(va, pb[s], o1, 0, 0, 0);
            }
    }
    asm volatile("s_waitcnt lgkmcnt(0)" ::: "memory"); __builtin_amdgcn_wave_barrier();
}
__device__ __forceinline__ void attn_pair0(const s16x8 (&qa)[4], const s16x8 (&qb)[4], const bf16* kbase, int qposA, int ntiles, int base, int n_win, bool rot  ,
                                           f32x16& a0, f32x16& a1, float& ma, float& la, f32x16& b0, f32x16& b1, float& mb, float& lb,
                                           LAS unsigned char* vbuf, int lane, v4u (&kc)[4], v4u (&vc)[4], const bf16* nsrc) {
    const int r32 = lane & 31, hi = lane >> 5;
    constexpr float C2 = 0.125f * 1.4426950408889634f;
    const int vrow = lane >> 3, vch = lane & 7;
    int woff[4];
#pragma unroll
    for (int i = 0; i < 4; ++i) woff[i] = vt_off(vrow + 8 * i, vch);
    const int g1 = (lane >> 4) & 1, q4 = (lane >> 2) & 3, pp = lane & 3;
    for (int v = 0; v < ntiles; ++v) {
        const int u = rot ? ((v + 4) & 7) : v, un = rot ? ((v + 5) & 7) : v + 1;
        const int kp0 = base + 32 * u; const bool more = v + 1 < ntiles;
        LAS unsigned char* kb = vbuf; LAS unsigned char* vb = kb + 4096;
#pragma unroll
        for (int i = 0; i < 4; ++i) { *(LAS v4u*)(kb + woff[i]) = kc[i]; *(LAS v4u*)(vb + woff[i]) = vc[i]; }
        asm volatile("s_waitcnt lgkmcnt(0)" ::: "memory"); __builtin_amdgcn_wave_barrier();
        const bf16* nb = more ? kbase + (size_t)(base + 32 * un) * 64 : nsrc;
#pragma unroll
        for (int i = 0; i < 4; ++i) { const bf16* src = nb + (vrow + 8 * i) * 64 + 8 * vch; kc[i] = *(const v4u*)src; vc[i] = *(const v4u*)(src + 131072); }
        f32x16 SA, SB;
#pragma unroll
        for (int r = 0; r < 16; ++r) { SA[r] = 0.f; SB[r] = 0.f; }
#pragma unroll
        for (int s = 0; s < 4; ++s) { const s16x8 kf = *(LAS s16x8*)(kb + vt_off(r32, 2 * s + hi));
            SA = __builtin_amdgcn_mfma_f32_32x32x16_bf16(kf, qa[s], SA, 0, 0, 0); SB = __builtin_amdgcn_mfma_f32_32x32x16_bf16(kf, qb[s], SB, 0, 0, 0); }
        const int dA = qposA - kp0 - 4 * hi;
        if (u >= n_win) {
#pragma unroll
            for (int r = 0; r < 16; ++r) { const int kr = (r & 3) + 8 * (r >> 2); SA[r] = (kr <= dA) ? SA[r] : -INFINITY; SB[r] = (kr <= dA + 1) ? SB[r] : -INFINITY; }
        } else { const int bw = dA - 128;
#pragma unroll
            for (int r = 0; r < 16; ++r) { const int kr = (r & 3) + 8 * (r >> 2); SA[r] = (kr >= bw) ? SA[r] : -INFINITY; SB[r] = (kr >= bw + 1) ? SB[r] : -INFINITY; }
        }
        float tA = SA[0], tB = SB[0];
#pragma unroll
        for (int r = 1; r < 16; ++r) { tA = fmaxf(tA, SA[r]); tB = fmaxf(tB, SB[r]); }
        tA = xmax32(tA); tB = xmax32(tB);
        const float mnA = fmaxf(ma, tA * C2), mnB = fmaxf(mb, tB * C2);
        if (__builtin_amdgcn_ballot_w64((mnA > ma + RESCALE_THR) | (mnB > mb + RESCALE_THR)) != 0) {
            const float alA = __builtin_amdgcn_exp2f(ma - mnA), alB = __builtin_amdgcn_exp2f(mb - mnB); ma = mnA; mb = mnB; la *= alA; lb *= alB;
#pragma unroll
            for (int r = 0; r < 16; ++r) { a0[r] *= alA; a1[r] *= alA; b0[r] *= alB; b1[r] *= alB; }
        }
        float psA, psB;
        { af2 pa2 = {0.f, 0.f}, pb2 = {0.f, 0.f}; const af2 c2 = {C2, C2}, nma = {-ma, -ma}, nmb = {-mb, -mb};
#pragma unroll
          for (int r = 0; r < 16; r += 2) {
              const af2 xa = (af2){SA[r], SA[r + 1]} * c2 + nma; af2 ea; ea.x = __builtin_amdgcn_exp2f(xa.x); ea.y = __builtin_amdgcn_exp2f(xa.y); SA[r] = ea.x; SA[r + 1] = ea.y; pa2 += ea;
              const af2 xb = (af2){SB[r], SB[r + 1]} * c2 + nmb; af2 eb; eb.x = __builtin_amdgcn_exp2f(xb.x); eb.y = __builtin_amdgcn_exp2f(xb.y); SB[r] = eb.x; SB[r + 1] = eb.y; pb2 += eb; }
          psA = pa2.x + pa2.y; psB = pb2.x + pb2.y; }
        la += psA; lb += psB;
        s16x8 pa[2], pb[2];
#pragma unroll
        for (int s = 0; s < 2; ++s) { v4u w; w.x = cvtpk(SA[8 * s + 0], SA[8 * s + 1]); w.y = cvtpk(SA[8 * s + 2], SA[8 * s + 3]); w.z = cvtpk(SA[8 * s + 4], SA[8 * s + 5]); w.w = cvtpk(SA[8 * s + 6], SA[8 * s + 7]); pa[s] = __builtin_bit_cast(s16x8, w);
            v4u x; x.x = cvtpk(SB[8 * s + 0], SB[8 * s + 1]); x.y = cvtpk(SB[8 * s + 2], SB[8 * s + 3]); x.z = cvtpk(SB[8 * s + 4], SB[8 * s + 5]); x.w = cvtpk(SB[8 * s + 6], SB[8 * s + 7]); pb[s] = __builtin_bit_cast(s16x8, x); }
#pragma unroll
        for (int dt = 0; dt < 2; ++dt)
#pragma unroll
            for (int s = 0; s < 2; ++s) {
                s16x4 lo = __builtin_amdgcn_ds_read_tr16_b64_v4i16((LAS s16x4*)(vb + vt_off(16 * s + 4 * hi + q4, 4 * dt + 2 * g1 + (pp >> 1)) + 8 * (pp & 1)));
                s16x4 hi4 = __builtin_amdgcn_ds_read_tr16_b64_v4i16((LAS s16x4*)(vb + vt_off(16 * s + 8 + 4 * hi + q4, 4 * dt + 2 * g1 + (pp >> 1)) + 8 * (pp & 1)));
                const s16x8 va = (s16x8){lo[0], lo[1], lo[2], lo[3], hi4[0], hi4[1], hi4[2], hi4[3]};
                if (dt == 0) { a0 = __builtin_amdgcn_mfma_f32_32x32x16_bf16(va, pa[s], a0, 0, 0, 0); b0 = __builtin_amdgcn_mfma_f32_32x32x16_bf16(va, pb[s], b0, 0, 0, 0); }
                else { a1 = __builtin_amdgcn_mfma_f32_32x32x16_bf16(va, pa[s], a1, 0, 0, 0); b1 = __builtin_amdgcn_mfma_f32_32x32x16_bf16(va, pb[s], b1, 0, 0, 0); }
            }
    }
    asm volatile("s_waitcnt lgkmcnt(0)" ::: "memory"); __builtin_amdgcn_wave_barrier();
}
__device__ __forceinline__ void tile_first(const bf16* krows, v4u (&kc)[4], v4u (&vc)[4], int lane) {
    const int vrow = lane >> 3, vch = lane & 7;
#pragma unroll
    for (int i = 0; i < 4; ++i) { const bf16* src = krows + (vrow + 8 * i) * 64 + 8 * vch; kc[i] = *(const v4u*)src; vc[i] = *(const v4u*)(src + 131072); }
}

__device__ __forceinline__ void ph_attn_g2(const Params& p, LAS unsigned char* lds, int G, int bid, int wv) {
    const int tid = otid(wv), lane = tid & 63, wave = __builtin_amdgcn_readfirstlane(tid >> 6);
    const int r32 = lane & 31, hi = lane >> 5;
    const bf16* Qb = (const bf16*)(p.ws + WS_Q); const bf16* KV = (const bf16*)(p.ws + WS_BIG); bf16* O2 = (bf16*)((unsigned char*)p.out + 192 * MiB); float* ML = (float*)(p.ws + WS_GS);
    LAS unsigned char* vbuf = lds + wave * 16384;
    const int vcu = (bid & 7) * (G >> 3) + (bid >> 3);
    const int NW = G * 8, gw = vcu * 8 + wave;
    v4u kc[4], vc[4];
    s16x8 qf[4];
    { const int x = gw >> 2, r16 = x & 15, bh = x >> 4, t0 = gw & 3; tile_first(KV + ((size_t)((bh >> 4) * 48 + 32 + (bh & 15)) * 2 * 2048 + r16 * 128) * 64, kc, vc, lane);
      const bf16* q0 = Qb + ((size_t)((bh >> 4) * 48 + 32 + (bh & 15)) * 2048 + r16 * 128 + 32 * t0 + r32) * 64 + 8 * hi;
#pragma unroll
      for (int s = 0; s < 4; ++s) qf[s] = *(const s16x8*)(q0 + 16 * s); }
    for (int T = gw, k = 0; T < 16 * 16 * 16 * 4; T += NW, ++k) {
        const int traw = T & 3, t = (k & 1) ? 3 - traw : traw, x = T >> 2, r16 = x & 15, bh = x >> 4, h = bh & 15, b = bh >> 4;
        const int bhn = (T + NW < 16 * 16 * 16 * 4) ? bh + (NW >> 6) : bh;
        const bf16* nsrc = KV + ((size_t)((bhn >> 4) * 48 + 32 + (bhn & 15)) * 2 * 2048 + r16 * 128) * 64;
        const int qpos = r16 + 16 * (32 * t + r32); const size_t brow = (size_t)b * SEQ;
        f32x16 o0, o1;
#pragma unroll
        for (int r = 0; r < 16; ++r) { o0[r] = 0.f; o1[r] = 0.f; }
        float m = -1.0e30f, lsum = 0.f;
        const bf16* kb = KV + (size_t)(b * 48 + 32 + h) * 2 * 131072;
        const int tn = (T + NW < 16 * 16 * 16 * 4) ? 3 - t : t;
        const bf16* qn = Qb + ((size_t)((bhn >> 4) * 48 + 32 + (bhn & 15)) * 2048 + r16 * 128 + 32 * tn + r32) * 64 + 8 * hi;
        s16x8 qfn[4];
#pragma unroll
        for (int s = 0; s < 4; ++s) qfn[s] = *(const s16x8*)(qn + 16 * s);
        attn_group<16>(qf, kb, qpos, t + 1, r16, t + 1, 512, 0, 0, 0, o0, o1, m, lsum, vbuf, lane, kc, vc, nsrc);
        const float l = xsum32(lsum);
        bf16* orow = O2 + ((size_t)bh * 2048 + r16 * 128 + 32 * t + r32) * 64 + 4 * hi;
#pragma unroll
        for (int rg = 0; rg < 4; ++rg) {
            v2u w0; w0.x = cvtpk(o0[4 * rg], o0[4 * rg + 1]); w0.y = cvtpk(o0[4 * rg + 2], o0[4 * rg + 3]); *(v2u*)(orow + 8 * rg) = w0;
            v2u w1; w1.x = cvtpk(o1[4 * rg], o1[4 * rg + 1]); w1.y = cvtpk(o1[4 * rg + 2], o1[4 * rg + 3]); *(v2u*)(orow + 32 + 8 * rg) = w1;
        }
        if (hi == 0) { float* ml = ML + ((size_t)((bh * 16 + r16) * 128 + 32 * t + r32)) * 2; v2u w; w.x = __float_as_uint(m); w.y = __float_as_uint(l); *(v2u*)ml = w; }
#pragma unroll
        for (int s = 0; s < 4; ++s) qf[s] = qfn[s];
    }
}
__device__ __forceinline__ void y_state(const bf16* o2, const float* ml, int hi, f32x16& o0, f32x16& o1, float& m, float& l) {
#pragma unroll
    for (int rg = 0; rg < 4; ++rg) { const v2u w0 = *(const v2u*)(o2 + 8 * rg), w1 = *(const v2u*)(o2 + 32 + 8 * rg);
        o0[4 * rg] = __uint_as_float(w0.x << 16); o0[4 * rg + 1] = __uint_as_float(w0.x & 0xffff0000u); o0[4 * rg + 2] = __uint_as_float(w0.y << 16); o0[4 * rg + 3] = __uint_as_float(w0.y & 0xffff0000u);
        o1[4 * rg] = __uint_as_float(w1.x << 16); o1[4 * rg + 1] = __uint_as_float(w1.x & 0xffff0000u); o1[4 * rg + 2] = __uint_as_float(w1.y << 16); o1[4 * rg + 3] = __uint_as_float(w1.y & 0xffff0000u); }
    const v2u mlv = *(const v2u*)ml; m = __uint_as_float(mlv.x); l = hi == 0 ? __uint_as_float(mlv.y) : 0.f;
}
__device__ __forceinline__ void y_store(bf16* orow0  , int hi, const f32x16& o0, const f32x16& o1, float lsum) {
    const float l = xsum32(lsum); const float inv = 1.0f / l;
#pragma unroll
    for (int pr2 = 0; pr2 < 2; ++pr2) {
        { const unsigned ax = cvtpk(o0[8 * pr2] * inv, o0[8 * pr2 + 1] * inv), ay = cvtpk(o0[8 * pr2 + 2] * inv, o0[8 * pr2 + 3] * inv), bx = cvtpk(o0[8 * pr2 + 4] * inv, o0[8 * pr2 + 5] * inv), by = cvtpk(o0[8 * pr2 + 6] * inv, o0[8 * pr2 + 7] * inv);
          auto sx = __builtin_amdgcn_permlane32_swap(ax, bx, false, false); auto sy = __builtin_amdgcn_permlane32_swap(ay, by, false, false);
          v4u w; w.x = sx[0]; w.y = sy[0]; w.z = sx[1]; w.w = sy[1]; *(v4u*)(orow0 + 16 * pr2 + 8 * hi) = w; }
        { const unsigned ax = cvtpk(o1[8 * pr2] * inv, o1[8 * pr2 + 1] * inv), ay = cvtpk(o1[8 * pr2 + 2] * inv, o1[8 * pr2 + 3] * inv), bx = cvtpk(o1[8 * pr2 + 4] * inv, o1[8 * pr2 + 5] * inv), by = cvtpk(o1[8 * pr2 + 6] * inv, o1[8 * pr2 + 7] * inv);
          auto sx = __builtin_amdgcn_permlane32_swap(ax, bx, false, false); auto sy = __builtin_amdgcn_permlane32_swap(ay, by, false, false);
          v4u w; w.x = sx[0]; w.y = sy[0]; w.z = sx[1]; w.w = sy[1]; *(v4u*)(orow0 + 32 + 16 * pr2 + 8 * hi) = w; }
    }
}
constexpr int HO_O2 = 65536, HO_ML = 132096;
__device__ __forceinline__ void y_state_lds(const LAS unsigned char* o2, int sw7  , const LAS unsigned char* ml, int hi, f32x16& o0, f32x16& o1, float& m, float& l) {
#pragma unroll
    for (int rg = 0; rg < 4; ++rg) { const v2u w0 = *(const LAS v2u*)(o2 + 16 * (rg ^ sw7)), w1 = *(const LAS v2u*)(o2 + 16 * ((4 + rg) ^ sw7));
        o0[4 * rg] = __uint_as_float(w0.x << 16); o0[4 * rg + 1] = __uint_as_float(w0.x & 0xffff0000u); o0[4 * rg + 2] = __uint_as_float(w0.y << 16); o0[4 * rg + 3] = __uint_as_float(w0.y & 0xffff0000u);
        o1[4 * rg] = __uint_as_float(w1.x << 16); o1[4 * rg + 1] = __uint_as_float(w1.x & 0xffff0000u); o1[4 * rg + 2] = __uint_as_float(w1.y << 16); o1[4 * rg + 3] = __uint_as_float(w1.y & 0xffff0000u); }
    const v2u mlv = *(const LAS v2u*)ml; m = __uint_as_float(mlv.x); l = hi == 0 ? __uint_as_float(mlv.y) : 0.f;
}
__device__ __forceinline__ void ph_attn_xy(const Params& p, LAS unsigned char* lds, int G, int bid, int wv) {
    const int tid = otid(wv), lane = tid & 63, wave = __builtin_amdgcn_readfirstlane(tid >> 6);
    const int r32 = lane & 31, hi = lane >> 5;
    const bf16* Qb = (const bf16*)(p.ws + WS_Q); const bf16* KV = (const bf16*)(p.ws + WS_BIG); bf16* O = (bf16*)(p.ws + WS_O); bf16* O2 = (bf16*)((unsigned char*)p.out + 192 * MiB); float* ML = (float*)(p.ws + WS_GS);
    LAS unsigned char* vbuf = lds + wave * 8192;
    const int vcu = (bid & 7) * (G >> 3) + (bid >> 3);
    const int NW = G * 8, gw = vcu * 8 + wave;
    constexpr int NT = 16 * 16 * 16 * 2;
    v4u kc[4], vc[4];
    { const int bh = (gw >> 1) >> 4; tile_first(KV + ((size_t)((bh >> 4) * 48 + 32 + (bh & 15)) * 2 * 2048 + wave * 128) * 64, kc, vc, lane); }
    for (int T = gw, k = 0; T < NT; T += NW, ++k) {
        const int pr = T & 1, x = T >> 1, craw = x & 15, bh = x >> 4, c = (k & 1) ? 15 - craw : craw, h = bh & 15, b = bh >> 4;
        const int jq = c >> 2;
        const bf16* kb = KV + (size_t)(b * 48 + h) * 2 * 131072; const bf16* kb1 = kb + (size_t)16 * 2 * 131072; const bf16* kb2 = kb + (size_t)32 * 2 * 131072;
        const int j0 = (c == 0) ? 4 : 0, j1 = (4 - c) > 0 ? (4 - c) : 0;
        for (int xi = 0; xi < 2; ++xi) {
            const int r16 = wave + 8 * xi, qpos = r16 + 16 * (32 * jq + r32);
            const bf16* qrow = Qb + ((size_t)(b * 48 + 32 + h) * 2048 + r16 * 128 + 32 * jq + r32) * 64 + 8 * hi;
            s16x8 qf[4];
#pragma unroll
            for (int s = 0; s < 4; ++s) qf[s] = *(const s16x8*)(qrow + 16 * s);
            f32x16 o0, o1;
#pragma unroll
            for (int r = 0; r < 16; ++r) { o0[r] = 0.f; o1[r] = 0.f; }
            float m = -1.0e30f, lsum = 0.f;
            const bf16* nsrc = xi == 0 ? kb2 + (size_t)((wave + 8) * 128) * 64 : kb + (size_t)((c & 1) ? 128 * c : 128 * c - 128 + 32 * j0) * 64;
            attn_group<16>(qf, kb2, qpos, jq + 1, r16, jq + 1, 512, 0, 0, 0, o0, o1, m, lsum, vbuf, lane, kc, vc, nsrc);
            const float l = xsum32(lsum);
            LAS unsigned char* orow = lds + HO_O2 + (r16 * 32 + r32) * 128 + 8 * hi; const int sw7 = r32 & 7;
#pragma unroll
            for (int rg = 0; rg < 4; ++rg) {
                v2u w0; w0.x = cvtpk(o0[4 * rg], o0[4 * rg + 1]); w0.y = cvtpk(o0[4 * rg + 2], o0[4 * rg + 3]); *(LAS v2u*)(orow + 16 * (rg ^ sw7)) = w0;
                v2u w1; w1.x = cvtpk(o1[4 * rg], o1[4 * rg + 1]); w1.y = cvtpk(o1[4 * rg + 2], o1[4 * rg + 3]); *(LAS v2u*)(orow + 16 * ((4 + rg) ^ sw7)) = w1;
            }
            if (hi == 0) { v2u w; w.x = __float_as_uint(m); w.y = __float_as_uint(l); *(LAS v2u*)(lds + HO_ML + (r16 * 32 + r32) * 8) = w; }
        }
        asm volatile("s_waitcnt lgkmcnt(0)" ::: "memory"); __syncthreads();
        const bool hasn = T + NW < NT; const int bhn = hasn ? bh + (NW >> 5) : bh;
        const bf16* nsrc_task = KV + ((size_t)((bhn >> 4) * 48 + 32 + (bhn & 15)) * 2 * 2048 + wave * 128) * 64;
        const int qposA = 128 * c + 2 * pr + 4 * r32, qposB = qposA + 1; const size_t brow = (size_t)b * SEQ;
        const bf16* qrowA = Qb + ((size_t)(b * 48 + h) * 2048 + (2 * pr) * 512 + 32 * c + r32) * 64 + 8 * hi;
        s16x8 qa[4], qb[4], q1a[4], q1b[4];
#pragma unroll
        for (int s = 0; s < 4; ++s) { qa[s] = *(const s16x8*)(qrowA + 16 * s); qb[s] = *(const s16x8*)(qrowA + 512 * 64 + 16 * s); }
        f32x16 a0, a1, b0, b1; float ma, la, mb, lb;
        { const int rowA = (qposA & 15) * 32 + (qposA >> 4) - 32 * jq, rowB = (qposB & 15) * 32 + (qposB >> 4) - 32 * jq;
          y_state_lds(lds + HO_O2 + rowA * 128 + 8 * hi, rowA & 7, lds + HO_ML + rowA * 8, hi, a0, a1, ma, la);
          y_state_lds(lds + HO_O2 + rowB * 128 + 8 * hi, rowB & 7, lds + HO_ML + rowB * 8, hi, b0, b1, mb, lb); }
        asm volatile("s_waitcnt lgkmcnt(0)" ::: "memory"); __syncthreads();
        const int s1 = 32 * c - 128 + 32 * j1;
        attn_pair0(qa, qb, kb, qposA, 8 - j0, 128 * c - 128 + 32 * j0, 4 - j0, (c & 1) != 0, a0, a1, ma, la, b0, b1, mb, lb, vbuf, lane, kc, vc, kb1 + (size_t)((2 * pr) * 512 + s1) * 64);
#pragma unroll
        for (int s = 0; s < 4; ++s) { q1a[s] = *(const s16x8*)(qrowA + (size_t)16 * 131072 + 16 * s); q1b[s] = *(const s16x8*)(qrowA + (size_t)16 * 131072 + 512 * 64 + 16 * s); }
        attn_group<4>(q1a, kb1, qposA, 5 - j1, 2 * pr + 4 * s1, 8, 128, 0, j1 == 0 ? 1 : 0, 4 - j1, a0, a1, ma, la, vbuf, lane, kc, vc, kb1 + (size_t)((2 * pr + 1) * 512 + s1) * 64);
        y_store(O + (brow + qposA) * D + h * 64, hi, a0, a1, la);
        attn_group<4>(q1b, kb1, qposB, 5 - j1, 2 * pr + 1 + 4 * s1, 8, 128, 0, j1 == 0 ? 1 : 0, 4 - j1, b0, b1, mb, lb, vbuf, lane, kc, vc, nsrc_task);
        y_store(O + (brow + qposB) * D + h * 64, hi, b0, b1, lb);
    }
}

__device__ __forceinline__ unsigned off_a(unsigned row, unsigned ch) { return 2048u * (row >> 3) + 512u * (ch >> 2) + 64u * (row & 7) + 16u * ((ch & 3) ^ ((row >> 2) & 3)); }
constexpr int RT_BUF = 49152, RT_Q = 0, RT_K = 16384, RT_V = 32768, RT_P0 = 98304, RT_P0SZ = 2048;

__device__ __forceinline__ void ret_stage(LAS unsigned char* lds, int buf, const bf16* rowbase  , const bf16* p0src  , int h, int dvh, int wave, int lane) {
    (void)p0src;
#pragma unroll
    for (int i = 0; i < 6; ++i) {
        const int idx = wave + 8 * i, img = idx >> 4, t = (idx >> 3) & 1, k = idx & 7;
        const int row = 8 * (k >> 1) + ((lane >> 2) & 7), chh = 2 * (k & 1) + (lane >> 5), ch = 4 * chh + ((lane & 3) ^ ((row >> 2) & 3));
        const int plane = img == 0 ? h : (img == 1 ? 4 + h : 8 + 2 * h + dvh);
        const bf16* src = rowbase + ((size_t)plane * 2048 + row) * 256 + 128 * t + 8 * ch;
        __builtin_amdgcn_global_load_lds((const unsigned*)src, (LAS unsigned*)(lds + buf * RT_BUF + img * 16384 + t * 8192 + k * 1024), 16, 0, 0);
    }
}
__device__ __forceinline__ void ph_ret_p0(const Params& p, int G, int bid, int wv) {
    const int tid = otid(wv), lane = tid & 63, wave = tid >> 6, r32 = lane & 31, hi = lane >> 5;
    const bf16* QKV = (const bf16*)(p.ws + WS_BIG); bf16* P0 = (bf16*)(p.ws + WS_P0);
    for (int t = bid * 8 + wave; t < NBATCH * 4 * 64; t += G * 8) {
        const int c = t & 63, h = (t >> 6) & 3, b = t >> 8;
        const bf16* qr = QKV + ((size_t)(b * 16 + h) * 2048 + c * 32 + r32) * 256 + 8 * hi;
        const bf16* kr = qr + (size_t)4 * 2048 * 256;
        f32x16 S;
#pragma unroll
        for (int r = 0; r < 16; ++r) S[r] = 0.f;
#pragma unroll
        for (int s = 0; s < 16; ++s) { const s16x8 a = *(const s16x8*)(kr + 16 * s), bq = *(const s16x8*)(qr + 16 * s); S = __builtin_amdgcn_mfma_f32_32x32x16_bf16(a, bq, S, 0, 0, 0); }
        bf16* dst = P0 + (size_t)t * 1024 + r32 * 32;
#pragma unroll
        for (int rg = 0; rg < 4; ++rg) { float v[4];
#pragma unroll
            for (int e = 0; e < 4; ++e) { const int key = e + 8 * rg + 4 * hi; v[e] = key <= r32 ? S[4 * rg + e] : 0.f; }
            v2u w; w.x = cvtpk(v[0], v[1]); w.y = cvtpk(v[2], v[3]);
            *(v2u*)(dst + 8 * rg + 4 * hi) = w; }
    }
}
__device__ __forceinline__ void ph_retention(const Params& p, LAS unsigned char* lds, int G, int bid, int wv) {
    const int tid = otid(wv), lane = tid & 63, wave = __builtin_amdgcn_readfirstlane(tid >> 6), r32 = lane & 31, hi = lane >> 5;
    const bf16* QKV = (const bf16*)(p.ws + WS_BIG); bf16* Y = (bf16*)p.out;
    const unsigned blk = (lane >> 4) & 1, q4 = (lane & 15) >> 2, pp = lane & 3;
    const unsigned xq = (r32 >> 2) & 3, lq = 2048u * (r32 >> 3) + 64u * (r32 & 7) + 8u * hi;
    const unsigned ltr = 2048u * hi + 64u * q4 + 8u * (pp & 1), ctr = 2u * blk + (pp >> 1);
    for (int ub = bid; ub < NBATCH * 8; ub += G) {
        const int unit = 16 * (ub >> 4) + 2 * (ub & 7) + ((ub >> 3) & 1);
        const int dvh = unit & 1, h = (unit >> 1) & 3, b = unit >> 3;
        const float lg = log2f(1.0f - exp2f(-5.0f - (float)h));
        const bf16* base = QKV + (size_t)b * 16 * 2048 * 256;
        bf16* ybase = Y + (size_t)b * SEQ * 2048 + h * 512 + dvh * 256 + wave * 32 + r32;
        f32x16 St[8];
#pragma unroll
        for (int kt = 0; kt < 8; ++kt)
#pragma unroll
            for (int r = 0; r < 16; ++r) St[kt][r] = 0.f;
        __syncthreads();
        const bf16* p0b = (const bf16*)(p.ws + WS_P0) + (size_t)((b * 4 + h) * 64) * 1024;
        ret_stage(lds, 0, base, p0b, h, dvh, wave, lane);
        asm volatile("s_waitcnt vmcnt(0) lgkmcnt(0)" ::: "memory");
        __syncthreads();
        for (int c = 0; c < SEQ / 32; ++c) {
            const int buf = c & 1;
            if (c + 1 < SEQ / 32) {
                ret_stage(lds, buf ^ 1, base + (size_t)(c + 1) * 32 * 256, p0b + (size_t)(c + 1) * 1024, h, dvh, wave, lane);
            }
            float lgc = lg; asm volatile("" : "+v"(lgc));
            LAS unsigned char* Lb = lds + buf * RT_BUF;
            LAS unsigned char* Lp = lds + RT_P0 + buf * RT_P0SZ + r32 * 64 + 16 * hi;
            LAS unsigned char* q0 = Lb + RT_Q + lq + 16u * (0u ^ xq); LAS unsigned char* q1 = Lb + RT_Q + lq + 16u * (1u ^ xq);
            LAS unsigned char* q2 = Lb + RT_Q + lq + 16u * (2u ^ xq); LAS unsigned char* q3 = Lb + RT_Q + lq + 16u * (3u ^ xq);
            LAS unsigned char* k0 = Lb + RT_K + ltr + 16u * (ctr ^ (2u * hi)); LAS unsigned char* k1 = Lb + RT_K + ltr + 16u * (ctr ^ (2u * hi + 1u));
            LAS unsigned char* v0 = Lb + RT_V + (wave >> 2) * 8192 + (wave & 3) * 512 + ltr + 16u * (ctr ^ (2u * hi)); LAS unsigned char* v1 = Lb + RT_V + (wave >> 2) * 8192 + (wave & 3) * 512 + ltr + 16u * (ctr ^ (2u * hi + 1u));
            s16x8 vf[2];
#pragma unroll
            for (int ks = 0; ks < 2; ++ks) {
                const s16x4 lo = __builtin_amdgcn_ds_read_tr16_b64_v4i16((LAS s16x4*)(v0 + 4096 * ks));
                const s16x4 h4 = __builtin_amdgcn_ds_read_tr16_b64_v4i16((LAS s16x4*)(v1 + 4096 * ks + 256));
                const float w0 = __builtin_amdgcn_exp2f(-(float)(32 * c + 16 * ks + 8 * hi + 1) * lgc), gi = __builtin_amdgcn_exp2f(-lgc);
                float f[8], w = w0;
#pragma unroll
                for (int e = 0; e < 4; ++e) { f[e] = bf2f((unsigned short)lo[e]); f[4 + e] = bf2f((unsigned short)h4[e]); }
#pragma unroll
                for (int j = 0; j < 8; ++j) { f[j] *= w; w *= gi; }
                v4u ww; ww.x = cvtpk(f[0], f[1]); ww.y = cvtpk(f[2], f[3]); ww.z = cvtpk(f[4], f[5]); ww.w = cvtpk(f[6], f[7]); vf[ks] = __builtin_bit_cast(s16x8, ww);
            }
            f32x16 T;
#pragma unroll
            for (int r = 0; r < 16; ++r) T[r] = 0.f;
            if (wave == (c & 7)) {
                constexpr int KQ = RT_K - RT_Q;
#pragma unroll
                for (int kt = 0; kt < 8; ++kt) { const int toff = (kt >> 2) * 8192 + (kt & 3) * 512;
#pragma unroll
                    for (int s = 0; s < 2; ++s) {
                        const v2u qa = *(LAS v2u*)((s ? q2 : q0) + toff), qb = *(LAS v2u*)((s ? q3 : q1) + toff), ka2 = *(LAS v2u*)((s ? q2 : q0) + KQ + toff), kb2 = *(LAS v2u*)((s ? q3 : q1) + KQ + toff);
                        v4u aw; aw.x = ka2.x; aw.y = ka2.y; aw.z = kb2.x; aw.w = kb2.y;
                        v4u bw; bw.x = qa.x; bw.y = qa.y; bw.z = qb.x; bw.w = qb.y;
                        T = __builtin_amdgcn_mfma_f32_32x32x16_bf16(__builtin_bit_cast(s16x8, aw), __builtin_bit_cast(s16x8, bw), T, 0, 0, 0); } }
                LAS unsigned char* Pw = lds + RT_P0 + buf * RT_P0SZ + r32 * 64;
#pragma unroll
                for (int rg = 0; rg < 4; ++rg) { float v[4];
#pragma unroll
                    for (int e = 0; e < 4; ++e) { const int key = e + 8 * rg + 4 * hi; v[e] = key <= r32 ? T[4 * rg + e] : 0.f; }
                    v2u w; w.x = cvtpk(v[0], v[1]); w.y = cvtpk(v[2], v[3]);
                    *(LAS v2u*)(Pw + (8 * rg + 4 * hi) * 2) = w; }
#pragma unroll
                for (int r = 0; r < 16; ++r) T[r] = 0.f;
            }
#pragma unroll
            for (int kt = 0; kt < 8; ++kt) {
                constexpr int dummy = 0; (void)dummy;
                const int toff = (kt >> 2) * 8192 + (kt & 3) * 512;
#pragma unroll
                for (int s = 0; s < 2; ++s) {
                    const v2u qa = *(LAS v2u*)((s ? q2 : q0) + toff), qb = *(LAS v2u*)((s ? q3 : q1) + toff);
                    v4u aw; aw.x = qa.x; aw.y = qa.y; aw.z = qb.x; aw.w = qb.y;
                    v4u bw; bw.x = cvtpk(St[kt][8 * s + 0], St[kt][8 * s + 1]); bw.y = cvtpk(St[kt][8 * s + 2], St[kt][8 * s + 3]); bw.z = cvtpk(St[kt][8 * s + 4], St[kt][8 * s + 5]); bw.w = cvtpk(St[kt][8 * s + 6], St[kt][8 * s + 7]);
                    T = __builtin_amdgcn_mfma_f32_32x32x16_bf16(__builtin_bit_cast(s16x8, aw), __builtin_bit_cast(s16x8, bw), T, 0, 0, 0);
                }
#pragma unroll
                for (int ks = 0; ks < 2; ++ks) {
                    const s16x4 lo = __builtin_amdgcn_ds_read_tr16_b64_v4i16((LAS s16x4*)(k0 + toff + 4096 * ks));
                    const s16x4 h4 = __builtin_amdgcn_ds_read_tr16_b64_v4i16((LAS s16x4*)(k1 + toff + 4096 * ks + 256));
                    const s16x8 ka = (s16x8){lo[0], lo[1], lo[2], lo[3], h4[0], h4[1], h4[2], h4[3]};
                    St[kt] = __builtin_amdgcn_mfma_f32_32x32x16_bf16(ka, vf[ks], St[kt], 0, 0, 0);
                }
            }
            asm volatile("s_waitcnt lgkmcnt(0)" ::: "memory"); __builtin_amdgcn_s_barrier(); asm volatile("" ::: "memory");
#pragma unroll
            for (int ks = 0; ks < 2; ++ks) { const s16x8 a = *(LAS s16x8*)(Lp + 32 * ks); T = __builtin_amdgcn_mfma_f32_32x32x16_bf16(a, vf[ks], T, 0, 0, 0); }
            bf16* yrow = ybase + (size_t)(c * 32) * 2048;
            const float g1 = __builtin_amdgcn_exp2f(lgc); float wq = __builtin_amdgcn_exp2f((float)(32 * c + 4 * hi + 1) * lgc);
#pragma unroll
            for (int rg = 0; rg < 4; ++rg) { float wr_ = wq;
#pragma unroll
                for (int e = 0; e < 4; ++e) { const int q = e + 8 * rg + 4 * hi; yrow[(size_t)q * 2048] = (bf16)f2bf(T[4 * rg + e] * wr_); wr_ *= g1; }
                wq *= __builtin_amdgcn_exp2f(8.0f * lgc); }
            asm volatile("s_waitcnt vmcnt(16) lgkmcnt(0)" ::: "memory");
            __builtin_amdgcn_s_barrier(); asm volatile("" ::: "memory");
        }
        asm volatile("s_waitcnt vmcnt(0)" ::: "memory");
    }
}

constexpr int LDS_BYTES = 147456, LDSCTL_OFF = 131072, MISC_OFF = LDSCTL_OFF + 320, HALO_LDS = LDSCTL_OFF + 1024;
constexpr int CW_BAR = 4096;
__device__ __forceinline__ int opq(int v) { asm volatile("" : "+s"(v)); return v; }
__global__ void __launch_bounds__(512, 2) yoco_fwd(Params p) {
    extern __shared__ __attribute__((aligned(16))) unsigned char lds_raw[];
    LAS unsigned char* lds = (LAS unsigned char*)lds_raw;
    constexpr int G = 256; const int bid = blockIdx.x;
    const int wv = __builtin_amdgcn_readfirstlane((int)threadIdx.x >> 6);
    for (int u = otid(wv); u < 1024 / 4; u += 512) ((LAS unsigned*)(lds + LDSCTL_OFF))[u] = 0u;
    __syncthreads();
    XcdBarrier bar = xcd_barrier_post((unsigned*)(p.ws + WS_CTL) + CW_BAR, (volatile LAS unsigned*)(lds + MISC_OFF) + 8, wv);
#define GRID_BAR() do { XcdBarrier b_ = bar; asm volatile("" : "+s"(b_.x)); asm volatile("" : "+s"(b_.bar)); xcd_barrier(b_); } while (0)
    bf16* WB = (bf16*)(p.ws + WS_W);
    ph_wmax(p, lds, G, opq(bid), wv); GRID_BAR();
    ph_prologue(p, lds, G, opq(bid), wv); GRID_BAR();
    for (int seg = 0; seg < 3; ++seg) {
        const int row0 = seg == 2 ? MC : 0, nrows = seg == 0 ? M_ALL : MC;
        const bf16* XBs = (const bf16*)(p.ws + WS_XB) + (size_t)row0 * D; const float* RSs = (const float*)(p.ws + WS_RS) + row0;
        bf16* MBs = (bf16*)(p.ws + (seg == 0 ? WS_MBF : WS_MB)); bf16* HAs = (bf16*)(p.ws + (seg == 0 ? WS_BIG : WS_Q));
        unsigned char* A8G = (unsigned char*)p.out + 128 * MiB + (size_t)row0 * D;
        unsigned char* A8s = seg == 0 ? p.ws + WS_MB : A8G;
        const float* SAs = (const float*)(p.ws + WS_SA) + row0; const float* WSCp = (const float*)(p.ws + WS_WSC);
        if (seg > 0) { pg8::EpiAttRot8 E{(bf16*)(p.ws + WS_BIG), SAs, WSCp + WSC_KV, (const float*)(p.ws + WS_ACOS), (const float*)(p.ws + WS_ASIN), KVW, 12}; gemm_call<pg8::EpiAttRot8, 2>(lds, (const bf16*)A8G, WB + W_KV, MC, KVW, D, E, G, opq(bid), wv); }
        for (int li = 0; li < 2; ++li) {
            const int layer = (seg == 0 ? 0 : 2) + li;
            if (seg == 0) {
                { pg8::EpiRetIn E{(bf16*)(p.ws + WS_BIG), RSs, (const float*)(p.ws + WS_RCOS), (const float*)(p.ws + WS_RSIN), RQP, 0}; gemm_call(lds, XBs, WB + W_RETIN + (size_t)layer * RET_IN * D, M_ALL, RQP, D, E, G, opq(bid), wv); } GRID_BAR();
                ph_retention(p, lds, G, opq(bid), wv); GRID_BAR();
                { pg8::EpiGate8 E{(bf16*)p.out, SAs, WSCp + WSC_RET + layer * RET_IN + RQP, (LAS float*)(lds + HALO_LDS), p.ret_gn + layer * 2048}; gemm_call_pair<pg8::EpiGate8, 2>(lds, (const bf16*)A8s, WB + W_RETIN + (size_t)layer * RET_IN * D + (size_t)RQP * D, M_ALL, 2048, D, E, G, opq(bid), wv); } GRID_BAR();
                { pg8::EpiRS E{MBs, D, 0}; gemm_call(lds, (const bf16*)p.out, WB + W_RETOUT + (size_t)layer * D * 2048, M_ALL, D, 2048, E, G, opq(bid), wv); } GRID_BAR();
            } else {
                { pg8::EpiAttRot8 E{(bf16*)(p.ws + WS_Q), SAs, WSCp + WSC_Q + (layer - 2) * QW, (const float*)(p.ws + WS_ACOS), (const float*)(p.ws + WS_ASIN), QW, 12}; gemm_call<pg8::EpiAttRot8, 2>(lds, (const bf16*)A8G, (const bf16*)((const unsigned char*)(WB + W_Q) + (size_t)(layer - 2) * QW * D), MC, QW, D, E, G, opq(bid), wv); } GRID_BAR();
                ph_attn_xy(p, lds, G, opq(bid), wv); GRID_BAR();
                { pg8::EpiRS E{MBs, D, 0}; gemm_call(lds, (const bf16*)(p.ws + WS_O), WB + W_O + (size_t)(layer - 2) * D * D, MC, D, D, E, G, opq(bid), wv); } GRID_BAR();
            }
            ph_thin(p, row0, nrows, MBs, p.n_mix_post + layer * D, nullptr, A8s, true, G, opq(bid), wv); GRID_BAR();
            { pg8::EpiUpConv E{HAs, (const float*)(p.ws + WS_SA) + row0, (const float*)(p.ws + WS_WSC) + layer * 2 * FF, p.conv_w + (size_t)layer * 3 * FF, p.conv_b + (size_t)layer * FF, (float*)(p.ws + WS_HALO), (LAS float*)(lds + HALO_LDS)}; gemm_call<pg8::EpiUpConv, 2>(lds, (const bf16*)A8s, (const bf16*)((const unsigned char*)(WB + W_UP) + (size_t)layer * 2 * FF * D), nrows, 2 * FF, D, E, G, opq(bid), wv); } GRID_BAR();
            conv_fix_local(p, layer, HAs, nrows, G, opq(bid), wv);
            { pg8::EpiRS E{MBs, D, 0}; gemm_call(lds, HAs, WB + W_DOWN + (size_t)layer * D * FF, nrows, D, FF, E, G, opq(bid), wv); } GRID_BAR();
            ph_thin(p, row0, nrows, MBs, p.n_ffn_post + layer * D, layer == 3 ? p.out + (size_t)row0 * D : nullptr, layer == 0 ? A8s : (layer < 3 ? A8G : nullptr), false, G, opq(bid), wv); GRID_BAR();
        }
    }
}

extern "C" void kernel_launch(void* const* d_in, const int* in_sizes, int n_in, void* d_out, int out_size, void* d_ws, size_t ws_size, hipStream_t stream) {
    static int grid = 0;
    if (grid == 0) {
        if (n_in != 16 || in_sizes[0] != M_ALL * D || out_size != M_ALL * D || ws_size < WS_END) {
            fprintf(stderr, "kernel_launch: unexpected shapes: n_in %d in0 %d out %d ws %zu (need %zu)\n", n_in, n_in > 0 ? in_sizes[0] : -1, out_size, ws_size, (size_t)WS_END); grid = -1; return; }
        int dev = 0, cus = 0, per_cu = 0;
        if (hipGetDevice(&dev) != hipSuccess || hipDeviceGetAttribute(&cus, hipDeviceAttributeMultiprocessorCount, dev) != hipSuccess) { grid = -1; return; }
        if (hipFuncSetAttribute((const void*)yoco_fwd, hipFuncAttributeMaxDynamicSharedMemorySize, LDS_BYTES) != hipSuccess) { fprintf(stderr, "kernel_launch: hipFuncSetAttribute failed\n"); grid = -1; return; }
        if (hipOccupancyMaxActiveBlocksPerMultiprocessor(&per_cu, (const void*)yoco_fwd, 512, LDS_BYTES) != hipSuccess || per_cu < 1) { fprintf(stderr, "kernel_launch: occupancy query says %d blocks per CU\n", per_cu); (void)hipGetLastError(); grid = -1; return; }
        if (cus != 256) { fprintf(stderr, "kernel_launch: built for a 256-CU device, found %d CUs\n", cus); grid = -1; return; }
        grid = cus;
    }
    if (grid < 0) return;
    Params p{};
    p.x = (const float*)d_in[0]; p.ret_w_in = (const float*)d_in[1]; p.ret_w_out = (const float*)d_in[2]; p.ret_gn = (const float*)d_in[3]; p.kv_norm = (const float*)d_in[4];
    p.w_kv = (const float*)d_in[5]; p.w_q = (const float*)d_in[6]; p.w_o = (const float*)d_in[7]; p.n_mix_pre = (const float*)d_in[8]; p.n_mix_post = (const float*)d_in[9];
    p.n_ffn_pre = (const float*)d_in[10]; p.n_ffn_post = (const float*)d_in[11]; p.w_up = (const float*)d_in[12]; p.conv_w = (const float*)d_in[13]; p.conv_b = (const float*)d_in[14]; p.w_down = (const float*)d_in[15];
    p.out = (float*)d_out; p.ws = (unsigned char*)d_ws;
    (void)hipMemsetAsync((char*)d_ws + WS_CTL, 0, 65536, stream);
    hipLaunchKernelGGL(yoco_fwd, dim3(grid), dim3(512), LDS_BYTES, stream, p);
}
```

```cpp
#include <hip/hip_runtime.h>
#include <cstdio>
#include <cstdint>
__device__ __forceinline__ int otid(int wv) { int l; asm volatile("v_mbcnt_lo_u32_b32 %0, -1, 0\n\tv_mbcnt_hi_u32_b32 %0, -1, %0" : "=v"(l)); return (wv << 6) | l; }
namespace pg8 {
#define PG8_LAS __attribute__((address_space(3)))
typedef unsigned short bf16_t;
typedef short bf16x8 __attribute__((ext_vector_type(8)));
typedef float f32x4 __attribute__((ext_vector_type(4)));
typedef unsigned u32x4 __attribute__((ext_vector_type(4)));
constexpr int BM = 256, BK = 64, HALF = 128, HTB = HALF * BK * 2  , STAGE_BYTES = 8 * HTB, NXCD = 8, WGM = 8;

__host__ __device__ __forceinline__ int lds_byte(int r, int c) { const int st = (r >> 4) * 2 + (c >> 5), rr = r & 15, cc = c & 31, ob = rr * 64 + cc * 2; return st * 1024 + (ob ^ (((ob >> 9) & 1) << 5)); }
__host__ __device__ __forceinline__ void stage_rc(int b, int& R, int& C) { const int st = b / 1024, sb = b % 1024, swz = sb ^ (((sb >> 9) & 1) << 5); R = (st >> 1) * 16 + swz / 64; C = (st & 1) * 32 + (swz % 64) / 2; }
__host__ __device__ __forceinline__ int perm32(int rho) { const int n = rho >> 4, i = rho & 15; return 8 * (i >> 2) + 4 * n + (i & 3); }

struct Unit { int pm, pn; };
struct Gemm { const bf16_t* A; const bf16_t* Bt; int M, N, K; };

struct StaticOrder {
    int nM, nN, nwg, G, c;
    __host__ __device__ void init(int M, int N, int G_, int c_) { nM = M / BM; nN = N / BM; nwg = nM * nN; G = G_; c = c_; }
    __host__ __device__ bool next(int i, Unit& u) const {
        const long L = (long)i * G + c; if (L >= nwg) return false;
        int wgid = (int)L; { const int q = nwg / NXCD, r = nwg % NXCD, xcd = wgid % NXCD, off = wgid / NXCD; wgid = (xcd < r ? xcd * (q + 1) : r * (q + 1) + (xcd - r) * q) + off; }
        const int nig = WGM * nN, gid = wgid / nig, fm = gid * WGM, gsz = (nM - fm) < WGM ? (nM - fm) : WGM;
        u.pm = fm + ((wgid % nig) % gsz); u.pn = (wgid % nig) / gsz; return true;
    }
    __device__ __forceinline__ void a_ready(const Unit&) const {}
    __device__ __forceinline__ void done(const Unit&) const {}
};
typedef float cvt_f32x2 __attribute__((ext_vector_type(2))); typedef __bf16 cvt_bf16x2 __attribute__((ext_vector_type(2)));
__device__ __forceinline__ unsigned cvt_pk_bf16(float lo, float hi) { const cvt_f32x2 v = {lo, hi}; return __builtin_bit_cast(unsigned, __builtin_convertvector(v, cvt_bf16x2)); }
typedef int i32x4 __attribute__((ext_vector_type(4)));
typedef int i32x8 __attribute__((ext_vector_type(8)));
__device__ __forceinline__ i32x8 cat8(bf16x8 a, bf16x8 b) { const i32x4 x = __builtin_bit_cast(i32x4, a), y = __builtin_bit_cast(i32x4, b); return __builtin_shufflevector(x, y, 0, 1, 2, 3, 4, 5, 6, 7); }
template <class Epi, class Sched, bool ALIGN_EPI = false, bool SP2 = false, int QM = 0>
__device__ __forceinline__ void gemm_phase(PG8_LAS unsigned char* lds, const Gemm g, const Sched& S, const Epi& E, int wv) {
    const int tid = otid(wv), wid = __builtin_amdgcn_readfirstlane(tid >> 6), lane = tid & 63, wr = wid >> 2, wc = wid & 3, fr = lane & 15, fq = lane >> 4;
    constexpr bool F8 = (QM == 1), I8 = (QM == 2); const int K = g.K, KB = (QM != 0) ? K : 2 * K  , nt = KB / (BK * 2);
    unsigned voffA[2], voffB[2];
#pragma unroll
    for (int i = 0; i < 2; ++i) { int R, C; stage_rc(tid * 16 + i * 8192, R, C); const int Rb = Epi::PERM ? ((R & ~31) + perm32(R & 31)) : R;
        voffA[i] = (unsigned)(R * KB + C * 2); voffB[i] = (unsigned)(Rb * KB + C * 2); }
    const size_t kstep = (size_t)(BK * 2);
    const size_t hstep = (size_t)HALF * KB;
    const size_t tstep = 2 * hstep;
    const unsigned ldsw = (unsigned)wid * 1024u;
    const int aoff = lds_byte(wr * 64 + fr, fq * 8), boff = lds_byte(wc * 32 + fr, fq * 8);
#define PG8_SA(b, h) (((b) * 2 + (h)) * HTB)
#define PG8_SB(b, h) ((4 + (b) * 2 + (h)) * HTB)
#define PG8_STAGE(bufoff, gbase, voff) do { const char* _gb = (const char*)(gbase); asm volatile("" : "+s"(_gb));   \
        _Pragma("unroll") for (int _i = 0; _i < 2; ++_i) \
        __builtin_amdgcn_global_load_lds((const unsigned*)(_gb + (voff)[_i]), (PG8_LAS unsigned*)(lds + (bufoff) + ldsw + _i * 8192), 16, 0, 0); } while (0)
#define PG8_LDA(dst, b, h) do { _Pragma("unroll") for (int m = 0; m < 4; ++m) _Pragma("unroll") for (int k = 0; k < 2; ++k) dst[m][k] = *(const PG8_LAS bf16x8*)(lds + PG8_SA(b, h) + aoff + m * 2048 + k * 1024); } while (0)
#define PG8_LDB(dst, b, h) do { _Pragma("unroll") for (int n = 0; n < 2; ++n) _Pragma("unroll") for (int k = 0; k < 2; ++k) dst[n][k] = *(const PG8_LAS bf16x8*)(lds + PG8_SB(b, h) + boff + n * 2048 + k * 1024); } while (0)
#define PG8_MMA(ai, bj, At, Bt) do { __builtin_amdgcn_s_setprio(1); _Pragma("unroll") for (int m = 0; m < 4; ++m) _Pragma("unroll") for (int n = 0; n < 2; ++n) { \
        if constexpr (F8) acc[ai][bj][m][n] = __builtin_amdgcn_mfma_scale_f32_16x16x128_f8f6f4(cat8(Bt[n][0], Bt[n][1]), cat8(At[m][0], At[m][1]), acc[ai][bj][m][n], 0, 0, 0, 0, 0, 0); \
        else if constexpr (I8) { _Pragma("unroll") for (int k = 0; k < 2; ++k) acc[ai][bj][m][n] = __builtin_bit_cast(f32x4, __builtin_amdgcn_mfma_i32_16x16x64_i8(__builtin_bit_cast(i32x4, Bt[n][k]), __builtin_bit_cast(i32x4, At[m][k]), __builtin_bit_cast(i32x4, acc[ai][bj][m][n]), 0, 0, 0)); } \
        else { _Pragma("unroll") for (int k = 0; k < 2; ++k) acc[ai][bj][m][n] = __builtin_amdgcn_mfma_f32_16x16x32_bf16(Bt[n][k], At[m][k], acc[ai][bj][m][n], 0, 0, 0); } } \
        __builtin_amdgcn_s_setprio(0); } while (0)
#define PG8_WAIT_V(n) asm volatile("s_waitcnt vmcnt(" #n ")" ::: "memory")
#define PG8_WAIT_L(n) asm volatile("s_waitcnt lgkmcnt(" #n ")" ::: "memory")
#define PG8_BAR __builtin_amdgcn_s_barrier()
#define PG8_SCHED __builtin_amdgcn_sched_barrier(0)
    Unit cur, nxt; int ui = 0;
    if (!S.next(0, cur)) return;
    const char* cA = (const char*)g.A + (size_t)cur.pm * tstep; const char* cB = (const char*)g.Bt + (size_t)cur.pn * tstep;
    S.a_ready(cur);
    if constexpr (SP2) {
        PG8_STAGE(PG8_SB(0, 0), cB, voffB); PG8_STAGE(PG8_SB(0, 1), cB + hstep, voffB); PG8_STAGE(PG8_SA(0, 0), cA, voffA); PG8_STAGE(PG8_SA(0, 1), cA + hstep, voffA);
        if (wr == 1) PG8_BAR;
        PG8_WAIT_V(2); PG8_BAR;
        PG8_STAGE(PG8_SB(1, 0), cB + kstep, voffB); PG8_STAGE(PG8_SA(1, 0), cA + kstep, voffA); PG8_STAGE(PG8_SB(1, 1), cB + hstep + kstep, voffB);
        PG8_WAIT_V(6); PG8_BAR;
    } else {
        PG8_STAGE(PG8_SB(0, 0), cB, voffB); PG8_STAGE(PG8_SA(0, 0), cA, voffA); PG8_STAGE(PG8_SB(0, 1), cB + hstep, voffB); PG8_STAGE(PG8_SA(0, 1), cA + hstep, voffA);
        if (wr == 1) PG8_BAR;
        PG8_WAIT_V(4); PG8_BAR;
        PG8_STAGE(PG8_SB(1, 0), cB + kstep, voffB); PG8_STAGE(PG8_SA(1, 0), cA + kstep, voffA); PG8_STAGE(PG8_SB(1, 1), cB + hstep + kstep, voffB);
        PG8_WAIT_V(6); PG8_BAR;
    }
    if constexpr (F8) {
        const int tid2 = otid(wv);
#pragma unroll
        for (int i = 0; i < 2; ++i) { int R, C; stage_rc(tid2 * 16 + i * 8192, R, C); const int Rb = Epi::PERM ? ((R & ~31) + perm32(R & 31)) : R;
            voffA[i] = (unsigned)(R * KB + C * 2); voffB[i] = (unsigned)(Rb * KB + C * 2); }
    }
    f32x4 acc[2][2][4][2];
#pragma unroll
    for (int a = 0; a < 2; ++a)
#pragma unroll
        for (int b = 0; b < 2; ++b)
#pragma unroll
            for (int m = 0; m < 4; ++m)
#pragma unroll
                for (int n = 0; n < 2; ++n) acc[a][b][m][n] = (f32x4){0.f, 0.f, 0.f, 0.f};
    bf16x8 At[4][2], B0[2][2], B1[2][2];
    for (;;) {
        const bool has_next = S.next(ui + 1, nxt);
        const char* nA = has_next ? (const char*)g.A + (size_t)nxt.pm * tstep : cA; const char* nB = has_next ? (const char*)g.Bt + (size_t)nxt.pn * tstep : cB;
        for (int t = 0; t < nt; t += 2) {
            const bool last = (t == nt - 2);
            const char* a1 = cA + (size_t)(t + 1) * kstep;
            const char* a2 = last ? nA : cA + (size_t)(t + 2) * kstep; const char* b2 = last ? nB : cB + (size_t)(t + 2) * kstep;
            const char* a3 = a2 + kstep; const char* b3 = b2 + kstep;
            if (last && has_next) S.a_ready(nxt);
            if constexpr (SP2) {
            PG8_LDB(B0, 0, 0); PG8_LDB(B1, 0, 1); PG8_SCHED; PG8_LDA(At, 0, 0); PG8_STAGE(PG8_SA(1, 1), a1 + hstep, voffA);
            PG8_WAIT_V(8); PG8_WAIT_L(0); PG8_BAR; PG8_MMA(0, 0, At, B0); PG8_MMA(0, 1, At, B1); PG8_BAR; PG8_SCHED;
            PG8_LDA(At, 0, 1); PG8_STAGE(PG8_SB(0, 0), b2, voffB); PG8_STAGE(PG8_SB(0, 1), b2 + hstep, voffB); PG8_STAGE(PG8_SA(0, 0), a2, voffA);
            PG8_WAIT_V(8); PG8_WAIT_L(0); PG8_BAR; PG8_MMA(1, 0, At, B0); PG8_MMA(1, 1, At, B1); PG8_BAR; PG8_SCHED;
            PG8_LDB(B0, 1, 0); PG8_LDB(B1, 1, 1); PG8_SCHED; PG8_LDA(At, 1, 0); PG8_STAGE(PG8_SA(0, 1), a2 + hstep, voffA);
            PG8_WAIT_V(8); PG8_WAIT_L(0); PG8_BAR; PG8_MMA(0, 0, At, B0); PG8_MMA(0, 1, At, B1); PG8_BAR; PG8_SCHED;
            PG8_LDA(At, 1, 1); PG8_STAGE(PG8_SB(1, 0), b3, voffB); PG8_STAGE(PG8_SB(1, 1), b3 + hstep, voffB); PG8_STAGE(PG8_SA(1, 0), a3, voffA);
            PG8_WAIT_V(8); PG8_WAIT_L(0); PG8_BAR; PG8_MMA(1, 0, At, B0); PG8_MMA(1, 1, At, B1); PG8_BAR; PG8_SCHED;
            } else {
            PG8_LDB(B0, 0, 0); PG8_SCHED; PG8_LDA(At, 0, 0); PG8_STAGE(PG8_SA(1, 1), a1 + hstep, voffA);
            PG8_WAIT_L(8); PG8_BAR; PG8_WAIT_L(0); PG8_MMA(0, 0, At, B0); PG8_BAR; PG8_SCHED;
            PG8_LDB(B1, 0, 1); PG8_STAGE(PG8_SB(0, 0), b2, voffB);
            PG8_BAR; PG8_WAIT_L(0); PG8_MMA(0, 1, At, B1); PG8_BAR;
            PG8_LDA(At, 0, 1); PG8_STAGE(PG8_SA(0, 0), a2, voffA);
            PG8_BAR; PG8_WAIT_L(0); PG8_MMA(1, 0, At, B0); PG8_BAR; PG8_SCHED;
            PG8_STAGE(PG8_SB(0, 1), b2 + hstep, voffB);
            PG8_WAIT_V(6); PG8_BAR; PG8_MMA(1, 1, At, B1); PG8_BAR;
            PG8_LDB(B0, 1, 0); PG8_SCHED; PG8_LDA(At, 1, 0); PG8_STAGE(PG8_SA(0, 1), a2 + hstep, voffA);
            PG8_WAIT_L(8); PG8_BAR; PG8_WAIT_L(0); PG8_MMA(0, 0, At, B0); PG8_BAR; PG8_SCHED;
            PG8_LDB(B1, 1, 1); PG8_STAGE(PG8_SB(1, 0), b3, voffB);
            PG8_BAR; PG8_WAIT_L(0); PG8_MMA(0, 1, At, B1); PG8_BAR;
            PG8_LDA(At, 1, 1); PG8_STAGE(PG8_SA(1, 0), a3, voffA);
            PG8_BAR; PG8_WAIT_L(0); PG8_MMA(1, 0, At, B0); PG8_BAR; PG8_SCHED;
            PG8_STAGE(PG8_SB(1, 1), b3 + hstep, voffB);
            PG8_WAIT_V(6); PG8_BAR; PG8_MMA(1, 1, At, B1); PG8_BAR;
            }
        }
        if constexpr (ALIGN_EPI) { if (wr == 0) PG8_BAR; }
        if constexpr (!Epi::AFTER_DRAIN) { E(acc, cur, wr, wc, fr, fq); S.done(cur); }
        if (!has_next) break;
#pragma unroll
        for (int a = 0; a < 2; ++a)
#pragma unroll
            for (int b = 0; b < 2; ++b)
#pragma unroll
                for (int m = 0; m < 4; ++m)
#pragma unroll
                    for (int n = 0; n < 2; ++n) acc[a][b][m][n] = (f32x4){0.f, 0.f, 0.f, 0.f};
        cur = nxt; cA = nA; cB = nB; ++ui;
        if constexpr (ALIGN_EPI) { if (wr == 1) PG8_BAR; }
    }
    PG8_WAIT_V(0);
    if constexpr (!ALIGN_EPI) { if (wr == 0) PG8_BAR; }
    PG8_BAR;
    if constexpr (Epi::AFTER_DRAIN) { E.fused(acc, cur, wr, wc, fr, fq, lds, wid, lane); S.done(cur); }
#undef PG8_SA
#undef PG8_SB
#undef PG8_STAGE
#undef PG8_LDA
#undef PG8_LDB
#undef PG8_MMA
#undef PG8_WAIT_V
#undef PG8_WAIT_L
#undef PG8_BAR
#undef PG8_SCHED
}
}
#define LAS __attribute__((address_space(3)))
#define XB_TMO      128
#define XB_XCNT(j)  (256  + 64 * (j))
#define XB_XSUB(j)  (1280 + 64 * (j))
#define XB_XGEN(j)  (2304 + 64 * (j))
#define XB_TOP      3328
#define XB_TOPGEN   3392
#define XCD_BAR_WORDS 3456
#define XB_SPIN_CAP (1u << 18)

__device__ __forceinline__ unsigned xb_ld(unsigned* p)              { return __hip_atomic_load(p, __ATOMIC_RELAXED, __HIP_MEMORY_SCOPE_AGENT); }
__device__ __forceinline__ unsigned xb_add(unsigned* p, unsigned v) { return __hip_atomic_fetch_add(p, v, __ATOMIC_RELAXED, __HIP_MEMORY_SCOPE_AGENT); }
__device__ __forceinline__ unsigned xb_xcc_id() { return (unsigned)__builtin_amdgcn_s_getreg((3 << 11) | 20) & 0xFu; }
#define XB_SPIN(cond, bar) do { unsigned _sp = 0; while (cond) { __builtin_amdgcn_s_sleep(1); \
    if ((++_sp & 255u) == 0u) { if (xb_ld(&(bar)[XB_TMO])) break; if (_sp > XB_SPIN_CAP) { atomicAdd(&(bar)[XB_TMO], 1u); break; } } } } while (0)

struct XcdBarrier {
    int wv;
    unsigned* bar; unsigned x;
    volatile LAS unsigned* st;
};

__device__ __forceinline__ XcdBarrier xcd_barrier_post(unsigned* bar, volatile LAS unsigned* st, int wv) {
    XcdBarrier b; b.wv = wv; b.bar = bar; b.x = xb_xcc_id(); b.st = st;
    if (otid(wv) == 0) (void)xb_add(&bar[XB_XCNT(b.x)], 1u);
    return b;
}
__device__ __forceinline__ void xcd_barrier_complete(unsigned* bar, unsigned x, unsigned& nloc, unsigned& nx) {
    const unsigned G = gridDim.x * gridDim.y * gridDim.z;
    unsigned sum, cnt, mine, sp = 0u;
    for (;;) {
        sum = 0u; cnt = 0u; mine = 0u;
#pragma unroll
        for (unsigned j = 0; j < 16; ++j) { const unsigned c = xb_ld(&bar[XB_XCNT(j)]); sum += c; cnt += (c > 0u) ? 1u : 0u; mine = (j == x) ? c : mine; }
        if (sum == G) break;
        __builtin_amdgcn_s_sleep(1);
        if ((++sp & 255u) == 0u) { if (xb_ld(&bar[XB_TMO])) break; if (sp > XB_SPIN_CAP) { atomicAdd(&bar[XB_TMO], 1u); break; } }
    }
    nloc = mine > 0u ? mine : 1u; nx = cnt > 0u ? cnt : 1u;
}

__device__ __forceinline__ void xcd_barrier(const XcdBarrier& b) {
    asm volatile("s_waitcnt vmcnt(0)" ::: "memory");
    __syncthreads();
    if (otid(b.wv) == 0) {
        unsigned* bar = b.bar;
        __builtin_amdgcn_s_waitcnt(0);
        unsigned nloc = b.st[0], nx = b.st[1];
        if (nloc == 0u) { xcd_barrier_complete(bar, b.x, nloc, nx); b.st[0] = nloc; b.st[1] = nx; }
        const unsigned old = xb_add(&bar[XB_XSUB(b.x)], 1u);
        const unsigned gen = old / nloc;
        if (old + 1u == (gen + 1u) * nloc) {
            __builtin_amdgcn_fence(__ATOMIC_RELEASE, "agent");
            asm volatile("s_waitcnt vmcnt(0)" ::: "memory");
            const unsigned og = xb_add(&bar[XB_TOP], 1u);
            const unsigned tg = og / nx;
            if (og + 1u == (tg + 1u) * nx) xb_add(&bar[XB_TOPGEN], 1u);
            else XB_SPIN(xb_ld(&bar[XB_TOPGEN]) == tg, bar);
            __builtin_amdgcn_fence(__ATOMIC_ACQUIRE, "agent");
            xb_add(&bar[XB_XGEN(b.x)], 1u);
            asm volatile("s_waitcnt vmcnt(0)" ::: "memory");
        } else {
            XB_SPIN(xb_ld(&bar[XB_XGEN(b.x)]) == gen, bar);
            __builtin_amdgcn_fence(__ATOMIC_ACQUIRE, "agent");
            asm volatile("s_waitcnt vmcnt(0)" ::: "memory");
        }
    }
    __syncthreads();
}


typedef unsigned short bf16;
typedef unsigned v4u __attribute__((ext_vector_type(4)));
typedef unsigned v2u __attribute__((ext_vector_type(2)));
typedef float f32x4 __attribute__((ext_vector_type(4)));

constexpr int D = 1024, SEQ = 2048, NBATCH = 32, M_ALL = NBATCH * SEQ;
constexpr int MC = M_ALL / 2;
constexpr int FF = 2816, RET_IN = 6144, QW = 3072, KVW = 6144;
constexpr float RMS_EPS = 1e-6f, GN_EPS = 1e-6f;
constexpr size_t MiB = 1u << 20;
constexpr size_t WS_CTL = 0;
constexpr size_t WS_RCOS = 1 * MiB, WS_RSIN = 2 * MiB;
constexpr size_t WS_ACOS = 3 * MiB, WS_ASIN = 3 * MiB + 65536;
constexpr size_t WS_RS = 3 * MiB + 512 * 1024;
constexpr size_t WS_SA = 3 * MiB + 768 * 1024;
constexpr size_t WS_WSC = 65536;
constexpr int WSC_KV = 4 * 2 * 2816, WSC_Q = WSC_KV + 6144, WSC_RET = WSC_Q + 2 * 3072;
constexpr size_t WS_W = 4 * MiB;
constexpr size_t W_RETIN = 0, W_RETOUT = W_RETIN + 2ull * RET_IN * D, W_KV = W_RETOUT + 2ull * D * 2048, W_Q = W_KV + (size_t)KVW * D,
                 W_O = W_Q + 2ull * QW * D, W_UP = W_O + 2ull * D * D, W_DOWN = W_UP + 4ull * 2 * FF * D, W_END = W_DOWN + 4ull * D * FF;
static_assert(W_END * 2 <= 127 * MiB, "weights");
constexpr size_t WS_XB = 132 * MiB;
constexpr size_t WS_GS = 260 * MiB;
constexpr size_t WS_BIG = 264 * MiB;
constexpr size_t WS_Q = 648 * MiB;
constexpr size_t WS_MBF = 776 * MiB;
constexpr size_t WS_O = 840 * MiB;
constexpr size_t WS_MB = 904 * MiB;
constexpr size_t WS_HALO = 968 * MiB;
constexpr size_t WS_P0 = 986 * MiB;
constexpr size_t WS_END = 1002 * MiB;
constexpr int RQP = 4096;

struct Params {
    const float* x; const float* ret_w_in; const float* ret_w_out; const float* ret_gn; const float* kv_norm; const float* w_kv; const float* w_q; const float* w_o;
    const float* n_mix_pre; const float* n_mix_post; const float* n_ffn_pre; const float* n_ffn_post; const float* w_up; const float* conv_w; const float* conv_b; const float* w_down;
    float* out; unsigned char* ws;
};

__device__ __forceinline__ float bf2f(unsigned short b) { return __uint_as_float(((unsigned)b) << 16); }
__device__ __forceinline__ unsigned f2bf(float f) { unsigned u = __float_as_uint(f); return (u + 0x7fffu + ((u >> 16) & 1u)) >> 16; }
__device__ __forceinline__ unsigned pk2(float lo, float hi) { return pg8::cvt_pk_bf16(lo, hi); }
__device__ __forceinline__ float dpp_add(float v, int ctrl_sel) {
    int r;
    if (ctrl_sel == 0) r = __builtin_amdgcn_update_dpp(0, __builtin_bit_cast(int, v), 0xB1, 0xF, 0xF, false);
    else if (ctrl_sel == 1) r = __builtin_amdgcn_update_dpp(0, __builtin_bit_cast(int, v), 0x4E, 0xF, 0xF, false);
    else if (ctrl_sel == 2) r = __builtin_amdgcn_update_dpp(0, __builtin_bit_cast(int, v), 0x141, 0xF, 0xF, false);
    else r = __builtin_amdgcn_update_dpp(0, __builtin_bit_cast(int, v), 0x140, 0xF, 0xF, false);
    return v + __builtin_bit_cast(float, r);
}
__device__ __forceinline__ float wave_max(float v) {
    v = fmaxf(v, __builtin_bit_cast(float, __builtin_amdgcn_update_dpp(0, __builtin_bit_cast(int, v), 0xB1, 0xF, 0xF, false)));
    v = fmaxf(v, __builtin_bit_cast(float, __builtin_amdgcn_update_dpp(0, __builtin_bit_cast(int, v), 0x4E, 0xF, 0xF, false)));
    v = fmaxf(v, __builtin_bit_cast(float, __builtin_amdgcn_update_dpp(0, __builtin_bit_cast(int, v), 0x141, 0xF, 0xF, false)));
    v = fmaxf(v, __builtin_bit_cast(float, __builtin_amdgcn_update_dpp(0, __builtin_bit_cast(int, v), 0x140, 0xF, 0xF, false)));
    { const unsigned u = __builtin_bit_cast(unsigned, v); auto r = __builtin_amdgcn_permlane16_swap(u, u, false, false); v = fmaxf(__builtin_bit_cast(float, (unsigned)r[0]), __builtin_bit_cast(float, (unsigned)r[1])); }
    { const unsigned u = __builtin_bit_cast(unsigned, v); auto r = __builtin_amdgcn_permlane32_swap(u, u, false, false); v = fmaxf(__builtin_bit_cast(float, (unsigned)r[0]), __builtin_bit_cast(float, (unsigned)r[1])); }
    return v;
}
__device__ __forceinline__ unsigned pk4_i8(float a, float b, float c, float d) {
    const unsigned ua = __float_as_uint(a + 12582912.0f), ub = __float_as_uint(b + 12582912.0f), uc = __float_as_uint(c + 12582912.0f), ud = __float_as_uint(d + 12582912.0f);
    const unsigned lo = __builtin_amdgcn_perm(ub, ua, 0x0c0c0400u), hi = __builtin_amdgcn_perm(ud, uc, 0x0c0c0400u);
    return __builtin_amdgcn_perm(hi, lo, 0x05040100u);
}
__device__ __forceinline__ float xmax32(float v) { const unsigned u = __builtin_bit_cast(unsigned, v); auto r = __builtin_amdgcn_permlane32_swap(u, u, false, false); return fmaxf(__builtin_bit_cast(float, (unsigned)r[0]), __builtin_bit_cast(float, (unsigned)r[1])); }
__device__ __forceinline__ float xsum32(float v) { const unsigned u = __builtin_bit_cast(unsigned, v); auto r = __builtin_amdgcn_permlane32_swap(u, u, false, false); return __builtin_bit_cast(float, (unsigned)r[0]) + __builtin_bit_cast(float, (unsigned)r[1]); }
__device__ __forceinline__ float xor32(float v) { int l; asm volatile("v_mbcnt_lo_u32_b32 %0, -1, 0\n\tv_mbcnt_hi_u32_b32 %0, -1, %0" : "=v"(l)); return __builtin_bit_cast(float, __builtin_amdgcn_ds_bpermute((l ^ 32) << 2, __builtin_bit_cast(int, v))); }
__device__ __forceinline__ float wave_sum(float v) {
    v = dpp_add(v, 0); v = dpp_add(v, 1); v = dpp_add(v, 2); v = dpp_add(v, 3);
    { const unsigned u = __builtin_bit_cast(unsigned, v); auto r = __builtin_amdgcn_permlane16_swap(u, u, false, false); v = __builtin_bit_cast(float, (unsigned)r[0]) + __builtin_bit_cast(float, (unsigned)r[1]); }
    { const unsigned u = __builtin_bit_cast(unsigned, v); auto r = __builtin_amdgcn_permlane32_swap(u, u, false, false); v = __builtin_bit_cast(float, (unsigned)r[0]) + __builtin_bit_cast(float, (unsigned)r[1]); }
    return v;
}
#define LDS_WAIT() asm volatile("s_waitcnt lgkmcnt(0)" ::: "memory")

namespace pg8 {
typedef float gf2 __attribute__((ext_vector_type(2)));
struct EpiRS {
    static constexpr bool PERM = true, AFTER_DRAIN = false;
    bf16_t* O; int ldc; int pad;
    __device__ __forceinline__ void operator()(const f32x4 (&acc)[2][2][4][2], const Unit& u, int wr, int wc, int fr, int fq) const {
        const int row0 = u.pm * BM + wr * 64 + fr, col0 = u.pn * BM + wc * 32 + 8 * fq;
#pragma unroll
        for (int ai = 0; ai < 2; ++ai)
#pragma unroll
            for (int m = 0; m < 4; ++m) {
                bf16_t* rowp = O + (size_t)(row0 + ai * HALF + m * 16) * ldc + col0;
#pragma unroll
                for (int bj = 0; bj < 2; ++bj) { const f32x4 v0 = acc[ai][bj][m][0], v1 = acc[ai][bj][m][1];
                    u32x4 w; w.x = cvt_pk_bf16(v0[0], v0[1]); w.y = cvt_pk_bf16(v0[2], v0[3]); w.z = cvt_pk_bf16(v1[0], v1[1]); w.w = cvt_pk_bf16(v1[2], v1[3]);
                    *(u32x4*)(rowp + bj * HALF) = w; }
            }
    }
};

struct EpiRetIn {
    static constexpr bool PERM = true, AFTER_DRAIN = false;
    bf16_t* O; const float* rs; const float* rc; const float* rsn; int ldc; int pad;
    __device__ __forceinline__ void operator()(const f32x4 (&acc)[2][2][4][2], const Unit& u, int wr, int wc, int fr_, int fq_) const {
        const int ln_ = otid(0); const int fr = ln_ & 15, fq = ln_ >> 4; (void)fr_; (void)fq_;
        const int row0 = u.pm * BM + wr * 64 + fr, j0 = wc * 32 + 8 * fq, col0 = u.pn * BM + j0;
        const bool rot = u.pn < 8; const float ksc = (u.pn >= 4 && u.pn < 8) ? 0.0625f : 1.0f;
#pragma unroll
        for (int ab = 0; ab < 4; ++ab) { const int ai = ab >> 1, mb = 2 * (ab & 1);
            float sv[4]; f32x4 c0[4], c1[4], s0[4], s1[4];
#pragma unroll
            for (int m = mb; m < mb + 2; ++m) { const int row = row0 + ai * HALF + m * 16; sv[m] = rs[row] * ksc;
                if (rot) { const int pos = row & 2047; const float* cp = rc + pos * 128 + j0; const float* sp = rsn + pos * 128 + j0;
                    c0[m] = *(const f32x4*)cp; c1[m] = *(const f32x4*)(cp + 4); s0[m] = *(const f32x4*)sp; s1[m] = *(const f32x4*)(sp + 4); } }
#pragma unroll
            for (int m = mb; m < mb + 2; ++m) {
                const int row = row0 + ai * HALF + m * 16; const float s = sv[m];
                f32x4 a0 = acc[ai][0][m][0], a1 = acc[ai][0][m][1], b0 = acc[ai][1][m][0], b1 = acc[ai][1][m][1];
                if (rot) { const f32x4 n0 = a0 * c0[m] - b0 * s0[m], n1 = a1 * c1[m] - b1 * s1[m], q0 = b0 * c0[m] + a0 * s0[m], q1 = b1 * c1[m] + a1 * s1[m];
                    a0 = n0; a1 = n1; b0 = q0; b1 = q1; }
                a0 = a0 * s; a1 = a1 * s; b0 = b0 * s; b1 = b1 * s;
                bf16_t* rowp = O + ((size_t)((row >> 11) * 16 + u.pn) * 2048 + (row & 2047)) * 256 + j0;
                u32x4 w; w.x = cvt_pk_bf16(a0[0], a0[1]); w.y = cvt_pk_bf16(a0[2], a0[3]); w.z = cvt_pk_bf16(a1[0], a1[1]); w.w = cvt_pk_bf16(a1[2], a1[3]); __builtin_nontemporal_store(w, (u32x4*)rowp);
                u32x4 x; x.x = cvt_pk_bf16(b0[0], b0[1]); x.y = cvt_pk_bf16(b0[2], b0[3]); x.z = cvt_pk_bf16(b1[0], b1[1]); x.w = cvt_pk_bf16(b1[2], b1[3]); __builtin_nontemporal_store(x, (u32x4*)(rowp + HALF));
            }
        }
    }
};
struct EpiGate8 {
    static constexpr bool PERM = true, AFTER_DRAIN = false;
    bf16_t* Y; const float* sa; const float* sw; PG8_LAS float* st; const float* gain;
    __device__ __forceinline__ void operator()(const f32x4 (&acc)[2][2][4][2], const Unit& u, int wr, int wc, int fr_, int fq_) const {
        const int ln_ = otid(0); const int fr = ln_ & 15, fq = ln_ >> 4; (void)fr_; (void)fq_;
        const int row0 = u.pm * BM + wr * 64 + fr, col0 = u.pn * BM + wc * 32 + 8 * fq, head = u.pn >> 1;
        if ((u.pn & 1) == 0) {
            const int wid = wr * 4 + wc;
#pragma unroll
            for (int jb = 0; jb < 2; ++jb) {
                u32x4 yr[16];
#pragma unroll
                for (int k = 0; k < 16; ++k) yr[k] = *((const u32x4*)(Y + (size_t)(u.pm * BM + wid * 32 + jb * 16 + k) * 2048 + head * 512) + ln_);
#pragma unroll
                for (int k = 0; k < 16; ++k) {
                    float y[8];
#pragma unroll
                    for (int e = 0; e < 4; ++e) { y[2 * e] = __uint_as_float(yr[k][e] << 16); y[2 * e + 1] = __uint_as_float(yr[k][e] & 0xffff0000u); }
                    float sm = 0.f;
#pragma unroll
                    for (int e = 0; e < 8; ++e) sm += y[e];
                    const float mu = ::wave_sum(sm) * (1.0f / 512.0f); float q = 0.f;
#pragma unroll
                    for (int e = 0; e < 8; ++e) { const float d = y[e] - mu; q += d * d; }
                    const float rstd = 1.0f / sqrtf(::wave_sum(q) * (1.0f / 512.0f) + 1e-6f);
                    if (ln_ == 0) { PG8_LAS float* d = st + (wid * 32 + jb * 16 + k) * 2; d[0] = mu; d[1] = rstd; }
                }
            }
            asm volatile("s_waitcnt lgkmcnt(0)" ::: "memory"); __builtin_amdgcn_s_barrier(); asm volatile("" ::: "memory");
        }
        float gn[2][8], cs[2][8];
#pragma unroll
        for (int bj = 0; bj < 2; ++bj) { const f32x4 a = *(const f32x4*)(gain + col0 + bj * HALF), b = *(const f32x4*)(gain + col0 + bj * HALF + 4), c = *(const f32x4*)(sw + col0 + bj * HALF), d = *(const f32x4*)(sw + col0 + bj * HALF + 4);
#pragma unroll
            for (int e = 0; e < 4; ++e) { gn[bj][e] = a[e]; gn[bj][4 + e] = b[e]; cs[bj][e] = c[e]; cs[bj][4 + e] = d[e]; } }
#pragma unroll
        for (int ai = 0; ai < 2; ++ai) {
            float sv[4], muv[4], rsv[4]; u32x4 yv[4][2];
#pragma unroll
            for (int m = 0; m < 4; ++m) { const int row = row0 + ai * HALF + m * 16; sv[m] = sa[row];
                const PG8_LAS float* sp = st + (wr * 64 + fr + ai * HALF + m * 16) * 2; muv[m] = sp[0]; rsv[m] = sp[1];
                const bf16_t* rowp = Y + (size_t)row * 2048 + col0; yv[m][0] = *(const u32x4*)rowp; yv[m][1] = *(const u32x4*)(rowp + HALF); }
#pragma unroll
            for (int m = 0; m < 4; ++m) {
                const int row = row0 + ai * HALF + m * 16; const float s = sv[m], mu = muv[m], rstd = rsv[m];
                bf16_t* rowp = Y + (size_t)row * 2048 + col0;
                const gf2 s2 = {s, s}, rs2 = {rstd, rstd}, nm2 = {-mu * rstd, -mu * rstd};
#pragma unroll
                for (int bj = 0; bj < 2; ++bj) { unsigned ow[4];
#pragma unroll
                    for (int e = 0; e < 8; e += 2) {
                        const gf2 g = (gf2){(float)__float_as_int(acc[ai][bj][m][e >> 2][e & 3]), (float)__float_as_int(acc[ai][bj][m][e >> 2][(e & 3) + 1])} * s2 * (gf2){cs[bj][e], cs[bj][e + 1]};
                        const unsigned w = yv[m][bj][e >> 1]; const gf2 y = {__uint_as_float(w << 16), __uint_as_float(w & 0xffff0000u)};
                        const gf2 a = g * (gf2){-1.4426950408889634f, -1.4426950408889634f};
                        gf2 t; t.x = __builtin_amdgcn_exp2f(a.x); t.y = __builtin_amdgcn_exp2f(a.y);
                        const gf2 d = t + (gf2){1.0f, 1.0f};
                        gf2 r; r.x = __builtin_amdgcn_rcpf(d.x); r.y = __builtin_amdgcn_rcpf(d.y);
                        const gf2 o = (g * r) * ((y * rs2 + nm2) * (gf2){gn[bj][e], gn[bj][e + 1]});
                        ow[e >> 1] = cvt_pk_bf16(o.x, o.y); }
                    u32x4 w; w.x = ow[0]; w.y = ow[1]; w.z = ow[2]; w.w = ow[3];
                    *(u32x4*)(rowp + bj * HALF) = w; }
            }
        }
    }
};
struct PairOrder {
    StaticOrder so;
    __host__ __device__ void init(int M, int N, int G_, int c_) { so.init(M, N / 2, G_, c_); }
    __host__ __device__ bool next(int i, Unit& u) const { Unit h; if (!so.next(i >> 1, h)) return false; u.pm = h.pm; u.pn = 2 * h.pn + (i & 1); return true; }
    __device__ __forceinline__ void a_ready(const Unit&) const {}
    __device__ __forceinline__ void done(const Unit&) const {}
};
struct EpiAttRot {
    static constexpr bool PERM = true, AFTER_DRAIN = false;
    bf16_t* O; const float* rs; const float* ac; const float* as; int ldc; int rot_tiles;
    __device__ __forceinline__ void operator()(const f32x4 (&acc)[2][2][4][2], const Unit& u, int wr, int wc, int fr, int fq) const {
        const int row0 = u.pm * BM + wr * 64 + fr, col0 = u.pn * BM + wc * 32 + 8 * fq;
        const bool wrot = (u.pn < rot_tiles) && ((wc & 1) == 0); const bool lrot = fq < 2;
#pragma unroll
        for (int ai = 0; ai < 2; ++ai)
#pragma unroll
            for (int m = 0; m < 4; ++m) {
                const int row = row0 + ai * HALF + m * 16; const float s = rs[row];
                f32x4 cc = (f32x4){1.f, 1.f, 1.f, 1.f}, ss = (f32x4){0.f, 0.f, 0.f, 0.f};
                if (wrot) { const int pos = row & 2047; const f32x4 c = *(const f32x4*)(ac + pos * 8 + 4 * (fq & 1)), sn = *(const f32x4*)(as + pos * 8 + 4 * (fq & 1));
                    if (lrot) { cc = c; ss = sn; } }
                bf16_t* rowp = O + (size_t)row * ldc + col0;
#pragma unroll
                for (int bj = 0; bj < 2; ++bj) { const f32x4 v0 = acc[ai][bj][m][0], v1 = acc[ai][bj][m][1];
                    const float n0 = (v0[0] * cc[0] - v0[1] * ss[0]) * s, n1 = (v0[1] * cc[0] + v0[0] * ss[0]) * s, n2 = (v0[2] * cc[1] - v0[3] * ss[1]) * s, n3 = (v0[3] * cc[1] + v0[2] * ss[1]) * s;
                    const float n4 = (v1[0] * cc[2] - v1[1] * ss[2]) * s, n5 = (v1[1] * cc[2] + v1[0] * ss[2]) * s, n6 = (v1[2] * cc[3] - v1[3] * ss[3]) * s, n7 = (v1[3] * cc[3] + v1[2] * ss[3]) * s;
                    u32x4 w; w.x = cvt_pk_bf16(n0, n1); w.y = cvt_pk_bf16(n2, n3); w.z = cvt_pk_bf16(n4, n5); w.w = cvt_pk_bf16(n6, n7);
                    *(u32x4*)(rowp + bj * HALF) = w; }
            }
    }
};

struct EpiAttRot8 {
    static constexpr bool PERM = true, AFTER_DRAIN = false;
    bf16_t* O; const float* sa; const float* sw; const float* ac; const float* as; int ldc; int rot_tiles;
    __device__ __forceinline__ void operator()(const f32x4 (&acc)[2][2][4][2], const Unit& u, int wr, int wc, int fr_, int fq_) const {
        const int ln_ = otid(0); const int fr = ln_ & 15, fq = ln_ >> 4; (void)fr_; (void)fq_;
        const int row0 = u.pm * BM + wr * 64 + fr, col0 = u.pn * BM + wc * 32 + 8 * fq;
        const bool iskv = ldc == 6144;
        size_t cbase[2]; int grp[2];
#pragma unroll
        for (int bj = 0; bj < 2; ++bj) { const int n = col0 + bj * HALF; const int part = (iskv && n >= 3072) ? 1 : 0, nn = n - 3072 * part, gh = nn >> 6, d = nn & 63;
            grp[bj] = (gh >> 4) + ((!iskv && gh < 16) ? 1 : 0)  ; cbase[bj] = (iskv ? (size_t)(gh * 2 + part) : (size_t)gh) * 131072 + d; }
        const bool wrot = (u.pn < rot_tiles) && ((wc & 1) == 0); const bool lrot = fq < 2;
        float cs[2][8];
#pragma unroll
        for (int bj = 0; bj < 2; ++bj) { const f32x4 a = *(const f32x4*)(sw + col0 + bj * HALF), b = *(const f32x4*)(sw + col0 + bj * HALF + 4);
#pragma unroll
            for (int e = 0; e < 4; ++e) { cs[bj][e] = a[e]; cs[bj][4 + e] = b[e]; } }
#pragma unroll
        for (int ai = 0; ai < 2; ++ai) {
            float sv[4]; f32x4 ccv[4], ssv[4];
#pragma unroll
            for (int m = 0; m < 4; ++m) { const int row = row0 + ai * HALF + m * 16; sv[m] = sa[row];
                ccv[m] = (f32x4){1.f, 1.f, 1.f, 1.f}; ssv[m] = (f32x4){0.f, 0.f, 0.f, 0.f};
                if (wrot) { const int pos = row & 2047; const f32x4 c = *(const f32x4*)(ac + pos * 8 + 4 * (fq & 1)), sn = *(const f32x4*)(as + pos * 8 + 4 * (fq & 1));
                    if (lrot) { ccv[m] = c; ssv[m] = sn; } } }
#pragma unroll
            for (int m = 0; m < 4; ++m) {
                const int row = row0 + ai * HALF + m * 16; const float s = sv[m];
                const f32x4 cc = ccv[m], ss = ssv[m];
                const int tk = row & 2047; bf16_t* rowb = O + (size_t)(row >> 11) * (iskv ? 48 * 2 * 131072 : 48 * 131072);
#pragma unroll
                for (int bj = 0; bj < 2; ++bj) { float t[8];
                    const int slot = grp[bj] == 0 ? tk : (grp[bj] == 1 ? (((tk & 3) << 9) | (tk >> 2)) : (((tk & 15) << 7) | (tk >> 4)));
#pragma unroll
                    for (int e = 0; e < 8; ++e) t[e] = (float)__float_as_int(acc[ai][bj][m][e >> 2][e & 3]) * cs[bj][e];
                    u32x4 w;
                    if (!wrot) {
                        w.x = cvt_pk_bf16(t[0] * s, t[1] * s); w.y = cvt_pk_bf16(t[2] * s, t[3] * s); w.z = cvt_pk_bf16(t[4] * s, t[5] * s); w.w = cvt_pk_bf16(t[6] * s, t[7] * s);
                    } else {
                    unsigned ww[4];
#pragma unroll
                    for (int i = 0; i < 4; ++i) { const gf2 T = {t[2 * i], t[2 * i + 1]}, Ts = {t[2 * i + 1], t[2 * i]};
                        const gf2 N = T * (gf2){cc[i] * s, cc[i] * s} + Ts * (gf2){-ss[i] * s, ss[i] * s};
                        ww[i] = cvt_pk_bf16(N.x, N.y); }
                    w.x = ww[0]; w.y = ww[1]; w.z = ww[2]; w.w = ww[3];
                    }
                    *(u32x4*)(rowb + cbase[bj] + (size_t)slot * 64) = w; }
            }
        }
    }
};

__device__ __forceinline__ float dpp_ror1(float x) { return __builtin_bit_cast(float, __builtin_amdgcn_update_dpp(0, __builtin_bit_cast(int, x), 0x121, 0xF, 0xF, false)); }
__device__ __forceinline__ float dpp_shr1_old(float oldv, float x) { return __builtin_bit_cast(float, __builtin_amdgcn_update_dpp(__builtin_bit_cast(int, oldv), __builtin_bit_cast(int, x), 0x111, 0xF, 0xF, false)); }
__device__ __forceinline__ float dpp_ror2(float x) { return __builtin_bit_cast(float, __builtin_amdgcn_update_dpp(0, __builtin_bit_cast(int, x), 0x122, 0xF, 0xF, false)); }
__device__ __forceinline__ gf2 gelu_tanh_mul2(gf2 x, gf2 v) {
    const gf2 p = x * x * (gf2){0.10294324f, 0.10294324f} + (gf2){2.30220819f, 2.30220819f};
    const gf2 a = -x * p;
    gf2 t; t.x = __builtin_amdgcn_exp2f(a.x); t.y = __builtin_amdgcn_exp2f(a.y);
    const gf2 d = t + (gf2){1.0f, 1.0f};
    gf2 r; r.x = __builtin_amdgcn_rcpf(d.x); r.y = __builtin_amdgcn_rcpf(d.y);
    return x * v * r;
}
__device__ __forceinline__ float gelu_tanh_mul(float x, float v) { const float t = __builtin_amdgcn_exp2f(-x * (2.30220819f + 0.10294324f * x * x)); return x * v * __builtin_amdgcn_rcpf(1.0f + t); }
struct EpiUpConv {
    static constexpr bool PERM = true, AFTER_DRAIN = false; static constexpr int NST = 8;
    bf16_t* H; const float* sa; const float* sw; const float* cw; const float* cb; float* halo_g; PG8_LAS float* hl;
    static __device__ __forceinline__ f32x4 cvt4(const f32x4 a, float s) { f32x4 r;
#pragma unroll
        for (int e = 0; e < 4; ++e) r[e] = (float)__float_as_int(a[e]) * s;
        return r; }
    __device__ __forceinline__ void operator()(const f32x4 (&acc)[2][2][4][2], const Unit& u, int wr, int wc, int fr_, int fq_) const {
        const int ln_ = otid(0); const int fr = ln_ & 15, fq = ln_ >> 4; (void)fr_; (void)fq_;
        const int c0 = wc * 32 + 8 * fq, f0 = u.pn * HALF + c0, row0 = u.pm * BM + wr * 64 + 4 * fr;
        float* hb = halo_g + ((size_t)u.pm * 22 + u.pn) * 768 + c0;
        float sv[2][4];
#pragma unroll
        for (int ai = 0; ai < 2; ++ai) { const f32x4 t = *(const f32x4*)(sa + row0 + ai * HALF);
#pragma unroll
            for (int m = 0; m < 4; ++m) sv[ai][m] = t[m]; }
        float w0[8], w1[8], w2[8], bb[8], sv8[8];
#pragma unroll
        for (int e = 0; e < 8; ++e) { const float sg = sw[f0 + e]; w0[e] = cw[f0 + e] * sg; w1[e] = cw[FF + f0 + e] * sg; w2[e] = cw[2 * FF + f0 + e] * sg; bb[e] = cb[f0 + e]; sv8[e] = sw[FF + f0 + e]; }
#pragma unroll
        for (int ai = 0; ai < 2; ++ai)
            if (fr == 15) {
#pragma unroll
                for (int k = 0; k < 2; ++k) { PG8_LAS float* d = hl + ((2 * ai + wr) * 2 + k) * 128 + c0; const float s = sv[ai][2 + k];
                    *(PG8_LAS f32x4*)d = cvt4(acc[ai][0][2 + k][0], s); *(PG8_LAS f32x4*)(d + 4) = cvt4(acc[ai][0][2 + k][1], s); } }
        asm volatile("s_waitcnt lgkmcnt(0)" ::: "memory"); __builtin_amdgcn_s_barrier(); asm volatile("" ::: "memory");
#pragma unroll
        for (int ai = 0; ai < 2; ++ai) {
            const int gid = 2 * ai + wr;
            float hm1[8], hm2[8];
#pragma unroll
            for (int e = 0; e < 8; ++e) { hm1[e] = 0.f; hm2[e] = 0.f; }
            if (gid > 0) { const PG8_LAS float* s2 = hl + ((gid - 1) * 2 + 0) * 128 + c0; const PG8_LAS float* s1 = hl + ((gid - 1) * 2 + 1) * 128 + c0;
                const f32x4 a = *(const PG8_LAS f32x4*)s2, b = *(const PG8_LAS f32x4*)(s2 + 4), c = *(const PG8_LAS f32x4*)s1, d = *(const PG8_LAS f32x4*)(s1 + 4);
#pragma unroll
                for (int e = 0; e < 4; ++e) { hm2[e] = a[e]; hm2[4 + e] = b[e]; hm1[e] = c[e]; hm1[4 + e] = d[e]; } }
            float o[4][8];
#pragma unroll
            for (int e = 0; e < 8; e += 2) {
                gf2 g[4], v[4];
#pragma unroll
                for (int m = 0; m < 4; ++m) {
                    g[m] = (gf2){(float)__float_as_int(acc[ai][0][m][e >> 2][e & 3]), (float)__float_as_int(acc[ai][0][m][e >> 2][(e & 3) + 1])} * sv[ai][m];
                    v[m] = (gf2){(float)__float_as_int(acc[ai][1][m][e >> 2][e & 3]), (float)__float_as_int(acc[ai][1][m][e >> 2][(e & 3) + 1])} * sv[ai][m] * (gf2){sv8[e], sv8[e + 1]}; }
                gf2 tm1, tm2;
                tm1.x = dpp_shr1_old(hm1[e], g[3].x); tm1.y = dpp_shr1_old(hm1[e + 1], g[3].y); tm2.x = dpp_shr1_old(hm2[e], g[2].x); tm2.y = dpp_shr1_old(hm2[e + 1], g[2].y);
                const gf2 W0 = {w0[e], w0[e + 1]}, W1 = {w1[e], w1[e + 1]}, W2 = {w2[e], w2[e + 1]}, BB = {bb[e], bb[e + 1]};
                const gf2 r0 = gelu_tanh_mul2(BB + W0 * tm2 + W1 * tm1 + W2 * g[0], v[0]);
                const gf2 r1 = gelu_tanh_mul2(BB + W0 * tm1 + W1 * g[0] + W2 * g[1], v[1]);
                const gf2 r2 = gelu_tanh_mul2(BB + W0 * g[0] + W1 * g[1] + W2 * g[2], v[2]);
                const gf2 r3 = gelu_tanh_mul2(BB + W0 * g[1] + W1 * g[2] + W2 * g[3], v[3]);
                o[0][e] = r0.x; o[0][e + 1] = r0.y; o[1][e] = r1.x; o[1][e + 1] = r1.y; o[2][e] = r2.x; o[2][e + 1] = r2.y; o[3][e] = r3.x; o[3][e + 1] = r3.y;
            }
#pragma unroll
            for (int m = 0; m < 4; ++m) {
                u32x4 w; w.x = cvt_pk_bf16(o[m][0], o[m][1]); w.y = cvt_pk_bf16(o[m][2], o[m][3]); w.z = cvt_pk_bf16(o[m][4], o[m][5]); w.w = cvt_pk_bf16(o[m][6], o[m][7]);
                __builtin_nontemporal_store(w, (u32x4*)(H + (size_t)(row0 + ai * HALF + m) * FF + f0));
            }
        }
        if (wr == 1 && fr == 15) {
#pragma unroll
            for (int k = 0; k < 2; ++k) { const float s = sv[1][2 + k]; float* gd = hb + k * 128; *(f32x4*)gd = cvt4(acc[1][0][2 + k][0], s); *(f32x4*)(gd + 4) = cvt4(acc[1][0][2 + k][1], s); } }
        if (wr == 0 && fr == 0) {
#pragma unroll
            for (int k = 0; k < 2; ++k) { const float s = sv[0][k]; float* gd = hb + (2 + k) * 128; *(f32x4*)gd = cvt4(acc[0][0][k][0], s); *(f32x4*)(gd + 4) = cvt4(acc[0][0][k][1], s);
                float* vd = hb + (4 + k) * 128; *(f32x4*)vd = cvt4(acc[0][1][k][0], s); *(f32x4*)(vd + 4) = cvt4(acc[0][1][k][1], s); } }
    }
};

struct EpiGate {
    static constexpr bool PERM = true, AFTER_DRAIN = false;
    bf16_t* Y; const float* rs; const float* gs; const float* gain;
    __device__ __forceinline__ void operator()(const f32x4 (&acc)[2][2][4][2], const Unit& u, int wr, int wc, int fr, int fq) const {
        const int row0 = u.pm * BM + wr * 64 + fr, col0 = u.pn * BM + wc * 32 + 8 * fq, head = u.pn >> 1;
        float gn[2][8];
#pragma unroll
        for (int bj = 0; bj < 2; ++bj) { const f32x4 a = *(const f32x4*)(gain + col0 + bj * HALF), b = *(const f32x4*)(gain + col0 + bj * HALF + 4);
#pragma unroll
            for (int e = 0; e < 4; ++e) { gn[bj][e] = a[e]; gn[bj][4 + e] = b[e]; } }
#pragma unroll
        for (int ai = 0; ai < 2; ++ai)
#pragma unroll
            for (int m = 0; m < 4; ++m) {
                const int row = row0 + ai * HALF + m * 16; const float s = rs[row]; const float mu = gs[(row * 4 + head) * 2], rstd = gs[(row * 4 + head) * 2 + 1];
                bf16_t* rowp = Y + (size_t)row * 2048 + col0;
#pragma unroll
                for (int bj = 0; bj < 2; ++bj) { const u32x4 yv = *(const u32x4*)(rowp + bj * HALF); float o[8];
#pragma unroll
                    for (int e = 0; e < 8; ++e) { const float g = acc[ai][bj][m][e >> 2][e & 3] * s; const unsigned w = yv[e >> 1]; const float y = __uint_as_float((e & 1) ? (w & 0xffff0000u) : (w << 16));
                        const float sil = g * __builtin_amdgcn_rcpf(1.0f + __builtin_amdgcn_exp2f(-1.4426950408889634f * g)); o[e] = sil * ((y - mu) * rstd * gn[bj][e]); }
                    u32x4 w; w.x = cvt_pk_bf16(o[0], o[1]); w.y = cvt_pk_bf16(o[2], o[3]); w.z = cvt_pk_bf16(o[4], o[5]); w.w = cvt_pk_bf16(o[6], o[7]);
                    *(u32x4*)(rowp + bj * HALF) = w; }
            }
    }
};
}

template <class Epi, int QM = 0>
__device__ __forceinline__ void gemm_call(LAS unsigned char* lds, const bf16* A, const bf16* Bt, int M, int N, int K, const Epi& E, int G, int bid, int wv) {
    pg8::Gemm g{A, Bt, M, N, K}; pg8::StaticOrder S; S.init(M, N, G, bid);
    pg8::gemm_phase<Epi, pg8::StaticOrder, true, true, QM>(lds, g, S, E, wv);
}
template <class Epi, int QM>
__device__ __forceinline__ void gemm_call_pair(LAS unsigned char* lds, const bf16* A, const bf16* Bt, int M, int N, int K, const Epi& E, int G, int bid, int wv) {
    pg8::Gemm g{A, Bt, M, N, K}; pg8::PairOrder S; S.init(M, N, G, bid);
    pg8::gemm_phase<Epi, pg8::PairOrder, true, true, QM>(lds, g, S, E, wv);
}
__device__ __forceinline__ unsigned pk4_fp8(float a, float b, float c, float d) { int w = 0; w = __builtin_amdgcn_cvt_pk_fp8_f32(a, b, w, false); w = __builtin_amdgcn_cvt_pk_fp8_f32(c, d, w, true); return (unsigned)w; }
constexpr float W8_SCALE = 32.0f;

struct TItem { const float* W; int K, N; bf16* WT; const float* gain; int mode, rot_limit, item; const float* wsc  ; };
__device__ __forceinline__ void transpose_load(const TItem& t, int lane, float (&v)[32]) {
    const int nblk = t.N / 32, kb = t.item / nblk, nb = t.item % nblk, k0 = 64 * kb, n0 = 32 * nb;
    int src0 = n0;
    if (t.mode == 1) { const int pn = n0 >> 8, bj = (n0 >> 7) & 1, i0 = n0 & 127; src0 = bj * FF + 128 * pn + i0; }
#pragma unroll
    for (int i = 0; i < 32; ++i) { const int kk = 2 * i + (lane >> 5); const float g = t.gain ? t.gain[k0 + kk] : 1.f; v[i] = t.W[(size_t)(k0 + kk) * t.N + src0 + (lane & 31)] * g; }
}
__device__ __forceinline__ void transpose_finish(const TItem& t, LAS float* scr, int lane, const float (&v)[32]) {
    const int K = t.K; bf16* WT = t.WT; const float* wsc = t.wsc;
    const int nblk = t.N / 32, kb = t.item / nblk, nb = t.item % nblk, k0 = 64 * kb, n0 = 32 * nb;
    int src0 = n0;
    if (t.mode == 1) { const int pn = n0 >> 8, bj = (n0 >> 7) & 1, i0 = n0 & 127; src0 = bj * FF + 128 * pn + i0; }
#pragma unroll
    for (int i = 0; i < 32; ++i) { const int kk = 2 * i + (lane >> 5); scr[kk * 33 + (lane & 31)] = v[i]; }
    LDS_WAIT(); asm volatile("" ::: "memory");
    const int c = lane & 7;
    const bool rot = (n0 < t.rot_limit) && ((n0 & 63) == 0);
#pragma unroll
    for (int j = 0; j < 4; ++j) { const int n = (lane >> 3) + 8 * j; const int sn = (rot && n < 16) ? ((n & 1) * 8 + (n >> 1)) : n; const LAS float* s = scr + (8 * c) * 33 + sn;
        if (wsc) { const float sc = wsc[src0 + n], iv = sc > 0.f ? 1.0f / sc : 0.f;
            v2u o; o.x = pk4_i8(s[0 * 33] * iv, s[1 * 33] * iv, s[2 * 33] * iv, s[3 * 33] * iv); o.y = pk4_i8(s[4 * 33] * iv, s[5 * 33] * iv, s[6 * 33] * iv, s[7 * 33] * iv);
            *(v2u*)((unsigned char*)WT + (size_t)(n0 + n) * K + k0 + 8 * c) = o; continue; }
        v4u o; o.x = pk2(s[0 * 33], s[1 * 33]); o.y = pk2(s[2 * 33], s[3 * 33]); o.z = pk2(s[4 * 33], s[5 * 33]); o.w = pk2(s[6 * 33], s[7 * 33]);
        *(v4u*)(WT + (size_t)(n0 + n) * K + k0 + 8 * c) = o; }
    LDS_WAIT(); asm volatile("" ::: "memory");
}

__device__ __forceinline__ void ph_wmax(const Params& p, LAS unsigned char* lds, int G, int bid, int wv) {
    const int tid = otid(wv), lane = tid & 63, wave = tid >> 6;
    LAS float* part = (LAS float*)lds;
    float* WSC = (float*)(p.ws + WS_WSC);
    for (int it = bid; it < 4 * 44 + 48 + 2 * 24 + 2 * 16; it += G) {
        const float* Wb; const float* gk; int pitch, c, obase, rot_limit;
        if (it < 176) { const int l = it / 44; c = it % 44; Wb = p.w_up + (size_t)l * D * 2 * FF; gk = p.n_ffn_pre + l * D; pitch = 2 * FF; obase = l * 2 * FF; rot_limit = 0; }
        else if (it < 224) { c = it - 176; Wb = p.w_kv; gk = p.kv_norm; pitch = KVW; obase = WSC_KV; rot_limit = 3072; }
        else if (it >= 272) { const int l = (it - 272) / 16; c = 32 + (it - 272) % 16  ; Wb = p.ret_w_in + (size_t)l * D * RET_IN; gk = p.n_mix_pre + l * D; pitch = RET_IN; obase = WSC_RET + l * RET_IN; rot_limit = 0; }
        else { const int l = (it - 224) / 24; c = (it - 224) % 24; Wb = p.w_q + (size_t)l * D * QW; gk = p.n_mix_pre + (2 + l) * D; pitch = QW; obase = WSC_Q + l * QW; rot_limit = QW; }
        const float* W = Wb + 128 * c + 2 * lane;
        float m0 = 0.f, m1 = 0.f;
#pragma unroll 32
        for (int k = wave * 128; k < wave * 128 + 128; ++k) { const float gg = gk[k]; const float2 w = *(const float2*)(W + (size_t)k * pitch); m0 = fmaxf(m0, fabsf(w.x * gg)); m1 = fmaxf(m1, fabsf(w.y * gg)); }
        part[wave * 128 + 2 * lane] = m0; part[wave * 128 + 2 * lane + 1] = m1;
        __syncthreads();
        if (tid < 128) { float m = part[tid];
#pragma unroll
            for (int w = 1; w < 8; ++w) m = fmaxf(m, part[w * 128 + tid]);
            const int sc_ = 128 * c + tid, hj = sc_ & 63; int oc = sc_;
            if (sc_ < rot_limit && hj < 16) oc = (sc_ & ~63) + (hj < 8 ? 2 * hj : 2 * (hj - 8) + 1);
            WSC[obase + oc] = m * (1.0f / 127.0f); }
        __syncthreads();
    }
}
__device__ __forceinline__ void ph_prologue(const Params& p, LAS unsigned char* lds, int G, int bid, int wv) {
    const int tid = otid(wv), lane = tid & 63, wave = tid >> 6;
    LAS float* scr = (LAS float*)(lds + wave * 16384);
    const int gw = bid * 8 + wave, NGW = G * 8;
    bf16* WB = (bf16*)(p.ws + WS_W);
    constexpr int I_RETIN = 16 * 192, I_RETOUT = 32 * 32, I_KV = 16 * 192, I_Q = 16 * 96, I_O = 16 * 32, I_UP = 16 * 176, I_DOWN = 44 * 32;
    constexpr int NITEMS = 2 * I_RETIN + 2 * I_RETOUT + I_KV + 2 * I_Q + 2 * I_O + 4 * I_UP + 4 * I_DOWN;
    const float* WSCb = (const float*)(p.ws + WS_WSC);
    auto decode = [&](int it) -> TItem {
        int r = it;
        if (r < 2 * I_RETIN) { const int l = r / I_RETIN; const int itx = r % I_RETIN; const bool gate = (itx % 192) >= 128;
            bf16* base = WB + W_RETIN + (size_t)l * RET_IN * D;
            return TItem{p.ret_w_in + (size_t)l * D * RET_IN, D, RET_IN, gate ? (bf16*)((unsigned char*)base + (size_t)RQP * D) : base, p.n_mix_pre + l * D, 0, 0, itx, gate ? WSCb + WSC_RET + l * RET_IN : nullptr}; } r -= 2 * I_RETIN;
        if (r < 2 * I_RETOUT) { const int l = r / I_RETOUT; return TItem{p.ret_w_out + (size_t)l * 2048 * D, 2048, D, WB + W_RETOUT + (size_t)l * D * 2048, nullptr, 0, 0, r % I_RETOUT, nullptr}; } r -= 2 * I_RETOUT;
        if (r < I_KV) return TItem{p.w_kv, D, KVW, WB + W_KV, p.kv_norm, 0, 3072, r, WSCb + WSC_KV}; r -= I_KV;
        if (r < 2 * I_Q) { const int l = r / I_Q; return TItem{p.w_q + (size_t)l * D * QW, D, QW, (bf16*)((unsigned char*)(WB + W_Q) + (size_t)l * QW * D), p.n_mix_pre + (2 + l) * D, 0, QW, r % I_Q, WSCb + WSC_Q + l * QW}; } r -= 2 * I_Q;
        if (r < 2 * I_O) { const int l = r / I_O; return TItem{p.w_o + (size_t)l * D * D, D, D, WB + W_O + (size_t)l * D * D, nullptr, 0, 0, r % I_O, nullptr}; } r -= 2 * I_O;
        if (r < 4 * I_UP) { const int l = r / I_UP; return TItem{p.w_up + (size_t)l * D * 2 * FF, D, 2 * FF, (bf16*)((unsigned char*)(WB + W_UP) + (size_t)l * 2 * FF * D), p.n_ffn_pre + l * D, 1, 0, r % I_UP, WSCb + l * 2 * FF}; } r -= 4 * I_UP;
        { const int l = r / I_DOWN; return TItem{p.w_down + (size_t)l * FF * D, FF, D, WB + W_DOWN + (size_t)l * D * FF, nullptr, 0, 0, r % I_DOWN, nullptr}; }
    };
    if (gw < NITEMS) {
        TItem cur = decode(gw); float v[32]; transpose_load(cur, lane, v);
        for (int it = gw; it < NITEMS; it += NGW) {
            const int nit = it + NGW < NITEMS ? it + NGW : it;
            const TItem nx = decode(nit); float vn[32]; transpose_load(nx, lane, vn);
            transpose_finish(cur, scr, lane, v);
            cur = nx;
#pragma unroll
            for (int i = 0; i < 32; ++i) v[i] = vn[i];
        }
    }
    float* rcos = (float*)(p.ws + WS_RCOS); float* rsin = (float*)(p.ws + WS_RSIN); float* acos_ = (float*)(p.ws + WS_ACOS); float* asin_ = (float*)(p.ws + WS_ASIN);
    const int gt = bid * 512 + tid, NGT = G * 512;
    for (int i = gt; i < 2048 * 128; i += NGT) { const int pos = i >> 7, j = i & 127;
        const float inv = (float)(1.0 / pow(10000.0, (double)j / 127.0)); const float ang = (float)pos * inv;
        rcos[i] = (float)cos((double)ang); rsin[i] = (float)sin((double)ang); }
    for (int i = gt; i < 2048 * 8; i += NGT) { const int pos = i >> 3, j = i & 7;
        const float inv = (float)pow(500000.0, -(double)(2 * j) / 16.0); const float ang = (float)pos * inv;
        acos_[i] = (float)cos((double)ang); asin_[i] = (float)sin((double)ang); }
    bf16* XB = (bf16*)(p.ws + WS_XB); float* RS = (float*)(p.ws + WS_RS); float* SA = (float*)(p.ws + WS_SA); unsigned char* A8 = p.ws + WS_MB;
    f32x4 v[4];
#pragma unroll
    for (int j = 0; j < 4; ++j) v[j] = ((const f32x4*)(p.x + (size_t)gw * D) + lane)[64 * j];
    for (int m = gw; m < M_ALL; m += NGW) {
        const int mn = m + NGW < M_ALL ? m + NGW : m;
        f32x4 vn[4];
#pragma unroll
        for (int j = 0; j < 4; ++j) vn[j] = ((const f32x4*)(p.x + (size_t)mn * D) + lane)[64 * j];
        float s = 0.f;
#pragma unroll
        for (int j = 0; j < 4; ++j) s += (v[j][0] * v[j][0] + v[j][1] * v[j][1]) + (v[j][2] * v[j][2] + v[j][3] * v[j][3]);
        s = wave_sum(s);
        v2u* o = (v2u*)(XB + (size_t)m * D) + lane;
#pragma unroll
        for (int j = 0; j < 4; ++j) { v2u w; w.x = pk2(v[j][0], v[j][1]); w.y = pk2(v[j][2], v[j][3]); o[64 * j] = w; }
        const float rn = 1.0f / sqrtf(s * (1.0f / D) + RMS_EPS);
        if (lane == 0) RS[m] = rn;
        float am = 0.f;
#pragma unroll
        for (int j = 0; j < 4; ++j) am = fmaxf(fmaxf(am, fmaxf(fabsf(v[j][0]), fabsf(v[j][1]))), fmaxf(fabsf(v[j][2]), fabsf(v[j][3])));
        am = wave_max(am);
        const float iv = am > 0.f ? 127.0f / am : 0.f;
        if (lane == 0) SA[m] = rn * am * (1.0f / 127.0f);
        unsigned* a8 = (unsigned*)(A8 + (size_t)m * D) + lane;
#pragma unroll
        for (int j = 0; j < 4; ++j) a8[64 * j] = pk4_i8(v[j][0] * iv, v[j][1] * iv, v[j][2] * iv, v[j][3] * iv);
#pragma unroll
        for (int j = 0; j < 4; ++j) v[j] = vn[j];
    }
}

__device__ __forceinline__ void thin_row(bf16* xrow, const bf16* mrow, float* rsp, float* orow, unsigned char* a8row, float* sap, const f32x4 (&g)[4], const v4u (&xv)[2], const v4u (&mv)[2], int lane) {
    float mf[16], xf[16]; float sm = 0.f;
#pragma unroll
    for (int j = 0; j < 2; ++j)
#pragma unroll
        for (int e = 0; e < 4; ++e) { mf[8 * j + 2 * e] = __uint_as_float(mv[j][e] << 16); mf[8 * j + 2 * e + 1] = __uint_as_float(mv[j][e] & 0xffff0000u);
            xf[8 * j + 2 * e] = __uint_as_float(xv[j][e] << 16); xf[8 * j + 2 * e + 1] = __uint_as_float(xv[j][e] & 0xffff0000u); }
#pragma unroll
    for (int e = 0; e < 16; ++e) sm += mf[e] * mf[e];
    const float r = 1.0f / sqrtf(wave_sum(sm) * (1.0f / D) + RMS_EPS);
    float s = 0.f; v4u wk[2];
#pragma unroll
    for (int j = 0; j < 2; ++j) { float y[8];
#pragma unroll
        for (int e = 0; e < 8; ++e) y[e] = xf[8 * j + e] + g[2 * j + (e >> 2)][e & 3] * r * mf[8 * j + e];
        v4u w; w.x = pk2(y[0], y[1]); w.y = pk2(y[2], y[3]); w.z = pk2(y[4], y[5]); w.w = pk2(y[6], y[7]);
        *((v4u*)(xrow + 512 * j) + lane) = w; wk[j] = w;
        if (orow) { __builtin_nontemporal_store((f32x4){y[0], y[1], y[2], y[3]}, (f32x4*)(orow + 512 * j) + 2 * lane); __builtin_nontemporal_store((f32x4){y[4], y[5], y[6], y[7]}, (f32x4*)(orow + 512 * j) + 2 * lane + 1); }
#pragma unroll
        for (int e = 0; e < 4; ++e) { const float a = __uint_as_float(w[e] << 16), b = __uint_as_float(w[e] & 0xffff0000u); s += a * a + b * b; } }
    s = wave_sum(s);
    const float rn = 1.0f / sqrtf(s * (1.0f / D) + RMS_EPS);
    if (lane == 0) *rsp = rn;
    if (a8row) {
        float f[16]; float am = 0.f;
#pragma unroll
        for (int j = 0; j < 2; ++j)
#pragma unroll
            for (int e = 0; e < 4; ++e) { f[8 * j + 2 * e] = __uint_as_float(wk[j][e] << 16); f[8 * j + 2 * e + 1] = __uint_as_float(wk[j][e] & 0xffff0000u); }
#pragma unroll
        for (int e = 0; e < 16; ++e) am = fmaxf(am, fabsf(f[e]));
        am = wave_max(am);
        const float iv = am > 0.f ? 127.0f / am : 0.f;
        if (lane == 0) *sap = rn * am * (1.0f / 127.0f);
#pragma unroll
        for (int j = 0; j < 2; ++j) { v2u o; o.x = pk4_i8(f[8 * j] * iv, f[8 * j + 1] * iv, f[8 * j + 2] * iv, f[8 * j + 3] * iv); o.y = pk4_i8(f[8 * j + 4] * iv, f[8 * j + 5] * iv, f[8 * j + 6] * iv, f[8 * j + 7] * iv);
            *((v2u*)(a8row + 512 * j) + lane) = o; }
    }
}
__device__ __forceinline__ void ph_thin(const Params& p, int row0, int nrows, const bf16* MB, const float* gpost, float* outf, unsigned char* a8, bool a8perm  , int G, int bid, int wv) {
    const int tid = otid(wv), lane = tid & 63, wave = tid >> 6, gw = bid * 8 + wave, NGW = G * 8;
    bf16* XB = (bf16*)(p.ws + WS_XB) + (size_t)row0 * D;
    float* RS = (float*)(p.ws + WS_RS) + row0; float* SA = (float*)(p.ws + WS_SA) + row0;
    f32x4 g[4];
#pragma unroll
    for (int j = 0; j < 2; ++j) { g[2 * j] = ((const f32x4*)(gpost + 512 * j))[2 * lane]; g[2 * j + 1] = ((const f32x4*)(gpost + 512 * j))[2 * lane + 1]; }
    for (int m = gw; m < nrows; m += 2 * NGW) {
        const int m2 = m + NGW; const bool has2 = m2 < nrows; const int mb = has2 ? m2 : m;
        v4u xa[2], ma[2], xb[2], mbv[2];
#pragma unroll
        for (int j = 0; j < 2; ++j) { xa[j] = *((const v4u*)(XB + (size_t)m * D + 512 * j) + lane); ma[j] = *((const v4u*)(MB + (size_t)m * D + 512 * j) + lane);
            xb[j] = *((const v4u*)(XB + (size_t)mb * D + 512 * j) + lane); mbv[j] = *((const v4u*)(MB + (size_t)mb * D + 512 * j) + lane); }
        thin_row(XB + (size_t)m * D, MB + (size_t)m * D, RS + m, outf ? outf + (size_t)m * D : nullptr, a8 ? a8 + (size_t)(a8perm ? ((m & ~63) | ((m & 3) << 4) | ((m >> 2) & 15)) : m) * D : nullptr, SA + m, g, xa, ma, lane);
        if (has2) thin_row(XB + (size_t)m2 * D, MB + (size_t)m2 * D, RS + m2, outf ? outf + (size_t)m2 * D : nullptr, a8 ? a8 + (size_t)(a8perm ? ((m2 & ~63) | ((m2 & 3) << 4) | ((m2 >> 2) & 15)) : m2) * D : nullptr, SA + m2, g, xb, mbv, lane);
    }
}
__device__ __forceinline__ void conv_fix_local(const Params& p, int layer, bf16* H, int nrows, int G, int bid, int wv) {
    const int tid = otid(wv);
    const float* halo = (const float*)(p.ws + WS_HALO);
    const float* cw = p.conv_w + (size_t)layer * 3 * FF; const float* cb = p.conv_b + (size_t)layer * FF; const float* sw = (const float*)(p.ws + WS_WSC) + layer * 2 * FF;
    pg8::StaticOrder S; S.init(nrows, D, G, bid); pg8::Unit u;
    for (int i = 0; S.next(i, u); ++i) {
        const int pm = u.pm; if ((pm & 7) == 0) continue;
        float ov[11];
#pragma unroll
        for (int q = 0; q < 11; ++q) { const int e = tid + 512 * q; const int j = e >= FF ? 1 : 0, f = e - j * FF, pn = f >> 7, c = f & 127;
            const float* cur = halo + ((size_t)pm * 22 + pn) * 768; const float* prv = halo + ((size_t)(pm - 1) * 22 + pn) * 768;
            const float g0 = cur[(2 + j) * 128 + c], gm1 = j ? cur[2 * 128 + c] : prv[128 + c], gm2 = j ? prv[128 + c] : prv[c], v = cur[(4 + j) * 128 + c];
            const float cv = cb[f] + sw[f] * (cw[f] * gm2 + cw[FF + f] * gm1 + cw[2 * FF + f] * g0);
            ov[q] = pg8::gelu_tanh_mul(cv, v * sw[FF + f]); }
#pragma unroll
        for (int q = 0; q < 11; ++q) { const int e = tid + 512 * q; const int j = e >= FF ? 1 : 0, f = e - j * FF; H[(size_t)(pm * 256 + j) * FF + f] = (bf16)f2bf(ov[q]); }
    }
    asm volatile("s_waitcnt vmcnt(0)" ::: "memory"); __syncthreads();
}

__device__ __forceinline__ void ph_gn_stats(const Params& p, int G, int bid, int wv) {
    const int tid = otid(wv), lane = tid & 63, wave = tid >> 6, gw = bid * 8 + wave, NGW = G * 8;
    const bf16* Y = (const bf16*)p.out; float* GS = (float*)(p.ws + WS_GS);
    for (int row = gw; row < M_ALL; row += NGW) {
        v4u yv[4];
#pragma unroll
        for (int hd = 0; hd < 4; ++hd) yv[hd] = *((const v4u*)(Y + (size_t)row * 2048 + hd * 512) + lane);
        float mu4[4], rs4[4];
#pragma unroll
        for (int hd = 0; hd < 4; ++hd) {
            float y[8];
#pragma unroll
            for (int e = 0; e < 4; ++e) { y[2 * e] = __uint_as_float(yv[hd][e] << 16); y[2 * e + 1] = __uint_as_float(yv[hd][e] & 0xffff0000u); }
            float s = 0.f;
#pragma unroll
            for (int e = 0; e < 8; ++e) s += y[e];
            const float mu = wave_sum(s) * (1.0f / 512.0f); float q = 0.f;
#pragma unroll
            for (int e = 0; e < 8; ++e) { const float d = y[e] - mu; q += d * d; }
            mu4[hd] = mu; rs4[hd] = 1.0f / sqrtf(wave_sum(q) * (1.0f / 512.0f) + GN_EPS);
        }
        if (lane == 0) { *(f32x4*)(GS + (size_t)row * 8) = (f32x4){mu4[0], rs4[0], mu4[1], rs4[1]}; *(f32x4*)(GS + (size_t)row * 8 + 4) = (f32x4){mu4[2], rs4[2], mu4[3], rs4[3]}; }
    }
}

typedef float f32x16 __attribute__((ext_vector_type(16)));
typedef short s16x8 __attribute__((ext_vector_type(8)));
typedef float af2 __attribute__((ext_vector_type(2)));
constexpr float RESCALE_THR = 8.0f;
typedef short s16x4 __attribute__((ext_vector_type(4)));
__device__ __forceinline__ int vt_off(int row, int ch) { return 1024 * (row >> 3) + 512 * (ch >> 2) + 64 * (row & 7) + 16 * ((ch & 3) ^ ((row >> 2) & 3)); }
__device__ __forceinline__ unsigned cvtpk(float lo, float hi) { return pg8::cvt_pk_bf16(lo, hi); }


template <int DIL>
__device__ __forceinline__ void attn_group(const s16x8 (&qf)[4], const bf16* kbase  , int qpos, int ntiles, int base, int n_inner, int step_inner, int step_outer, int n_win, int first_causal,
                                           f32x16& o0, f32x16& o1, float& m, float& lsum, LAS unsigned char* vbuf, int lane,
                                           v4u (&kc)[4], v4u (&vc)[4]  , const bf16* nsrc  ) {
    const int r32 = lane & 31, hi = lane >> 5;
    constexpr float C2 = 0.125f * 1.4426950408889634f;
    const int vrow = lane >> 3, vch = lane & 7;
    int woff[4];
#pragma unroll
    for (int i = 0; i < 4; ++i) woff[i] = vt_off(vrow + 8 * i, vch);
    const int g1 = (lane >> 4) & 1, q4 = (lane >> 2) & 3, pp = lane & 3;
    int ca = 0, cj = 0, kp_cur = base;
    for (int u = 0; u < ntiles; ++u) {
        const int kp0 = kp_cur, cj_cur = cj;
        int nj = cj + 1, na = ca; if (nj == n_inner) { nj = 0; na = ca + 1; }
        const bool more = u + 1 < ntiles; const int kpn = more ? base + na * step_outer + nj * step_inner : kp0;
        ca = na; cj = nj; kp_cur = kpn;
        LAS unsigned char* kb = vbuf; LAS unsigned char* vb = kb + 4096;
#pragma unroll
        for (int i = 0; i < 4; ++i) { *(LAS v4u*)(kb + woff[i]) = kc[i]; *(LAS v4u*)(vb + woff[i]) = vc[i]; }
        asm volatile("s_waitcnt lgkmcnt(0)" ::: "memory"); __builtin_amdgcn_wave_barrier();
        const int sln = DIL == 1 ? kpn : (DIL == 4 ? (((kpn & 3) << 9) | (kpn >> 2)) : (((kpn & 15) << 7) | (kpn >> 4)));
        const bf16* nb = more ? kbase + (size_t)sln * 64 : nsrc;
#pragma unroll
        for (int i = 0; i < 4; ++i) { const bf16* src = nb + (vrow + 8 * i) * 64 + 8 * vch; kc[i] = *(const v4u*)src; vc[i] = *(const v4u*)(src + 131072); }
        f32x16 S;
#pragma unroll
        for (int r = 0; r < 16; ++r) S[r] = 0.f;
#pragma unroll
        for (int s = 0; s < 4; ++s) { const s16x8 kf = *(LAS s16x8*)(kb + vt_off(r32, 2 * s + hi)); S = __builtin_amdgcn_mfma_f32_32x32x16_bf16(kf, qf[s], S, 0, 0, 0); }
        const bool t_causal = (DIL == 16) ? (cj_cur == n_inner - 1) : (u >= first_causal);
        const int dbase = qpos - kp0 - 4 * hi * DIL;
        constexpr bool lv = true;
        if (t_causal) { const int a = (DIL == 16) ? (lv ? dbase : -1) : dbase;
#pragma unroll
            for (int r = 0; r < 16; ++r) { const int kr = ((r & 3) + 8 * (r >> 2)) * DIL; S[r] = (kr <= a) ? S[r] : -INFINITY; }
        } else if (u < n_win) { const int bw = dbase - 128 * DIL;
#pragma unroll
            for (int r = 0; r < 16; ++r) { const int kr = ((r & 3) + 8 * (r >> 2)) * DIL; S[r] = (kr >= bw) ? S[r] : -INFINITY; }
        }
        float tmax = S[0];
#pragma unroll
        for (int r = 1; r < 16; ++r) tmax = fmaxf(tmax, S[r]);
        const bool pmask = (DIL == 16) && !t_causal;
        if (pmask) tmax = lv ? tmax : -INFINITY;
        tmax = xmax32(tmax);
        const float mnew = fmaxf(m, tmax * C2);
        if (__builtin_amdgcn_ballot_w64(mnew > m + RESCALE_THR) != 0) {
            const float alpha = __builtin_amdgcn_exp2f(m - mnew); m = mnew; lsum *= alpha;
#pragma unroll
            for (int r = 0; r < 16; ++r) { o0[r] *= alpha; o1[r] *= alpha; }
        }
        float ps;
        { af2 ps2 = {0.f, 0.f}; const af2 c2 = {C2, C2}, nm = {-m, -m};
#pragma unroll
          for (int r = 0; r < 16; r += 2) { const af2 a = (af2){S[r], S[r + 1]} * c2 + nm; af2 ev; ev.x = __builtin_amdgcn_exp2f(a.x); ev.y = __builtin_amdgcn_exp2f(a.y); S[r] = ev.x; S[r + 1] = ev.y; ps2 += ev; }
          ps = ps2.x + ps2.y; }
        if (pmask) ps = lv ? ps : 0.f;
        lsum += ps;
        s16x8 pb[2];
#pragma unroll
        for (int s = 0; s < 2; ++s) { v4u w; w.x = cvtpk(S[8 * s + 0], S[8 * s + 1]); w.y = cvtpk(S[8 * s + 2], S[8 * s + 3]); w.z = cvtpk(S[8 * s + 4], S[8 * s + 5]); w.w = cvtpk(S[8 * s + 6], S[8 * s + 7]);
            if (pmask) { const unsigned lm = lv ? 0xffffffffu : 0u; w.x &= lm; w.y &= lm; w.z &= lm; w.w &= lm; }
            pb[s] = __builtin_bit_cast(s16x8, w); }
#pragma unroll
        for (int dt = 0; dt < 2; ++dt)
#pragma unroll
            for (int s = 0; s < 2; ++s) {
                s16x4 lo = __builtin_amdgcn_ds_read_tr16_b64_v4i16((LAS s16x4*)(vb + vt_off(16 * s + 4 * hi + q4, 4 * dt + 2 * g1 + (pp >> 1)) + 8 * (pp & 1)));
                s16x4 hi4 = __builtin_amdgcn_ds_read_tr16_b64_v4i16((LAS s16x4*)(vb + vt_off(16 * s + 8 + 4 * hi + q4, 4 * dt + 2 * g1 + (pp >> 1)) + 8 * (pp & 1)));
                const s16x8 va = (s16x8){lo[0], lo[1], lo[2], lo[3], hi4[0], hi4[1], hi4[2], hi4[3]};
                if (dt == 0) o0 = __builtin_amdgcn_mfma_f32_32x32x16_bf16(va, pb[s], o0, 0, 0, 0);
                else o1 = __builtin_amdgcn_mfma_f32_32x32x16_bf16(va, pb[s], o1, 0, 0, 0);
            }
    }
    asm volatile("s_waitcnt lgkmcnt(0)" ::: "memory"); __builtin_amdgcn_wave_barrier();
}
__device__ __forceinline__ void attn_pair0(const s16x8 (&qa)[4], const s16x8 (&qb)[4], const bf16* kbase, int qposA, int ntiles, int base, int n_win, bool rot  ,
                                           f32x16& a0, f32x16& a1, float& ma, float& la, f32x16& b0, f32x16& b1, float& mb, float& lb,
                                           LAS unsigned char* vbuf, int lane, v4u (&kc)[4], v4u (&vc)[4], const bf16* nsrc) {
    const int r32 = lane & 31, hi = lane >> 5;
    constexpr float C2 = 0.125f * 1.4426950408889634f;
    const int vrow = lane >> 3, vch = lane & 7;
    int woff[4];
#pragma unroll
    for (int i = 0; i < 4; ++i) woff[i] = vt_off(vrow + 8 * i, vch);
    const int g1 = (lane >> 4) & 1, q4 = (lane >> 2) & 3, pp = lane & 3;
    for (int v = 0; v < ntiles; ++v) {
        const int u = rot ? ((v + 4) & 7) : v, un = rot ? ((v + 5) & 7) : v + 1;
        const int kp0 = base + 32 * u; const bool more = v + 1 < ntiles;
        LAS unsigned char* kb = vbuf; LAS unsigned char* vb = kb + 4096;
#pragma unroll
        for (int i = 0; i < 4; ++i) { *(LAS v4u*)(kb + woff[i]) = kc[i]; *(LAS v4u*)(vb + woff[i]) = vc[i]; }
        asm volatile("s_waitcnt lgkmcnt(0)" ::: "memory"); __builtin_amdgcn_wave_barrier();
        const bf16* nb = more ? kbase + (size_t)(base + 32 * un) * 64 : nsrc;
#pragma unroll
        for (int i = 0; i < 4; ++i) { const bf16* src = nb + (vrow + 8 * i) * 64 + 8 * vch; kc[i] = *(const v4u*)src; vc[i] = *(const v4u*)(src + 131072); }
        f32x16 SA, SB;
#pragma unroll
        for (int r = 0; r < 16; ++r) { SA[r] = 0.f; SB[r] = 0.f; }
#pragma unroll
        for (int s = 0; s < 4; ++s) { const s16x8 kf = *(LAS s16x8*)(kb + vt_off(r32, 2 * s + hi));
            SA = __builtin_amdgcn_mfma_f32_32x32x16_bf16(kf, qa[s], SA, 0, 0, 0); SB = __builtin_amdgcn_mfma_f32_32x32x16_bf16(kf, qb[s], SB, 0, 0, 0); }
        const int dA = qposA - kp0 - 4 * hi;
        if (u >= n_win) {
#pragma unroll
            for (int r = 0; r < 16; ++r) { const int kr = (r & 3) + 8 * (r >> 2); SA[r] = (kr <= dA) ? SA[r] : -INFINITY; SB[r] = (kr <= dA + 1) ? SB[r] : -INFINITY; }
        } else { const int bw = dA - 128;
#pragma unroll
            for (int r = 0; r < 16; ++r) { const int kr = (r & 3) + 8 * (r >> 2); SA[r] = (kr >= bw) ? SA[r] : -INFINITY; SB[r] = (kr >= bw + 1) ? SB[r] : -INFINITY; }
        }
        float tA = SA[0], tB = SB[0];
#pragma unroll
        for (int r = 1; r < 16; ++r) { tA = fmaxf(tA, SA[r]); tB = fmaxf(tB, SB[r]); }
        tA = xmax32(tA); tB = xmax32(tB);
        const float mnA = fmaxf(ma, tA * C2), mnB = fmaxf(mb, tB * C2);
        if (__builtin_amdgcn_ballot_w64((mnA > ma + RESCALE_THR) | (mnB > mb + RESCALE_THR)) != 0) {
            const float alA = __builtin_amdgcn_exp2f(ma - mnA), alB = __builtin_amdgcn_exp2f(mb - mnB); ma = mnA; mb = mnB; la *= alA; lb *= alB;
#pragma unroll
            for (int r = 0; r < 16; ++r) { a0[r] *= alA; a1[r] *= alA; b0[r] *= alB; b1[r] *= alB; }
        }
        float psA, psB;
        { af2 pa2 = {0.f, 0.f}, pb2 = {0.f, 0.f}; const af2 c2 = {C2, C2}, nma = {-ma, -ma}, nmb = {-mb, -mb};
#pragma unroll
          for (int r = 0; r < 16; r += 2) {
              const af2 xa = (af2){SA[r], SA[r + 1]} * c2 + nma; af2 ea; ea.x = __builtin_amdgcn_exp2f(xa.x); ea.y = __builtin_amdgcn_exp2f(xa.y); SA[r] = ea.x; SA[r + 1] = ea.y; pa2 += ea;
              const af2 xb = (af2){SB[r], SB[r + 1]} * c2 + nmb; af2 eb; eb.x = __builtin_amdgcn_exp2f(xb.x); eb.y = __builtin_amdgcn_exp2f(xb.y); SB[r] = eb.x; SB[r + 1] = eb.y; pb2 += eb; }
          psA = pa2.x + pa2.y; psB = pb2.x + pb2.y; }
        la += psA; lb += psB;
        s16x8 pa[2], pb[2];
#pragma unroll
        for (int s = 0; s < 2; ++s) { v4u w; w.x = cvtpk(SA[8 * s + 0], SA[8 * s + 1]); w.y = cvtpk(SA[8 * s + 2], SA[8 * s + 3]); w.z = cvtpk(SA[8 * s + 4], SA[8 * s + 5]); w.w = cvtpk(SA[8 * s + 6], SA[8 * s + 7]); pa[s] = __builtin_bit_cast(s16x8, w);
            v4u x; x.x = cvtpk(SB[8 * s + 0], SB[8 * s + 1]); x.y = cvtpk(SB[8 * s + 2], SB[8 * s + 3]); x.z = cvtpk(SB[8 * s + 4], SB[8 * s + 5]); x.w = cvtpk(SB[8 * s + 6], SB[8 * s + 7]); pb[s] = __builtin_bit_cast(s16x8, x); }
#pragma unroll
        for (int dt = 0; dt < 2; ++dt)
#pragma unroll
            for (int s = 0; s < 2; ++s) {
                s16x4 lo = __builtin_amdgcn_ds_read_tr16_b64_v4i16((LAS s16x4*)(vb + vt_off(16 * s + 4 * hi + q4, 4 * dt + 2 * g1 + (pp >> 1)) + 8 * (pp & 1)));
                s16x4 hi4 = __builtin_amdgcn_ds_read_tr16_b64_v4i16((LAS s16x4*)(vb + vt_off(16 * s + 8 + 4 * hi + q4, 4 * dt + 2 * g1 + (pp >> 1)) + 8 * (pp & 1)));
                const s16x8 va = (s16x8){lo[0], lo[1], lo[2], lo[3], hi4[0], hi4[1], hi4[2], hi4[3]};
                if (dt == 0) { a0 = __builtin_amdgcn_mfma_f32_32x32x16_bf16(va, pa[s], a0, 0, 0, 0); b0 = __builtin_amdgcn_mfma_f32_32x32x16_bf16(va, pb[s], b0, 0, 0, 0); }
                else { a1 = __builtin_amdgcn_mfma_f32_32x32x16_bf16(va, pa[s], a1, 0, 0, 0); b1 = __builtin_amdgcn_mfma_f32_32x32x16_bf16(va, pb[s], b1, 0, 0, 0); }
            }
    }
    asm volatile("s_waitcnt lgkmcnt(0)" ::: "memory"); __builtin_amdgcn_wave_barrier();
}
__device__ __forceinline__ void tile_first(const bf16* krows, v4u (&kc)[4], v4u (&vc)[4], int lane) {
    const int vrow = lane >> 3, vch = lane & 7;
#pragma unroll
    for (int i = 0; i < 4; ++i) { const bf16* src = krows + (vrow + 8 * i) * 64 + 8 * vch; kc[i] = *(const v4u*)src; vc[i] = *(const v4u*)(src + 131072); }
}

__device__ __forceinline__ void ph_attn_g2(const Params& p, LAS unsigned char* lds, int G, int bid, int wv) {
    const int tid = otid(wv), lane = tid & 63, wave = __builtin_amdgcn_readfirstlane(tid >> 6);
    const int r32 = lane & 31, hi = lane >> 5;
    const bf16* Qb = (const bf16*)(p.ws + WS_Q); const bf16* KV = (const bf16*)(p.ws + WS_BIG); bf16* O2 = (bf16*)((unsigned char*)p.out + 192 * MiB); float* ML = (float*)(p.ws + WS_GS);
    LAS unsigned char* vbuf = lds + wave * 16384;
    const int vcu = (bid & 7) * (G >> 3) + (bid >> 3);
    const int NW = G * 8, gw = vcu * 8 + wave;
    v4u kc[4], vc[4];
    s16x8 qf[4];
    { const int x = gw >> 2, r16 = x & 15, bh = x >> 4, t0 = gw & 3; tile_first(KV + ((size_t)((bh >> 4) * 48 + 32 + (bh & 15)) * 2 * 2048 + r16 * 128) * 64, kc, vc, lane);
      const bf16* q0 = Qb + ((size_t)((bh >> 4) * 48 + 32 + (bh & 15)) * 2048 + r16 * 128 + 32 * t0 + r32) * 64 + 8 * hi;
#pragma unroll
      for (int s = 0; s < 4; ++s) qf[s] = *(const s16x8*)(q0 + 16 * s); }
    for (int T = gw, k = 0; T < 16 * 16 * 16 * 4; T += NW, ++k) {
        const int traw = T & 3, t = (k & 1) ? 3 - traw : traw, x = T >> 2, r16 = x & 15, bh = x >> 4, h = bh & 15, b = bh >> 4;
        const int bhn = (T + NW < 16 * 16 * 16 * 4) ? bh + (NW >> 6) : bh;
        const bf16* nsrc = KV + ((size_t)((bhn >> 4) * 48 + 32 + (bhn & 15)) * 2 * 2048 + r16 * 128) * 64;
        const int qpos = r16 + 16 * (32 * t + r32); const size_t brow = (size_t)b * SEQ;
        f32x16 o0, o1;
#pragma unroll
        for (int r = 0; r < 16; ++r) { o0[r] = 0.f; o1[r] = 0.f; }
        float m = -1.0e30f, lsum = 0.f;
        const bf16* kb = KV + (size_t)(b * 48 + 32 + h) * 2 * 131072;
        const int tn = (T + NW < 16 * 16 * 16 * 4) ? 3 - t : t;
        const bf16* qn = Qb + ((size_t)((bhn >> 4) * 48 + 32 + (bhn & 15)) * 2048 + r16 * 128 + 32 * tn + r32) * 64 + 8 * hi;
        s16x8 qfn[4];
#pragma unroll
        for (int s = 0; s < 4; ++s) qfn[s] = *(const s16x8*)(qn + 16 * s);
        attn_group<16>(qf, kb, qpos, t + 1, r16, t + 1, 512, 0, 0, 0, o0, o1, m, lsum, vbuf, lane, kc, vc, nsrc);
        const float l = xsum32(lsum);
        bf16* orow = O2 + ((size_t)bh * 2048 + r16 * 128 + 32 * t + r32) * 64 + 4 * hi;
#pragma unroll
        for (int rg = 0; rg < 4; ++rg) {
            v2u w0; w0.x = cvtpk(o0[4 * rg], o0[4 * rg + 1]); w0.y = cvtpk(o0[4 * rg + 2], o0[4 * rg + 3]); *(v2u*)(orow + 8 * rg) = w0;
            v2u w1; w1.x = cvtpk(o1[4 * rg], o1[4 * rg + 1]); w1.y = cvtpk(o1[4 * rg + 2], o1[4 * rg + 3]); *(v2u*)(orow + 32 + 8 * rg) = w1;
        }
        if (hi == 0) { float* ml = ML + ((size_t)((bh * 16 + r16) * 128 + 32 * t + r32)) * 2; v2u w; w.x = __float_as_uint(m); w.y = __float_as_uint(l); *(v2u*)ml = w; }
#pragma unroll
        for (int s = 0; s < 4; ++s) qf[s] = qfn[s];
    }
}
__device__ __forceinline__ void y_state(const bf16* o2, const float* ml, int hi, f32x16& o0, f32x16& o1, float& m, float& l) {
#pragma unroll
    for (int rg = 0; rg < 4; ++rg) { const v2u w0 = *(const v2u*)(o2 + 8 * rg), w1 = *(const v2u*)(o2 + 32 + 8 * rg);
        o0[4 * rg] = __uint_as_float(w0.x << 16); o0[4 * rg + 1] = __uint_as_float(w0.x & 0xffff0000u); o0[4 * rg + 2] = __uint_as_float(w0.y << 16); o0[4 * rg + 3] = __uint_as_float(w0.y & 0xffff0000u);
        o1[4 * rg] = __uint_as_float(w1.x << 16); o1[4 * rg + 1] = __uint_as_float(w1.x & 0xffff0000u); o1[4 * rg + 2] = __uint_as_float(w1.y << 16); o1[4 * rg + 3] = __uint_as_float(w1.y & 0xffff0000u); }
    const v2u mlv = *(const v2u*)ml; m = __uint_as_float(mlv.x); l = hi == 0 ? __uint_as_float(mlv.y) : 0.f;
}
__device__ __forceinline__ void y_store(bf16* orow0  , int hi, const f32x16& o0, const f32x16& o1, float lsum) {
    const float l = xsum32(lsum); const float inv = 1.0f / l;
#pragma unroll
    for (int pr2 = 0; pr2 < 2; ++pr2) {
        { const unsigned ax = cvtpk(o0[8 * pr2] * inv, o0[8 * pr2 + 1] * inv), ay = cvtpk(o0[8 * pr2 + 2] * inv, o0[8 * pr2 + 3] * inv), bx = cvtpk(o0[8 * pr2 + 4] * inv, o0[8 * pr2 + 5] * inv), by = cvtpk(o0[8 * pr2 + 6] * inv, o0[8 * pr2 + 7] * inv);
          auto sx = __builtin_amdgcn_permlane32_swap(ax, bx, false, false); auto sy = __builtin_amdgcn_permlane32_swap(ay, by, false, false);
          v4u w; w.x = sx[0]; w.y = sy[0]; w.z = sx[1]; w.w = sy[1]; *(v4u*)(orow0 + 16 * pr2 + 8 * hi) = w; }
        { const unsigned ax = cvtpk(o1[8 * pr2] * inv, o1[8 * pr2 + 1] * inv), ay = cvtpk(o1[8 * pr2 + 2] * inv, o1[8 * pr2 + 3] * inv), bx = cvtpk(o1[8 * pr2 + 4] * inv, o1[8 * pr2 + 5] * inv), by = cvtpk(o1[8 * pr2 + 6] * inv, o1[8 * pr2 + 7] * inv);
          auto sx = __builtin_amdgcn_permlane32_swap(ax, bx, false, false); auto sy = __builtin_amdgcn_permlane32_swap(ay, by, false, false);
          v4u w; w.x = sx[0]; w.y = sy[0]; w.z = sx[1]; w.w = sy[1]; *(v4u*)(orow0 + 32 + 16 * pr2 + 8 * hi) = w; }
    }
}
constexpr int HO_O2 = 65536, HO_ML = 132096;
__device__ __forceinline__ void y_state_lds(const LAS unsigned char* o2, int sw7  , const LAS unsigned char* ml, int hi, f32x16& o0, f32x16& o1, float& m, float& l) {
#pragma unroll
    for (int rg = 0; rg < 4; ++rg) { const v2u w0 = *(const LAS v2u*)(o2 + 16 * (rg ^ sw7)), w1 = *(const LAS v2u*)(o2 + 16 * ((4 + rg) ^ sw7));
        o0[4 * rg] = __uint_as_float(w0.x << 16); o0[4 * rg + 1] = __uint_as_float(w0.x & 0xffff0000u); o0[4 * rg + 2] = __uint_as_float(w0.y << 16); o0[4 * rg + 3] = __uint_as_float(w0.y & 0xffff0000u);
        o1[4 * rg] = __uint_as_float(w1.x << 16); o1[4 * rg + 1] = __uint_as_float(w1.x & 0xffff0000u); o1[4 * rg + 2] = __uint_as_float(w1.y << 16); o1[4 * rg + 3] = __uint_as_float(w1.y & 0xffff0000u); }
    const v2u mlv = *(const LAS v2u*)ml; m = __uint_as_float(mlv.x); l = hi == 0 ? __uint_as_float(mlv.y) : 0.f;
}
__device__ __forceinline__ void ph_attn_xy(const Params& p, LAS unsigned char* lds, int G, int bid, int wv) {
    const int tid = otid(wv), lane = tid & 63, wave = __builtin_amdgcn_readfirstlane(tid >> 6);
    const int r32 = lane & 31, hi = lane >> 5;
    const bf16* Qb = (const bf16*)(p.ws + WS_Q); const bf16* KV = (const bf16*)(p.ws + WS_BIG); bf16* O = (bf16*)(p.ws + WS_O); bf16* O2 = (bf16*)((unsigned char*)p.out + 192 * MiB); float* ML = (float*)(p.ws + WS_GS);
    LAS unsigned char* vbuf = lds + wave * 8192;
    const int vcu = (bid & 7) * (G >> 3) + (bid >> 3);
    const int NW = G * 8, gw = vcu * 8 + wave;
    constexpr int NT = 16 * 16 * 16 * 2;
    v4u kc[4], vc[4];
    { const int bh = (gw >> 1) >> 4; tile_first(KV + ((size_t)((bh >> 4) * 48 + 32 + (bh & 15)) * 2 * 2048 + wave * 128) * 64, kc, vc, lane); }
    for (int T = gw, k = 0; T < NT; T += NW, ++k) {
        const int pr = T & 1, x = T >> 1, craw = x & 15, bh = x >> 4, c = (k & 1) ? 15 - craw : craw, h = bh & 15, b = bh >> 4;
        const int jq = c >> 2;
        const bf16* kb = KV + (size_t)(b * 48 + h) * 2 * 131072; const bf16* kb1 = kb + (size_t)16 * 2 * 131072; const bf16* kb2 = kb + (size_t)32 * 2 * 131072;
        const int j0 = (c == 0) ? 4 : 0, j1 = (4 - c) > 0 ? (4 - c) : 0;
        for (int xi = 0; xi < 2; ++xi) {
            const int r16 = wave + 8 * xi, qpos = r16 + 16 * (32 * jq + r32);
            const bf16* qrow = Qb + ((size_t)(b * 48 + 32 + h) * 2048 + r16 * 128 + 32 * jq + r32) * 64 + 8 * hi;
            s16x8 qf[4];
#pragma unroll
            for (int s = 0; s < 4; ++s) qf[s] = *(const s16x8*)(qrow + 16 * s);
            f32x16 o0, o1;
#pragma unroll
            for (int r = 0; r < 16; ++r) { o0[r] = 0.f; o1[r] = 0.f; }
            float m = -1.0e30f, lsum = 0.f;
            const bf16* nsrc = xi == 0 ? kb2 + (size_t)((wave + 8) * 128) * 64 : kb + (size_t)((c & 1) ? 128 * c : 128 * c - 128 + 32 * j0) * 64;
            attn_group<16>(qf, kb2, qpos, jq + 1, r16, jq + 1, 512, 0, 0, 0, o0, o1, m, lsum, vbuf, lane, kc, vc, nsrc);
            const float l = xsum32(lsum);
            LAS unsigned char* orow = lds + HO_O2 + (r16 * 32 + r32) * 128 + 8 * hi; const int sw7 = r32 & 7;
#pragma unroll
            for (int rg = 0; rg < 4; ++rg) {
                v2u w0; w0.x = cvtpk(o0[4 * rg], o0[4 * rg + 1]); w0.y = cvtpk(o0[4 * rg + 2], o0[4 * rg + 3]); *(LAS v2u*)(orow + 16 * (rg ^ sw7)) = w0;
                v2u w1; w1.x = cvtpk(o1[4 * rg], o1[4 * rg + 1]); w1.y = cvtpk(o1[4 * rg + 2], o1[4 * rg + 3]); *(LAS v2u*)(orow + 16 * ((4 + rg) ^ sw7)) = w1;
            }
            if (hi == 0) { v2u w; w.x = __float_as_uint(m); w.y = __float_as_uint(l); *(LAS v2u*)(lds + HO_ML + (r16 * 32 + r32) * 8) = w; }
        }
        asm volatile("s_waitcnt lgkmcnt(0)" ::: "memory"); __syncthreads();
        const bool hasn = T + NW < NT; const int bhn = hasn ? bh + (NW >> 5) : bh;
        const bf16* nsrc_task = KV + ((size_t)((bhn >> 4) * 48 + 32 + (bhn & 15)) * 2 * 2048 + wave * 128) * 64;
        const int qposA = 128 * c + 2 * pr + 4 * r32, qposB = qposA + 1; const size_t brow = (size_t)b * SEQ;
        const bf16* qrowA = Qb + ((size_t)(b * 48 + h) * 2048 + (2 * pr) * 512 + 32 * c + r32) * 64 + 8 * hi;
        s16x8 qa[4], qb[4], q1a[4], q1b[4];
#pragma unroll
        for (int s = 0; s < 4; ++s) { qa[s] = *(const s16x8*)(qrowA + 16 * s); qb[s] = *(const s16x8*)(qrowA + 512 * 64 + 16 * s); }
        f32x16 a0, a1, b0, b1; float ma, la, mb, lb;
        { const int rowA = (qposA & 15) * 32 + (qposA >> 4) - 32 * jq, rowB = (qposB & 15) * 32 + (qposB >> 4) - 32 * jq;
          y_state_lds(lds + HO_O2 + rowA * 128 + 8 * hi, rowA & 7, lds + HO_ML + rowA * 8, hi, a0, a1, ma, la);
          y_state_lds(lds + HO_O2 + rowB * 128 + 8 * hi, rowB & 7, lds + HO_ML + rowB * 8, hi, b0, b1, mb, lb); }
        asm volatile("s_waitcnt lgkmcnt(0)" ::: "memory"); __syncthreads();
        const int s1 = 32 * c - 128 + 32 * j1;
        attn_pair0(qa, qb, kb, qposA, 8 - j0, 128 * c - 128 + 32 * j0, 4 - j0, (c & 1) != 0, a0, a1, ma, la, b0, b1, mb, lb, vbuf, lane, kc, vc, kb1 + (size_t)((2 * pr) * 512 + s1) * 64);
#pragma unroll
        for (int s = 0; s < 4; ++s) { q1a[s] = *(const s16x8*)(qrowA + (size_t)16 * 131072 + 16 * s); q1b[s] = *(const s16x8*)(qrowA + (size_t)16 * 131072 + 512 * 64 + 16 * s); }
        attn_group<4>(q1a, kb1, qposA, 5 - j1, 2 * pr + 4 * s1, 8, 128, 0, j1 == 0 ? 1 : 0, 4 - j1, a0, a1, ma, la, vbuf, lane, kc, vc, kb1 + (size_t)((2 * pr + 1) * 512 + s1) * 64);
        y_store(O + (brow + qposA) * D + h * 64, hi, a0, a1, la);
        attn_group<4>(q1b, kb1, qposB, 5 - j1, 2 * pr + 1 + 4 * s1, 8, 128, 0, j1 == 0 ? 1 : 0, 4 - j1, b0, b1, mb, lb, vbuf, lane, kc, vc, nsrc_task);
        y_store(O + (brow + qposB) * D + h * 64, hi, b0, b1, lb);
    }
}

__device__ __forceinline__ unsigned off_a(unsigned row, unsigned ch) { return 2048u * (row >> 3) + 512u * (ch >> 2) + 64u * (row & 7) + 16u * ((ch & 3) ^ ((row >> 2) & 3)); }
constexpr int RT_BUF = 49152, RT_Q = 0, RT_K = 16384, RT_V = 32768, RT_P0 = 98304, RT_P0SZ = 2048;

__device__ __forceinline__ void ret_stage(LAS unsigned char* lds, int buf, const bf16* rowbase  , const bf16* p0src  , int h, int dvh, int wave, int lane) {
    (void)p0src;
#pragma unroll
    for (int i = 0; i < 6; ++i) {
        const int idx = wave + 8 * i, img = idx >> 4, t = (idx >> 3) & 1, k = idx & 7;
        const int row = 8 * (k >> 1) + ((lane >> 2) & 7), chh = 2 * (k & 1) + (lane >> 5), ch = 4 * chh + ((lane & 3) ^ ((row >> 2) & 3));
        const int plane = img == 0 ? h : (img == 1 ? 4 + h : 8 + 2 * h + dvh);
        const bf16* src = rowbase + ((size_t)plane * 2048 + row) * 256 + 128 * t + 8 * ch;
        __builtin_amdgcn_global_load_lds((const unsigned*)src, (LAS unsigned*)(lds + buf * RT_BUF + img * 16384 + t * 8192 + k * 1024), 16, 0, 0);
    }
}
__device__ __forceinline__ void ph_ret_p0(const Params& p, int G, int bid, int wv) {
    const int tid = otid(wv), lane = tid & 63, wave = tid >> 6, r32 = lane & 31, hi = lane >> 5;
    const bf16* QKV = (const bf16*)(p.ws + WS_BIG); bf16* P0 = (bf16*)(p.ws + WS_P0);
    for (int t = bid * 8 + wave; t < NBATCH * 4 * 64; t += G * 8) {
        const int c = t & 63, h = (t >> 6) & 3, b = t >> 8;
        const bf16* qr = QKV + ((size_t)(b * 16 + h) * 2048 + c * 32 + r32) * 256 + 8 * hi;
        const bf16* kr = qr + (size_t)4 * 2048 * 256;
        f32x16 S;
#pragma unroll
        for (int r = 0; r < 16; ++r) S[r] = 0.f;
#pragma unroll
        for (int s = 0; s < 16; ++s) { const s16x8 a = *(const s16x8*)(kr + 16 * s), bq = *(const s16x8*)(qr + 16 * s); S = __builtin_amdgcn_mfma_f32_32x32x16_bf16(a, bq, S, 0, 0, 0); }
        bf16* dst = P0 + (size_t)t * 1024 + r32 * 32;
#pragma unroll
        for (int rg = 0; rg < 4; ++rg) { float v[4];
#pragma unroll
            for (int e = 0; e < 4; ++e) { const int key = e + 8 * rg + 4 * hi; v[e] = key <= r32 ? S[4 * rg + e] : 0.f; }
            v2u w; w.x = cvtpk(v[0], v[1]); w.y = cvtpk(v[2], v[3]);
            *(v2u*)(dst + 8 * rg + 4 * hi) = w; }
    }
}
__device__ __forceinline__ void ph_retention(const Params& p, LAS unsigned char* lds, int G, int bid, int wv) {
    const int tid = otid(wv), lane = tid & 63, wave = __builtin_amdgcn_readfirstlane(tid >> 6), r32 = lane & 31, hi = lane >> 5;
    const bf16* QKV = (const bf16*)(p.ws + WS_BIG); bf16* Y = (bf16*)p.out;
    const unsigned blk = (lane >> 4) & 1, q4 = (lane & 15) >> 2, pp = lane & 3;
    const unsigned xq = (r32 >> 2) & 3, lq = 2048u * (r32 >> 3) + 64u * (r32 & 7) + 8u * hi;
    const unsigned ltr = 2048u * hi + 64u * q4 + 8u * (pp & 1), ctr = 2u * blk + (pp >> 1);
    for (int ub = bid; ub < NBATCH * 8; ub += G) {
        const int unit = 16 * (ub >> 4) + 2 * (ub & 7) + ((ub >> 3) & 1);
        const int dvh = unit & 1, h = (unit >> 1) & 3, b = unit >> 3;
        const float lg = log2f(1.0f - exp2f(-5.0f - (float)h));
        const bf16* base = QKV + (size_t)b * 16 * 2048 * 256;
        bf16* ybase = Y + (size_t)b * SEQ * 2048 + h * 512 + dvh * 256 + wave * 32 + r32;
        f32x16 St[8];
#pragma unroll
        for (int kt = 0; kt < 8; ++kt)
#pragma unroll
            for (int r = 0; r < 16; ++r) St[kt][r] = 0.f;
        __syncthreads();
        const bf16* p0b = (const bf16*)(p.ws + WS_P0) + (size_t)((b * 4 + h) * 64) * 1024;
        ret_stage(lds, 0, base, p0b, h, dvh, wave, lane);
        asm volatile("s_waitcnt vmcnt(0) lgkmcnt(0)" ::: "memory");
        __syncthreads();
        for (int c = 0; c < SEQ / 32; ++c) {
            const int buf = c & 1;
            if (c + 1 < SEQ / 32) {
                ret_stage(lds, buf ^ 1, base + (size_t)(c + 1) * 32 * 256, p0b + (size_t)(c + 1) * 1024, h, dvh, wave, lane);
            }
            float lgc = lg; asm volatile("" : "+v"(lgc));
            LAS unsigned char* Lb = lds + buf * RT_BUF;
            LAS unsigned char* Lp = lds + RT_P0 + buf * RT_P0SZ + r32 * 64 + 16 * hi;
            LAS unsigned char* q0 = Lb + RT_Q + lq + 16u * (0u ^ xq); LAS unsigned char* q1 = Lb + RT_Q + lq + 16u * (1u ^ xq);
            LAS unsigned char* q2 = Lb + RT_Q + lq + 16u * (2u ^ xq); LAS unsigned char* q3 = Lb + RT_Q + lq + 16u * (3u ^ xq);
            LAS unsigned char* k0 = Lb + RT_K + ltr + 16u * (ctr ^ (2u * hi)); LAS unsigned char* k1 = Lb + RT_K + ltr + 16u * (ctr ^ (2u * hi + 1u));
            LAS unsigned char* v0 = Lb + RT_V + (wave >> 2) * 8192 + (wave & 3) * 512 + ltr + 16u * (ctr ^ (2u * hi)); LAS unsigned char* v1 = Lb + RT_V + (wave >> 2) * 8192 + (wave & 3) * 512 + ltr + 16u * (ctr ^ (2u * hi + 1u));
            s16x8 vf[2];
#pragma unroll
            for (int ks = 0; ks < 2; ++ks) {
                const s16x4 lo = __builtin_amdgcn_ds_read_tr16_b64_v4i16((LAS s16x4*)(v0 + 4096 * ks));
                const s16x4 h4 = __builtin_amdgcn_ds_read_tr16_b64_v4i16((LAS s16x4*)(v1 + 4096 * ks + 256));
                const float w0 = __builtin_amdgcn_exp2f(-(float)(32 * c + 16 * ks + 8 * hi + 1) * lgc), gi = __builtin_amdgcn_exp2f(-lgc);
                float f[8], w = w0;
#pragma unroll
                for (int e = 0; e < 4; ++e) { f[e] = bf2f((unsigned short)lo[e]); f[4 + e] = bf2f((unsigned short)h4[e]); }
#pragma unroll
                for (int j = 0; j < 8; ++j) { f[j] *= w; w *= gi; }
                v4u ww; ww.x = cvtpk(f[0], f[1]); ww.y = cvtpk(f[2], f[3]); ww.z = cvtpk(f[4], f[5]); ww.w = cvtpk(f[6], f[7]); vf[ks] = __builtin_bit_cast(s16x8, ww);
            }
            f32x16 T;
#pragma unroll
            for (int r = 0; r < 16; ++r) T[r] = 0.f;
            if (wave == (c & 7)) {
                constexpr int KQ = RT_K - RT_Q;
#pragma unroll
                for (int kt = 0; kt < 8; ++kt) { const int toff = (kt >> 2) * 8192 + (kt & 3) * 512;
#pragma unroll
                    for (int s = 0; s < 2; ++s) {
                        const v2u qa = *(LAS v2u*)((s ? q2 : q0) + toff), qb = *(LAS v2u*)((s ? q3 : q1) + toff), ka2 = *(LAS v2u*)((s ? q2 : q0) + KQ + toff), kb2 = *(LAS v2u*)((s ? q3 : q1) + KQ + toff);
                        v4u aw; aw.x = ka2.x; aw.y = ka2.y; aw.z = kb2.x; aw.w = kb2.y;
                        v4u bw; bw.x = qa.x; bw.y = qa.y; bw.z = qb.x; bw.w = qb.y;
                        T = __builtin_amdgcn_mfma_f32_32x32x16_bf16(__builtin_bit_cast(s16x8, aw), __builtin_bit_cast(s16x8, bw), T, 0, 0, 0); } }
                LAS unsigned char* Pw = lds + RT_P0 + buf * RT_P0SZ + r32 * 64;
#pragma unroll
                for (int rg = 0; rg < 4; ++rg) { float v[4];
#pragma unroll
                    for (int e = 0; e < 4; ++e) { const int key = e + 8 * rg + 4 * hi; v[e] = key <= r32 ? T[4 * rg + e] : 0.f; }
                    v2u w; w.x = cvtpk(v[0], v[1]); w.y = cvtpk(v[2], v[3]);
                    *(LAS v2u*)(Pw + (8 * rg + 4 * hi) * 2) = w; }
#pragma unroll
                for (int r = 0; r < 16; ++r) T[r] = 0.f;
            }
#pragma unroll
            for (int kt = 0; kt < 8; ++kt) {
                constexpr int dummy = 0; (void)dummy;
                const int toff = (kt >> 2) * 8192 + (kt & 3) * 512;
#pragma unroll
                for (int s = 0; s < 2; ++s) {
                    const v2u qa = *(LAS v2u*)((s ? q2 : q0) + toff), qb = *(LAS v2u*)((s ? q3 : q1) + toff);
                    v4u aw; aw.x = qa.x; aw.y = qa.y; aw.z = qb.x; aw.w = qb.y;
                    v4u bw; bw.x = cvtpk(St[kt][8 * s + 0], St[kt][8 * s + 1]); bw.y = cvtpk(St[kt][8 * s + 2], St[kt][8 * s + 3]); bw.z = cvtpk(St[kt][8 * s + 4], St[kt][8 * s + 5]); bw.w = cvtpk(St[kt][8 * s + 6], St[kt][8 * s + 7]);
                    T = __builtin_amdgcn_mfma_f32_32x32x16_bf16(__builtin_bit_cast(s16x8, aw), __builtin_bit_cast(s16x8, bw), T, 0, 0, 0);
                }
#pragma unroll
                for (int ks = 0; ks < 2; ++ks) {
                    const s16x4 lo = __builtin_amdgcn_ds_read_tr16_b64_v4i16((LAS s16x4*)(k0 + toff + 4096 * ks));
                    const s16x4 h4 = __builtin_amdgcn_ds_read_tr16_b64_v4i16((LAS s16x4*)(k1 + toff + 4096 * ks + 256));
                    const s16x8 ka = (s16x8){lo[0], lo[1], lo[2], lo[3], h4[0], h4[1], h4[2], h4[3]};
                    St[kt] = __builtin_amdgcn_mfma_f32_32x32x16_bf16(ka, vf[ks], St[kt], 0, 0, 0);
                }
            }
            asm volatile("s_waitcnt lgkmcnt(0)" ::: "memory"); __builtin_amdgcn_s_barrier(); asm volatile("" ::: "memory");
#pragma unroll
            for (int ks = 0; ks < 2; ++ks) { const s16x8 a = *(LAS s16x8*)(Lp + 32 * ks); T = __builtin_amdgcn_mfma_f32_32x32x16_bf16(a, vf[ks], T, 0, 0, 0); }
            bf16* yrow = ybase + (size_t)(c * 32) * 2048;
            const float g1 = __builtin_amdgcn_exp2f(lgc); float wq = __builtin_amdgcn_exp2f((float)(32 * c + 4 * hi + 1) * lgc);
#pragma unroll
            for (int rg = 0; rg < 4; ++rg) { float wr_ = wq;
#pragma unroll
                for (int e = 0; e < 4; e += 2) { const int q = e + 8 * rg + 4 * hi; const float w1_ = wr_ * g1; const unsigned pw = pk2(T[4 * rg + e] * wr_, T[4 * rg + e + 1] * w1_);
                    yrow[(size_t)q * 2048] = (bf16)(pw & 0xffffu); yrow[(size_t)(q + 1) * 2048] = (bf16)(pw >> 16); wr_ = w1_ * g1; }
                wq *= __builtin_amdgcn_exp2f(8.0f * lgc); }
            asm volatile("s_waitcnt vmcnt(16) lgkmcnt(0)" ::: "memory");
            __builtin_amdgcn_s_barrier(); asm volatile("" ::: "memory");
        }
        asm volatile("s_waitcnt vmcnt(0)" ::: "memory");
    }
}

constexpr int LDS_BYTES = 147456, LDSCTL_OFF = 131072, MISC_OFF = LDSCTL_OFF + 320, HALO_LDS = LDSCTL_OFF + 1024;
constexpr int CW_BAR = 4096;
__device__ __forceinline__ int opq(int v) { asm volatile("" : "+s"(v)); return v; }
__global__ void __launch_bounds__(512, 2) yoco_fwd(Params p) {
    extern __shared__ __attribute__((aligned(16))) unsigned char lds_raw[];
    LAS unsigned char* lds = (LAS unsigned char*)lds_raw;
    constexpr int G = 256; const int bid = blockIdx.x;
    const int wv = __builtin_amdgcn_readfirstlane((int)threadIdx.x >> 6);
    for (int u = otid(wv); u < 1024 / 4; u += 512) ((LAS unsigned*)(lds + LDSCTL_OFF))[u] = 0u;
    __syncthreads();
    XcdBarrier bar = xcd_barrier_post((unsigned*)(p.ws + WS_CTL) + CW_BAR, (volatile LAS unsigned*)(lds + MISC_OFF) + 8, wv);
#define GRID_BAR() do { XcdBarrier b_ = bar; asm volatile("" : "+s"(b_.x)); asm volatile("" : "+s"(b_.bar)); xcd_barrier(b_); } while (0)
    bf16* WB = (bf16*)(p.ws + WS_W);
    ph_wmax(p, lds, G, opq(bid), wv); GRID_BAR();
    ph_prologue(p, lds, G, opq(bid), wv); GRID_BAR();
    for (int seg = 0; seg < 3; ++seg) {
        const int row0 = seg == 2 ? MC : 0, nrows = seg == 0 ? M_ALL : MC;
        const bf16* XBs = (const bf16*)(p.ws + WS_XB) + (size_t)row0 * D; const float* RSs = (const float*)(p.ws + WS_RS) + row0;
        bf16* MBs = (bf16*)(p.ws + (seg == 0 ? WS_MBF : WS_MB)); bf16* HAs = (bf16*)(p.ws + (seg == 0 ? WS_BIG : WS_Q));
        unsigned char* A8G = (unsigned char*)p.out + 128 * MiB + (size_t)row0 * D;
        unsigned char* A8s = seg == 0 ? p.ws + WS_MB : A8G;
        const float* SAs = (const float*)(p.ws + WS_SA) + row0; const float* WSCp = (const float*)(p.ws + WS_WSC);
        if (seg > 0) { pg8::EpiAttRot8 E{(bf16*)(p.ws + WS_BIG), SAs, WSCp + WSC_KV, (const float*)(p.ws + WS_ACOS), (const float*)(p.ws + WS_ASIN), KVW, 12}; gemm_call<pg8::EpiAttRot8, 2>(lds, (const bf16*)A8G, WB + W_KV, MC, KVW, D, E, G, opq(bid), wv); }
        for (int li = 0; li < 2; ++li) {
            const int layer = (seg == 0 ? 0 : 2) + li;
            if (seg == 0) {
                { pg8::EpiRetIn E{(bf16*)(p.ws + WS_BIG), RSs, (const float*)(p.ws + WS_RCOS), (const float*)(p.ws + WS_RSIN), RQP, 0}; gemm_call(lds, XBs, WB + W_RETIN + (size_t)layer * RET_IN * D, M_ALL, RQP, D, E, G, opq(bid), wv); } GRID_BAR();
                ph_retention(p, lds, G, opq(bid), wv); GRID_BAR();
                { pg8::EpiGate8 E{(bf16*)p.out, SAs, WSCp + WSC_RET + layer * RET_IN + RQP, (LAS float*)(lds + HALO_LDS), p.ret_gn + layer * 2048}; gemm_call_pair<pg8::EpiGate8, 2>(lds, (const bf16*)A8s, WB + W_RETIN + (size_t)layer * RET_IN * D + (size_t)RQP * D, M_ALL, 2048, D, E, G, opq(bid), wv); } GRID_BAR();
                { pg8::EpiRS E{MBs, D, 0}; gemm_call(lds, (const bf16*)p.out, WB + W_RETOUT + (size_t)layer * D * 2048, M_ALL, D, 2048, E, G, opq(bid), wv); } GRID_BAR();
            } else {
                { pg8::EpiAttRot8 E{(bf16*)(p.ws + WS_Q), SAs, WSCp + WSC_Q + (layer - 2) * QW, (const float*)(p.ws + WS_ACOS), (const float*)(p.ws + WS_ASIN), QW, 12}; gemm_call<pg8::EpiAttRot8, 2>(lds, (const bf16*)A8G, (const bf16*)((const unsigned char*)(WB + W_Q) + (size_t)(layer - 2) * QW * D), MC, QW, D, E, G, opq(bid), wv); } GRID_BAR();
                ph_attn_xy(p, lds, G, opq(bid), wv); GRID_BAR();
                { pg8::EpiRS E{MBs, D, 0}; gemm_call(lds, (const bf16*)(p.ws + WS_O), WB + W_O + (size_t)(layer - 2) * D * D, MC, D, D, E, G, opq(bid), wv); } GRID_BAR();
            }
            ph_thin(p, row0, nrows, MBs, p.n_mix_post + layer * D, nullptr, A8s, true, G, opq(bid), wv); GRID_BAR();
            { pg8::EpiUpConv E{HAs, (const float*)(p.ws + WS_SA) + row0, (const float*)(p.ws + WS_WSC) + layer * 2 * FF, p.conv_w + (size_t)layer * 3 * FF, p.conv_b + (size_t)layer * FF, (float*)(p.ws + WS_HALO), (LAS float*)(lds + HALO_LDS)}; gemm_call<pg8::EpiUpConv, 2>(lds, (const bf16*)A8s, (const bf16*)((const unsigned char*)(WB + W_UP) + (size_t)layer * 2 * FF * D), nrows, 2 * FF, D, E, G, opq(bid), wv); } GRID_BAR();
            conv_fix_local(p, layer, HAs, nrows, G, opq(bid), wv);
            { pg8::EpiRS E{MBs, D, 0}; gemm_call(lds, HAs, WB + W_DOWN + (size_t)layer * D * FF, nrows, D, FF, E, G, opq(bid), wv); } GRID_BAR();
            ph_thin(p, row0, nrows, MBs, p.n_ffn_post + layer * D, layer == 3 ? p.out + (size_t)row0 * D : nullptr, layer == 0 ? A8s : (layer < 3 ? A8G : nullptr), false, G, opq(bid), wv); GRID_BAR();
        }
    }
}

extern "C" void kernel_launch(void* const* d_in, const int* in_sizes, int n_in, void* d_out, int out_size, void* d_ws, size_t ws_size, hipStream_t stream) {
    static int grid = 0;
    if (grid == 0) {
        if (n_in != 16 || in_sizes[0] != M_ALL * D || out_size != M_ALL * D || ws_size < WS_END) {
            fprintf(stderr, "kernel_launch: unexpected shapes: n_in %d in0 %d out %d ws %zu (need %zu)\n", n_in, n_in > 0 ? in_sizes[0] : -1, out_size, ws_size, (size_t)WS_END); grid = -1; return; }
        int dev = 0, cus = 0, per_cu = 0;
        if (hipGetDevice(&dev) != hipSuccess || hipDeviceGetAttribute(&cus, hipDeviceAttributeMultiprocessorCount, dev) != hipSuccess) { grid = -1; return; }
        if (hipFuncSetAttribute((const void*)yoco_fwd, hipFuncAttributeMaxDynamicSharedMemorySize, LDS_BYTES) != hipSuccess) { fprintf(stderr, "kernel_launch: hipFuncSetAttribute failed\n"); grid = -1; return; }
        if (hipOccupancyMaxActiveBlocksPerMultiprocessor(&per_cu, (const void*)yoco_fwd, 512, LDS_BYTES) != hipSuccess || per_cu < 1) { fprintf(stderr, "kernel_launch: occupancy query says %d blocks per CU\n", per_cu); (void)hipGetLastError(); grid = -1; return; }
        if (cus != 256) { fprintf(stderr, "kernel_launch: built for a 256-CU device, found %d CUs\n", cus); grid = -1; return; }
        grid = cus;
    }
    if (grid < 0) return;
    Params p{};
    p.x = (const float*)d_in[0]; p.ret_w_in = (const float*)d_in[1]; p.ret_w_out = (const float*)d_in[2]; p.ret_gn = (const float*)d_in[3]; p.kv_norm = (const float*)d_in[4];
    p.w_kv = (const float*)d_in[5]; p.w_q = (const float*)d_in[6]; p.w_o = (const float*)d_in[7]; p.n_mix_pre = (const float*)d_in[8]; p.n_mix_post = (const float*)d_in[9];
    p.n_ffn_pre = (const float*)d_in[10]; p.n_ffn_post = (const float*)d_in[11]; p.w_up = (const float*)d_in[12]; p.conv_w = (const float*)d_in[13]; p.conv_b = (const float*)d_in[14]; p.w_down = (const float*)d_in[15];
    p.out = (float*)d_out; p.ws = (unsigned char*)d_ws;
    (void)hipMemsetAsync((char*)d_ws + WS_CTL, 0, 65536, stream);
    hipLaunchKernelGGL(yoco_fwd, dim3(grid), dim3(512), LDS_BYTES, stream, p);
}
```
